# Optimizing an MI355X kernel written in HIP

```python
import math
import jax, jax.numpy as jnp
from jax import lax
import numpy as np

D_MODEL = 2048
BATCH = 4
SEQ = 8192
DEPTH = 2
DEC_BATCH = 8
DEC_SEQ = 16
PAST_LEN = 2048

CHUNK = 64
Q_BLOCK = 128
N_MIXERS = 2
SB_HEADS = 16
SB_HEAD_DIM = D_MODEL // SB_HEADS
DIFF_HEADS = 8
DIFF_QK_DIM = D_MODEL // (2 * DIFF_HEADS)
DIFF_V_DIM = 2 * DIFF_QK_DIM
D_FF = 4 * D_MODEL
N_DIFF_LAYERS = DEPTH // N_MIXERS
NORM_EPS = 1e-6
SUBLN_EPS = 1e-5

kernel_name = "sb_diff_alibi_stream_step"


def rmsnorm(x, g, eps=NORM_EPS):
    xf = x.astype(jnp.float32)
    y = xf * lax.rsqrt(jnp.mean(xf * xf, axis=-1, keepdims=True) + eps)
    return (y * g.astype(jnp.float32)).astype(x.dtype)


def alibi_slopes(n):
    return jnp.asarray(np.array([2.0 ** (-8.0 * (i + 1) / n) for i in range(n)], dtype=np.float32))


def diff_lambda_init(layer_idx):
    return 0.8 - 0.6 * math.exp(-0.3 * layer_idx)


def stick_breaking_attn(q, k, v, q_pos, k_pos):
    z = jnp.einsum("bqhd,bkhd->bhqk", q.astype(jnp.float32), k.astype(jnp.float32)) * (SB_HEAD_DIM ** -0.5)
    allowed = k_pos[None, :] < q_pos[:, None]
    log_fail = jnp.where(allowed, jax.nn.log_sigmoid(-z), 0.0)
    suffix = lax.cumsum(log_fail, axis=3, reverse=True) - log_fail
    w = jnp.where(allowed, jnp.exp(jax.nn.log_sigmoid(z) + suffix), 0.0)
    out = jnp.einsum("bhqk,bkhd->bqhd", w, v.astype(jnp.float32))
    return out.astype(q.dtype)


def diff_attn(q, k, v, q_pos, k_pos, lam, subln_g, lambda_init):
    B, Tq = q.shape[:2]
    Tk = k.shape[1]
    s = jnp.einsum("bqhd,bkhd->bhqk", q.astype(jnp.float32), k.astype(jnp.float32)) * (DIFF_QK_DIM ** -0.5)
    slopes = jnp.repeat(alibi_slopes(DIFF_HEADS), 2)
    dist = jnp.abs(q_pos[:, None] - k_pos[None, :]).astype(jnp.float32)
    allowed = (k_pos[None, :] // CHUNK) <= (q_pos[:, None] // CHUNK)
    s = jnp.where(allowed, s - slopes[:, None, None] * dist, -jnp.inf)
    p = jax.nn.softmax(s, axis=-1).reshape(B, DIFF_HEADS, 2, Tq, Tk)
    w = p[:, :, 0] - lam * p[:, :, 1]
    o = jnp.einsum("bhqk,bkhd->bqhd", w, v.astype(jnp.float32))
    o = rmsnorm(o, subln_g, SUBLN_EPS) * (1.0 - lambda_init)
    return o.astype(q.dtype)


def sweep_query_blocks(attn_fn, q, q_pos):
    B, T = q.shape[:2]
    if T <= Q_BLOCK:
        return attn_fn(q, q_pos)
    nb = T // Q_BLOCK
    qb = jnp.moveaxis(q.reshape(B, nb, Q_BLOCK, *q.shape[2:]), 1, 0)
    pb = q_pos.reshape(nb, Q_BLOCK)
    ob = lax.map(lambda a: attn_fn(a[0], a[1]), (qb, pb))
    ob = jnp.moveaxis(ob, 0, 1)
    return ob.reshape(B, T, *ob.shape[3:])


def trunk_layer(i, x, past_k, past_v, q_pos, k_pos, g_attn, w_qkv_i, w_o_i,
                lq1, lk1, lq2, lk2, subln_g, g_mlp, w_up_i, w_down_i):
    B, T, _ = x.shape
    h = rmsnorm(x, g_attn)
    q, k, v = jnp.split(h @ w_qkv_i, 3, axis=-1)
    k_all = k if past_k is None else jnp.concatenate([past_k.astype(k.dtype), k], axis=1)
    v_all = v if past_v is None else jnp.concatenate([past_v.astype(v.dtype), v], axis=1)
    Tk = k_all.shape[1]
    if i % N_MIXERS == 0:
        qh = q.reshape(B, T, SB_HEADS, SB_HEAD_DIM)
        kh = k_all.reshape(B, Tk, SB_HEADS, SB_HEAD_DIM)
        vh = v_all.reshape(B, Tk, SB_HEADS, SB_HEAD_DIM)
        fn = lambda qb, pb: stick_breaking_attn(qb, kh, vh, pb, k_pos)
    else:
        j = i // N_MIXERS
        lam = (jnp.exp(jnp.sum(lq1[j].astype(jnp.float32) * lk1[j].astype(jnp.float32)))
               - jnp.exp(jnp.sum(lq2[j].astype(jnp.float32) * lk2[j].astype(jnp.float32)))
               + diff_lambda_init(i))
        qh = q.reshape(B, T, 2 * DIFF_HEADS, DIFF_QK_DIM)
        kh = k_all.reshape(B, Tk, 2 * DIFF_HEADS, DIFF_QK_DIM)
        vh = v_all.reshape(B, Tk, DIFF_HEADS, DIFF_V_DIM)
        g_sub = subln_g[j]
        li = diff_lambda_init(i)
        fn = lambda qb, pb: diff_attn(qb, kh, vh, pb, k_pos, lam, g_sub, li)
    mix = sweep_query_blocks(fn, qh, q_pos).reshape(B, T, D_MODEL)
    x = x + mix @ w_o_i
    h2 = rmsnorm(x, g_mlp)
    x = x + jnp.square(jax.nn.relu(h2 @ w_up_i)) @ w_down_i
    return x, k, v


def setup_inputs(seed: int = 0) -> dict:
    key = jax.random.key(seed)
    ks = jax.random.split(key, 16)
    f32 = jnp.float32
    nd = max(N_DIFF_LAYERS, 1) if DEPTH > 1 else N_DIFF_LAYERS
    return {
        "x_prompt": jax.random.normal(ks[0], (BATCH, SEQ, D_MODEL), f32),
        "x_sample": jax.random.normal(ks[1], (DEC_BATCH, DEC_SEQ, D_MODEL), f32),
        "cache_k": jax.random.normal(ks[2], (DEPTH, DEC_BATCH, PAST_LEN, D_MODEL), f32),
        "cache_v": jax.random.normal(ks[3], (DEPTH, DEC_BATCH, PAST_LEN, D_MODEL), f32),
        "norm_attn": 1.0 + 0.01 * jax.random.normal(ks[4], (DEPTH, D_MODEL), f32),
        "w_qkv": jax.random.normal(ks[5], (DEPTH, D_MODEL, 3 * D_MODEL), f32) * D_MODEL ** -0.5,
        "w_o": jax.random.normal(ks[6], (DEPTH, D_MODEL, D_MODEL), f32) * D_MODEL ** -0.5,
        "lambda_q1": 0.1 * jax.random.normal(ks[7], (nd, DIFF_QK_DIM), f32),
        "lambda_k1": 0.1 * jax.random.normal(ks[8], (nd, DIFF_QK_DIM), f32),
        "lambda_q2": 0.1 * jax.random.normal(ks[9], (nd, DIFF_QK_DIM), f32),
        "lambda_k2": 0.1 * jax.random.normal(ks[10], (nd, DIFF_QK_DIM), f32),
        "subln_g": 1.0 + 0.01 * jax.random.normal(ks[11], (nd, DIFF_V_DIM), f32),
        "norm_mlp": 1.0 + 0.01 * jax.random.normal(ks[12], (DEPTH, D_MODEL), f32),
        "w_up": jax.random.normal(ks[13], (DEPTH, D_MODEL, D_FF), f32) * D_MODEL ** -0.5,
        "w_down": jax.random.normal(ks[14], (DEPTH, D_FF, D_MODEL), f32) * D_FF ** -0.5,
        "norm_final": 1.0 + 0.01 * jax.random.normal(ks[15], (D_MODEL,), f32),
    }


def reference(x_prompt, x_sample, cache_k, cache_v, norm_attn, w_qkv, w_o,
              lambda_q1, lambda_k1, lambda_q2, lambda_k2, subln_g,
              norm_mlp, w_up, w_down, norm_final):
    t_p = x_prompt.shape[1]
    t_s = x_sample.shape[1]
    past = cache_k.shape[2]
    pos_p = jnp.arange(t_p, dtype=jnp.int32)
    pos_s = past + jnp.arange(t_s, dtype=jnp.int32)
    pos_s_keys = jnp.arange(past + t_s, dtype=jnp.int32)
    xp, xs = x_prompt, x_sample
    kp, vp, ksm, vsm = [], [], [], []
    for i in range(DEPTH):
        shared = (norm_attn[i], w_qkv[i], w_o[i], lambda_q1, lambda_k1, lambda_q2, lambda_k2,
                  subln_g, norm_mlp[i], w_up[i], w_down[i])
        xp, k_new, v_new = trunk_layer(i, xp, None, None, pos_p, pos_p, *shared)
        xs, k_s, v_s = trunk_layer(i, xs, cache_k[i], cache_v[i], pos_s, pos_s_keys, *shared)
        kp.append(k_new); vp.append(v_new); ksm.append(k_s); vsm.append(v_s)
    y_prompt = rmsnorm(xp, norm_final)
    y_sample = rmsnorm(xs, norm_final)
    return (y_prompt, y_sample, jnp.stack(kp), jnp.stack(vp), jnp.stack(ksm), jnp.stack(vsm))
```

```cpp
#include <hip/hip_runtime.h>
#include <cstdio>
#include <cstdint>
constexpr int D = 2048, BATCH = 4, SEQ = 8192, DEC_B = 8, DEC_T = 16, PAST = 2048, FF = 8192;
constexpr int MP = BATCH * SEQ;
constexpr int MS = DEC_B * DEC_T;
constexpr int MV = MP + MS;
constexpr int M = 33024;
constexpr size_t QKV_WS_Q = (size_t)451 << 20, QKV_WS_STRIDE = (size_t)129 << 20;
constexpr size_t QKV_OUT_KP = (size_t)MV * D, QKV_OUT_VP = QKV_OUT_KP + 2 * (size_t)MP * D, QKV_OUT_KS = QKV_OUT_VP + 2 * (size_t)MP * D, QKV_OUT_VS = QKV_OUT_KS + 2 * (size_t)MS * D;
namespace pg8 {
#define PG8_LAS __attribute__((address_space(3)))
typedef unsigned short bf16_t;
typedef short bf16x8 __attribute__((ext_vector_type(8)));
typedef float f32x4 __attribute__((ext_vector_type(4)));
typedef unsigned u32x4 __attribute__((ext_vector_type(4)));
constexpr int BM = 256, BK = 64, HALF = 128, HTB = HALF * BK * 2  , STAGE_BYTES = 8 * HTB, NXCD = 8, WGM = 8;

__host__ __device__ __forceinline__ int lds_byte(int r, int c) { const int st = (r >> 4) * 2 + (c >> 5), rr = r & 15, cc = c & 31, ob = rr * 64 + cc * 2; return st * 1024 + (ob ^ (((ob >> 9) & 1) << 5)); }
__host__ __device__ __forceinline__ void stage_rc(int b, int& R, int& C) { const int st = b / 1024, sb = b % 1024, swz = sb ^ (((sb >> 9) & 1) << 5); R = (st >> 1) * 16 + swz / 64; C = (st & 1) * 32 + (swz % 64) / 2; }
__host__ __device__ __forceinline__ int perm32(int rho) { const int n = rho >> 4, i = rho & 15; return 8 * (i >> 2) + 4 * n + (i & 3); }

struct Unit { int pm, pn; };
struct Gemm { const bf16_t* A; const bf16_t* Bt; int M, N, K; };

struct StaticOrder {
    int nM, nN, nwg, G, c;
    __host__ __device__ void init(int M, int N, int G_, int c_) { nM = M / BM; nN = N / BM; nwg = nM * nN; G = G_; c = c_; }
    __host__ __device__ bool next(int i, Unit& u) const {
        const long L = (long)i * G + c; if (L >= nwg) return false;
        int wgid = (int)L; { const int q = nwg / NXCD, r = nwg % NXCD, xcd = wgid % NXCD, off = wgid / NXCD; wgid = (xcd < r ? xcd * (q + 1) : r * (q + 1) + (xcd - r) * q) + off; }
        const int nig = WGM * nN, gid = wgid / nig, fm = gid * WGM, gsz = (nM - fm) < WGM ? (nM - fm) : WGM;
        u.pm = fm + ((wgid % nig) % gsz); u.pn = (wgid % nig) / gsz; return true;
    }
    __device__ __forceinline__ void a_ready(const Unit&) const {}
    __device__ __forceinline__ void done(const Unit&) const {}
};

__device__ __forceinline__ unsigned cvt_pk_bf16(float lo, float hi) { unsigned r; asm volatile("v_cvt_pk_bf16_f32 %0, %1, %2" : "=v"(r) : "v"(lo), "v"(hi)); return r; }
typedef float f32x2 __attribute__((ext_vector_type(2)));
typedef unsigned u32x2 __attribute__((ext_vector_type(2)));
struct EpiQKV {
    static constexpr bool PERM = true, AFTER_DRAIN = false;
    unsigned char* ws; float* out; int L; float qscale;
    __device__ __forceinline__ void operator()(const f32x4 (&acc)[2][2][4][2], const Unit& u, int wr, int wc, int fr, int fq) const {
        const int row0 = u.pm * BM + wr * 64 + fr; const int t = u.pn >> 3; const int col0 = (u.pn & 7) * BM + wc * 32 + 8 * fq;
        bf16_t* ob = (bf16_t*)(ws + QKV_WS_Q + (size_t)t * QKV_WS_STRIDE);
        float* fp = out + (t == 1 ? QKV_OUT_KP : QKV_OUT_VP) + (size_t)L * MP * D; float* fs = out + (t == 1 ? QKV_OUT_KS : QKV_OUT_VS) + (size_t)L * MS * D;
        const float sc = t == 0 ? qscale : 1.f;
#pragma unroll
        for (int ai = 0; ai < 2; ++ai)
#pragma unroll
            for (int m = 0; m < 4; ++m) { const int row = row0 + ai * HALF + m * 16;
                float* frow = nullptr; if (t != 0) { if (row < MP) frow = fp + (size_t)row * D; else if (row < MV) frow = fs + (size_t)(row - MP) * D; }
                bf16_t* rowp = ob + (size_t)row * D + col0;
#pragma unroll
                for (int bj = 0; bj < 2; ++bj) { const f32x4 v0 = acc[ai][bj][m][0], v1 = acc[ai][bj][m][1];
                    u32x4 w; w.x = cvt_pk_bf16(v0[0] * sc, v0[1] * sc); w.y = cvt_pk_bf16(v0[2] * sc, v0[3] * sc); w.z = cvt_pk_bf16(v1[0] * sc, v1[1] * sc); w.w = cvt_pk_bf16(v1[2] * sc, v1[3] * sc);
                    *(u32x4*)(rowp + bj * HALF) = w;
                    if (frow) { *(f32x4*)(frow + col0 + bj * HALF) = v0; *(f32x4*)(frow + col0 + bj * HALF + 4) = v1; } } }
    }
};
struct EpiResid {
    static constexpr bool PERM = false, AFTER_DRAIN = false;
    const float* rp; const float* rs; float* out;
    __device__ __forceinline__ void operator()(const f32x4 (&acc)[2][2][4][2], const Unit& u, int wr, int wc, int fr, int fq) const {
        const int col0 = u.pn * BM + wc * 32 + 4 * fq;
#pragma unroll
        for (int ai = 0; ai < 2; ++ai)
#pragma unroll
            for (int m = 0; m < 4; ++m) { const int row = u.pm * BM + ai * HALF + wr * 64 + m * 16 + fr;
                if (row < MV) { const float* r = row < MP ? rp + (size_t)row * D : rs + (size_t)(row - MP) * D; float* o = out + (size_t)row * D;
#pragma unroll
                    for (int bj = 0; bj < 2; ++bj)
#pragma unroll
                        for (int n = 0; n < 2; ++n) { const int c = col0 + bj * HALF + n * 16; *(f32x4*)(o + c) = *(const f32x4*)(r + c) + acc[ai][bj][m][n]; } } }
    }
};
struct EpiRelu2 {
    static constexpr bool PERM = true, AFTER_DRAIN = false;
    bf16_t* O; int ldc;
    __device__ __forceinline__ void operator()(const f32x4 (&acc)[2][2][4][2], const Unit& u, int wr, int wc, int fr, int fq) const {
        const int row0 = u.pm * BM + wr * 64 + fr, col0 = u.pn * BM + wc * 32 + 8 * fq;
#pragma unroll
        for (int ai = 0; ai < 2; ++ai)
#pragma unroll
            for (int m = 0; m < 4; ++m) { bf16_t* rowp = O + (size_t)(row0 + ai * HALF + m * 16) * ldc + col0;
#pragma unroll
                for (int bj = 0; bj < 2; ++bj) { f32x4 v0 = acc[ai][bj][m][0], v1 = acc[ai][bj][m][1];
#pragma unroll
                    for (int e = 0; e < 4; ++e) { const float a = fmaxf(v0[e], 0.f), b = fmaxf(v1[e], 0.f); v0[e] = a * a; v1[e] = b * b; }
                    u32x4 w; w.x = cvt_pk_bf16(v0[0], v0[1]); w.y = cvt_pk_bf16(v0[2], v0[3]); w.z = cvt_pk_bf16(v1[0], v1[1]); w.w = cvt_pk_bf16(v1[2], v1[3]);
                    *(u32x4*)(rowp + bj * HALF) = w; } }
    }
};
template <class Epi, class Sched, bool ALIGN_EPI = false, bool SP2 = false>
__device__ __forceinline__ void gemm_phase(PG8_LAS unsigned char* lds, const Gemm g, const Sched& S, const Epi& E) {
    const int tid = threadIdx.x, wid = __builtin_amdgcn_readfirstlane(tid >> 6), lane = tid & 63, wr = wid >> 2, wc = wid & 3, fr = lane & 15, fq = lane >> 4;
    const int K = g.K, nt = K / BK;
    unsigned voffA[2], voffB[2];
#pragma unroll
    for (int i = 0; i < 2; ++i) { int R, C; stage_rc(tid * 16 + i * 8192, R, C); const int Rb = Epi::PERM ? ((R & ~31) + perm32(R & 31)) : R;
        voffA[i] = (unsigned)(R * K + C) * 2u; voffB[i] = (unsigned)(Rb * K + C) * 2u; }
    const size_t kstep = (size_t)(BK * 2);
    const size_t hstep = (size_t)HALF * K * 2;
    const size_t tstep = 2 * hstep;
    const unsigned ldsw = (unsigned)wid * 1024u;
    const int aoff = lds_byte(wr * 64 + fr, fq * 8), boff = lds_byte(wc * 32 + fr, fq * 8);
#define PG8_SA(b, h) (((b) * 2 + (h)) * HTB)
#define PG8_SB(b, h) ((4 + (b) * 2 + (h)) * HTB)
#define PG8_STAGE(bufoff, gbase, voff) do { _Pragma("unroll") for (int _i = 0; _i < 2; ++_i) \
        __builtin_amdgcn_global_load_lds((const unsigned*)((const char*)(gbase) + (voff)[_i]), (PG8_LAS unsigned*)(lds + (bufoff) + ldsw + _i * 8192), 16, 0, 0); } while (0)
#define PG8_LDA(dst, b, h) do { _Pragma("unroll") for (int m = 0; m < 4; ++m) _Pragma("unroll") for (int k = 0; k < 2; ++k) dst[m][k] = *(const PG8_LAS bf16x8*)(lds + PG8_SA(b, h) + aoff + m * 2048 + k * 1024); } while (0)
#define PG8_LDB(dst, b, h) do { _Pragma("unroll") for (int n = 0; n < 2; ++n) _Pragma("unroll") for (int k = 0; k < 2; ++k) dst[n][k] = *(const PG8_LAS bf16x8*)(lds + PG8_SB(b, h) + boff + n * 2048 + k * 1024); } while (0)
#define PG8_MMA(ai, bj, At, Bt) do { __builtin_amdgcn_s_setprio(1); _Pragma("unroll") for (int m = 0; m < 4; ++m) _Pragma("unroll") for (int n = 0; n < 2; ++n) _Pragma("unroll") for (int k = 0; k < 2; ++k) \
        acc[ai][bj][m][n] = __builtin_amdgcn_mfma_f32_16x16x32_bf16(Bt[n][k], At[m][k], acc[ai][bj][m][n], 0, 0, 0); __builtin_amdgcn_s_setprio(0); } while (0)
#define PG8_WAIT_V(n) asm volatile("s_waitcnt vmcnt(" #n ")" ::: "memory")
#define PG8_WAIT_L(n) asm volatile("s_waitcnt lgkmcnt(" #n ")" ::: "memory")
#define PG8_BAR __builtin_amdgcn_s_barrier()
#define PG8_SCHED __builtin_amdgcn_sched_barrier(0)
    Unit cur, nxt; int ui = 0;
    if (!S.next(0, cur)) return;
    f32x4 acc[2][2][4][2];
#pragma unroll
    for (int a = 0; a < 2; ++a)
#pragma unroll
        for (int b = 0; b < 2; ++b)
#pragma unroll
            for (int m = 0; m < 4; ++m)
#pragma unroll
                for (int n = 0; n < 2; ++n) acc[a][b][m][n] = (f32x4){0.f, 0.f, 0.f, 0.f};
    bf16x8 At[4][2], B0[2][2], B1[2][2];
    const char* cA = (const char*)g.A + (size_t)cur.pm * tstep; const char* cB = (const char*)g.Bt + (size_t)cur.pn * tstep;
    S.a_ready(cur);
    if constexpr (SP2) {
        PG8_STAGE(PG8_SB(0, 0), cB, voffB); PG8_STAGE(PG8_SB(0, 1), cB + hstep, voffB); PG8_STAGE(PG8_SA(0, 0), cA, voffA); PG8_STAGE(PG8_SA(0, 1), cA + hstep, voffA);
        if (wr == 1) PG8_BAR;
        PG8_WAIT_V(2); PG8_BAR;
        PG8_STAGE(PG8_SB(1, 0), cB + kstep, voffB); PG8_STAGE(PG8_SA(1, 0), cA + kstep, voffA); PG8_STAGE(PG8_SB(1, 1), cB + hstep + kstep, voffB);
        PG8_WAIT_V(6); PG8_BAR;
    } else {
        PG8_STAGE(PG8_SB(0, 0), cB, voffB); PG8_STAGE(PG8_SA(0, 0), cA, voffA); PG8_STAGE(PG8_SB(0, 1), cB + hstep, voffB); PG8_STAGE(PG8_SA(0, 1), cA + hstep, voffA);
        if (wr == 1) PG8_BAR;
        PG8_WAIT_V(4); PG8_BAR;
        PG8_STAGE(PG8_SB(1, 0), cB + kstep, voffB); PG8_STAGE(PG8_SA(1, 0), cA + kstep, voffA); PG8_STAGE(PG8_SB(1, 1), cB + hstep + kstep, voffB);
        PG8_WAIT_V(6); PG8_BAR;
    }
    for (;;) {
        const bool has_next = S.next(ui + 1, nxt);
        const char* nA = has_next ? (const char*)g.A + (size_t)nxt.pm * tstep : cA; const char* nB = has_next ? (const char*)g.Bt + (size_t)nxt.pn * tstep : cB;
        for (int t = 0; t < nt; t += 2) {
            const bool last = (t == nt - 2);
            const char* a1 = cA + (size_t)(t + 1) * kstep;
            const char* a2 = last ? nA : cA + (size_t)(t + 2) * kstep; const char* b2 = last ? nB : cB + (size_t)(t + 2) * kstep;
            const char* a3 = a2 + kstep; const char* b3 = b2 + kstep;
            if (last && has_next) S.a_ready(nxt);
            if constexpr (SP2) {
            PG8_LDB(B0, 0, 0); PG8_LDB(B1, 0, 1); PG8_SCHED; PG8_LDA(At, 0, 0); PG8_STAGE(PG8_SA(1, 1), a1 + hstep, voffA);
            PG8_WAIT_V(8); PG8_WAIT_L(0); PG8_BAR; PG8_MMA(0, 0, At, B0); PG8_MMA(0, 1, At, B1); PG8_BAR; PG8_SCHED;
            PG8_LDA(At, 0, 1); PG8_STAGE(PG8_SB(0, 0), b2, voffB); PG8_STAGE(PG8_SB(0, 1), b2 + hstep, voffB); PG8_STAGE(PG8_SA(0, 0), a2, voffA);
            PG8_WAIT_V(8); PG8_WAIT_L(0); PG8_BAR; PG8_MMA(1, 0, At, B0); PG8_MMA(1, 1, At, B1); PG8_BAR; PG8_SCHED;
            PG8_LDB(B0, 1, 0); PG8_LDB(B1, 1, 1); PG8_SCHED; PG8_LDA(At, 1, 0); PG8_STAGE(PG8_SA(0, 1), a2 + hstep, voffA);
            PG8_WAIT_V(8); PG8_WAIT_L(0); PG8_BAR; PG8_MMA(0, 0, At, B0); PG8_MMA(0, 1, At, B1); PG8_BAR; PG8_SCHED;
            PG8_LDA(At, 1, 1); PG8_STAGE(PG8_SB(1, 0), b3, voffB); PG8_STAGE(PG8_SB(1, 1), b3 + hstep, voffB); PG8_STAGE(PG8_SA(1, 0), a3, voffA);
            PG8_WAIT_V(8); PG8_WAIT_L(0); PG8_BAR; PG8_MMA(1, 0, At, B0); PG8_MMA(1, 1, At, B1); PG8_BAR; PG8_SCHED;
            } else {
            PG8_LDB(B0, 0, 0); PG8_SCHED; PG8_LDA(At, 0, 0); PG8_STAGE(PG8_SA(1, 1), a1 + hstep, voffA);
            PG8_WAIT_L(8); PG8_BAR; PG8_WAIT_L(0); PG8_MMA(0, 0, At, B0); PG8_BAR; PG8_SCHED;
            PG8_LDB(B1, 0, 1); PG8_STAGE(PG8_SB(0, 0), b2, voffB);
            PG8_BAR; PG8_WAIT_L(0); PG8_MMA(0, 1, At, B1); PG8_BAR;
            PG8_LDA(At, 0, 1); PG8_STAGE(PG8_SA(0, 0), a2, voffA);
            PG8_BAR; PG8_WAIT_L(0); PG8_MMA(1, 0, At, B0); PG8_BAR; PG8_SCHED;
            PG8_STAGE(PG8_SB(0, 1), b2 + hstep, voffB);
            PG8_WAIT_V(6); PG8_BAR; PG8_MMA(1, 1, At, B1); PG8_BAR;
            PG8_LDB(B0, 1, 0); PG8_SCHED; PG8_LDA(At, 1, 0); PG8_STAGE(PG8_SA(0, 1), a2 + hstep, voffA);
            PG8_WAIT_L(8); PG8_BAR; PG8_WAIT_L(0); PG8_MMA(0, 0, At, B0); PG8_BAR; PG8_SCHED;
            PG8_LDB(B1, 1, 1); PG8_STAGE(PG8_SB(1, 0), b3, voffB);
            PG8_BAR; PG8_WAIT_L(0); PG8_MMA(0, 1, At, B1); PG8_BAR;
            PG8_LDA(At, 1, 1); PG8_STAGE(PG8_SA(1, 0), a3, voffA);
            PG8_BAR; PG8_WAIT_L(0); PG8_MMA(1, 0, At, B0); PG8_BAR; PG8_SCHED;
            PG8_STAGE(PG8_SB(1, 1), b3 + hstep, voffB);
            PG8_WAIT_V(6); PG8_BAR; PG8_MMA(1, 1, At, B1); PG8_BAR;
            }
        }
        if constexpr (ALIGN_EPI) { if (wr == 0) PG8_BAR; }
        if constexpr (!Epi::AFTER_DRAIN) { E(acc, cur, wr, wc, fr, fq); S.done(cur); }
        if (!has_next) break;
#pragma unroll
        for (int a = 0; a < 2; ++a)
#pragma unroll
            for (int b = 0; b < 2; ++b)
#pragma unroll
                for (int m = 0; m < 4; ++m)
#pragma unroll
                    for (int n = 0; n < 2; ++n) acc[a][b][m][n] = (f32x4){0.f, 0.f, 0.f, 0.f};
        cur = nxt; cA = nA; cB = nB; ++ui;
        if constexpr (ALIGN_EPI) { if (wr == 1) PG8_BAR; }
    }
    PG8_WAIT_V(0);
    if constexpr (!ALIGN_EPI) { if (wr == 0) PG8_BAR; }
    PG8_BAR;
    if constexpr (Epi::AFTER_DRAIN) { E.fused(acc, cur, wr, wc, fr, fq, lds, wid, lane); S.done(cur); }
#undef PG8_SA
#undef PG8_SB
#undef PG8_STAGE
#undef PG8_LDA
#undef PG8_LDB
#undef PG8_MMA
#undef PG8_WAIT_V
#undef PG8_WAIT_L
#undef PG8_BAR
#undef PG8_SCHED
}
}
#ifndef PG8_SP2
#define PG8_SP2 true
#endif
#ifndef PG8_ALIGN
#define PG8_ALIGN true
#endif
constexpr int NWAVES = 8;
#ifndef MK_N_LAUNCHES
#define MK_N_LAUNCHES 15
#endif
constexpr int N_PHASES = 15;
constexpr bool ONE_LAUNCH = (MK_N_LAUNCHES == 1);

constexpr size_t MiB = 1u << 20;
constexpr size_t WS_CTL = 0, CTL_ZERO_BYTES = 1 * MiB;
constexpr size_t WS_W = 2 * MiB;
constexpr size_t W_LAYER = 96 * MiB, W_QKV = 0, W_O = 24 * MiB, W_UP = 32 * MiB, W_DN = 64 * MiB;
constexpr size_t WS_XN = 194 * MiB;
constexpr size_t WS_CK = 323 * MiB, WS_CV = 387 * MiB;
constexpr size_t WS_Q = 451 * MiB, WS_K = 580 * MiB, WS_V = 709 * MiB;
constexpr size_t WS_H = WS_Q;
constexpr size_t WS_END = 967 * MiB;
static_assert(WS_H + (size_t)M * FF * 2 <= WS_END && WS_V + (size_t)M * D * 2 <= WS_END && WS_XN + (size_t)M * D * 2 <= WS_CK && WS_W + 2 * W_LAYER <= WS_XN, "d_ws map");
static_assert(QKV_WS_Q == WS_Q && WS_K == WS_Q + QKV_WS_STRIDE && WS_V == WS_Q + 2 * QKV_WS_STRIDE, "QKV epilogue map");
constexpr int CW_TMO = 0;
constexpr int CW_BAR = 4096;

constexpr size_t OUT_Y = 0, OUT_KP = (size_t)MV * D, OUT_VP = OUT_KP + 2 * (size_t)MP * D, OUT_KS = OUT_VP + 2 * (size_t)MP * D, OUT_VS = OUT_KS + 2 * (size_t)MS * D, OUT_END = OUT_VS + 2 * (size_t)MS * D;
static_assert(OUT_KP == QKV_OUT_KP && OUT_VP == QKV_OUT_VP && OUT_KS == QKV_OUT_KS && OUT_VS == QKV_OUT_VS, "QKV epilogue map");

constexpr int RING_OFF = 0, RING_BYTES = 131072;
constexpr int LDSCTL_OFF = RING_BYTES;
constexpr int GTAB_OFF = LDSCTL_OFF + 1024;
constexpr int LDS_BYTES = 147456;
static_assert(GTAB_OFF + 1024 <= LDS_BYTES, "LDS map");

#define GAS __attribute__((address_space(1)))
#define LAS __attribute__((address_space(3)))
typedef unsigned short bf16;
typedef unsigned v4u __attribute__((ext_vector_type(4)));
typedef unsigned v2u __attribute__((ext_vector_type(2)));
typedef float f32x4 __attribute__((ext_vector_type(4)));
typedef GAS unsigned gu32;
#define RLX_AGENT __ATOMIC_RELAXED, __HIP_MEMORY_SCOPE_AGENT
#define LDS_WAIT() asm volatile("s_waitcnt lgkmcnt(0)" ::: "memory")
#define VM_WAIT() asm volatile("s_waitcnt vmcnt(0)" ::: "memory")
typedef float f32x2_t __attribute__((ext_vector_type(2))); typedef __bf16 bf16x2_t __attribute__((ext_vector_type(2)));
__device__ __forceinline__ unsigned pk2(float lo, float hi) { f32x2_t v = {lo, hi}; bf16x2_t b = __builtin_convertvector(v, bf16x2_t); return __builtin_bit_cast(unsigned, b); }
__device__ __forceinline__ float wave_sum(float v) {
#pragma unroll
    for (int o = 1; o < 64; o <<= 1) v += __shfl_xor(v, o);
    return v;
}
#define XB_TMO      128
#define XB_XCNT(j)  (256  + 64 * (j))
#define XB_XSUB(j)  (1280 + 64 * (j))
#define XB_XGEN(j)  (2304 + 64 * (j))
#define XB_TOP      3328
#define XB_TOPGEN   3392
#define XCD_BAR_WORDS 3456
#define XB_SPIN_CAP (1u << 18)

__device__ __forceinline__ unsigned xb_ld(unsigned* p)              { return __hip_atomic_load(p, __ATOMIC_RELAXED, __HIP_MEMORY_SCOPE_AGENT); }
__device__ __forceinline__ unsigned xb_add(unsigned* p, unsigned v) { return __hip_atomic_fetch_add(p, v, __ATOMIC_RELAXED, __HIP_MEMORY_SCOPE_AGENT); }
__device__ __forceinline__ unsigned xb_xcc_id() { return (unsigned)__builtin_amdgcn_s_getreg((3 << 11) | 20) & 0xFu; }
#define XB_SPIN(cond, bar) do { unsigned _sp = 0; while (cond) { __builtin_amdgcn_s_sleep(1); \
    if ((++_sp & 255u) == 0u) { if (xb_ld(&(bar)[XB_TMO])) break; if (_sp > XB_SPIN_CAP) { atomicAdd(&(bar)[XB_TMO], 1u); break; } } } } while (0)

struct XcdBarrier {
    unsigned* bar; unsigned x;
    volatile LAS unsigned* st;
};

__device__ __forceinline__ XcdBarrier xcd_barrier_post(unsigned* bar, volatile LAS unsigned* st) {
    XcdBarrier b; b.bar = bar; b.x = xb_xcc_id(); b.st = st;
    if (threadIdx.x == 0) (void)xb_add(&bar[XB_XCNT(b.x)], 1u);
    return b;
}
__device__ __forceinline__ void xcd_barrier_complete(unsigned* bar, unsigned x, unsigned& nloc, unsigned& nx) {
    const unsigned G = gridDim.x * gridDim.y * gridDim.z;
    unsigned sum, cnt, mine, sp = 0u;
    for (;;) {
        sum = 0u; cnt = 0u; mine = 0u;
#pragma unroll
        for (unsigned j = 0; j < 16; ++j) { const unsigned c = xb_ld(&bar[XB_XCNT(j)]); sum += c; cnt += (c > 0u) ? 1u : 0u; mine = (j == x) ? c : mine; }
        if (sum == G) break;
        __builtin_amdgcn_s_sleep(1);
        if ((++sp & 255u) == 0u) { if (xb_ld(&bar[XB_TMO])) break; if (sp > XB_SPIN_CAP) { atomicAdd(&bar[XB_TMO], 1u); break; } }
    }
    nloc = mine > 0u ? mine : 1u; nx = cnt > 0u ? cnt : 1u;
}

__device__ __forceinline__ void xcd_barrier(const XcdBarrier& b) {
    asm volatile("s_waitcnt vmcnt(0)" ::: "memory");
    __syncthreads();
    if (threadIdx.x == 0) {
        unsigned* bar = b.bar;
        __builtin_amdgcn_s_waitcnt(0);
        unsigned nloc = b.st[0], nx = b.st[1];
        if (nloc == 0u) { xcd_barrier_complete(bar, b.x, nloc, nx); b.st[0] = nloc; b.st[1] = nx; }
        const unsigned old = xb_add(&bar[XB_XSUB(b.x)], 1u);
        const unsigned gen = old / nloc;
        if (old + 1u == (gen + 1u) * nloc) {
            __builtin_amdgcn_fence(__ATOMIC_RELEASE, "agent");
            asm volatile("s_waitcnt vmcnt(0)" ::: "memory");
            const unsigned og = xb_add(&bar[XB_TOP], 1u);
            const unsigned tg = og / nx;
            if (og + 1u == (tg + 1u) * nx) xb_add(&bar[XB_TOPGEN], 1u);
            else XB_SPIN(xb_ld(&bar[XB_TOPGEN]) == tg, bar);
            __builtin_amdgcn_fence(__ATOMIC_ACQUIRE, "agent");
            xb_add(&bar[XB_XGEN(b.x)], 1u);
            asm volatile("s_waitcnt vmcnt(0)" ::: "memory");
        } else {
            XB_SPIN(xb_ld(&bar[XB_XGEN(b.x)]) == gen, bar);
            __builtin_amdgcn_fence(__ATOMIC_ACQUIRE, "agent");
            asm volatile("s_waitcnt vmcnt(0)" ::: "memory");
        }
    }
    __syncthreads();
}
namespace att {
typedef short bf16x8 __attribute__((ext_vector_type(8)));
typedef short s16x4 __attribute__((ext_vector_type(4)));
typedef short v4i16_t __attribute__((ext_vector_type(4)));
typedef float f32x16 __attribute__((ext_vector_type(16)));
typedef LAS unsigned char* lptr;
constexpr float LOG2E = 1.4426950408889634f;
constexpr float QSCALE = 0.08838834764831845f * 1.4426950408889634f;
constexpr float SB_DONE = -150.0f;

__device__ __forceinline__ s16x4 vtr(const LAS unsigned char* p) { return __builtin_bit_cast(s16x4, __builtin_amdgcn_ds_read_tr16_b64_v4i16((LAS v4i16_t*)p)); }
__device__ __forceinline__ float swap_lo(float x, float& other_hi) { auto rr = __builtin_amdgcn_permlane32_swap(__float_as_uint(x), __float_as_uint(x), false, false); other_hi = __uint_as_float(rr[1]); return __uint_as_float(rr[0]); }

template <int KW, int VW, int TK> struct KVStage {
    static constexpr int KBYTES = TK * KW * 2, VBYTES = TK * VW * 2, BUF = KBYTES + VBYTES, NK = KBYTES / 8192, NV = VBYTES / 8192, VDB = TK * 64  ;
    unsigned voffK[NK], voffV[NV];
    __device__ __forceinline__ void init(int wid, int lane) {
#pragma unroll
        for (int j = 0; j < NK; ++j) { const int pos = (wid * NK + j) * 64 + lane; int row, c16;
            if (KW == 128) { row = pos >> 4; c16 = (pos & 15) ^ (row & 15); } else { row = pos >> 5; c16 = ((pos >> 4) & 1) * 16 + ((pos & 15) ^ (row & 15)); }
            voffK[j] = (unsigned)(row * D + c16 * 8) * 2u; }
#pragma unroll
        for (int j = 0; j < NV; ++j) { const int pos = (wid * NV + j) * 64 + lane; const int dblk = pos / (TK * 4), row = (pos >> 2) % TK, sub = pos & 3;
            voffV[j] = (unsigned)(row * D + (dblk * 4 + sub) * 8) * 2u; }
    }
    __device__ __forceinline__ void issue(lptr buf, const bf16* kp, const bf16* vp, int wid) const {
#pragma unroll
        for (int j = 0; j < NK; ++j) __builtin_amdgcn_global_load_lds((const unsigned*)((const char*)kp + voffK[j]), (LAS unsigned*)(buf + (wid * NK + j) * 1024), 16, 0, 0);
#pragma unroll
        for (int j = 0; j < NV; ++j) __builtin_amdgcn_global_load_lds((const unsigned*)((const char*)vp + voffV[j]), (LAS unsigned*)(buf + KBYTES + (wid * NV + j) * 1024), 16, 0, 0);
    }
};

template <int KPITCH> __device__ __forceinline__ void qkt1(f32x16& p, const LAS unsigned char* Kb, int mp, const bf16x8* qr, int r32, int hi) {
    const int xk = (r32 & 15) << 4; const LAS unsigned char* k0 = Kb + r32 * KPITCH + mp * 256;
#pragma unroll
    for (int ks = 0; ks < 8; ++ks) { const int cb = (ks * 32 + hi * 16) ^ xk;
        const bf16x8 a0 = *(const LAS bf16x8*)(k0 + cb);
        p = __builtin_amdgcn_mfma_f32_32x32x16_bf16(a0, qr[ks], p, 0, 0, 0); }
}
template <int NDB, int NS, int VDB> __device__ __forceinline__ void pv(f32x16* o, const LAS unsigned char* Vb, int lane, const bf16x8* pf) {
    const LAS unsigned char* vb = Vb + (4 * (lane >> 5) + ((lane & 15) >> 2)) * 64 + ((lane >> 4) & 1) * 32 + (lane & 3) * 8;
#pragma unroll
    for (int db = 0; db < NDB; ++db)
#pragma unroll
        for (int s = 0; s < NS; ++s) { const s16x4 lo = vtr(vb + db * VDB + s * 1024), hi4 = vtr(vb + db * VDB + s * 1024 + 512);
            const bf16x8 vf = (bf16x8){lo[0], lo[1], lo[2], lo[3], hi4[0], hi4[1], hi4[2], hi4[3]};
            o[db] = __builtin_amdgcn_mfma_f32_32x32x16_bf16(vf, pf[s], o[db], 0, 0, 0);
            if (NDB == 8 && (db & 1) == 1 && s == NS - 1) __builtin_amdgcn_sched_barrier(0); }
}
__device__ __forceinline__ void pack_p(bf16x8* pf, const f32x16& p) {
#pragma unroll
    for (int s = 0; s < 2; ++s) { v4u a;
        a.x = pk2(p[8 * s + 0], p[8 * s + 1]); a.y = pk2(p[8 * s + 2], p[8 * s + 3]); a.z = pk2(p[8 * s + 4], p[8 * s + 5]); a.w = pk2(p[8 * s + 6], p[8 * s + 7]);
        pf[s] = __builtin_bit_cast(bf16x8, a); }
}

template <bool SAMPLE>
__device__ __forceinline__ void sb_unit(lptr ring, volatile LAS int* flags, const bf16* Qb, const bf16* Kb, const bf16* Vb, const bf16* CK, const bf16* CV, bf16* Ob,
                                        int b, int h, int qb, int wid, int lane) {
    KVStage<128, 128, 64> st; st.init(wid, lane);
    constexpr int BUF = KVStage<128, 128, 64>::BUF, KBYTES = KVStage<128, 128, 64>::KBYTES;
    const int r32 = lane & 31, hi = lane >> 5;
    const int qbase = SAMPLE ? PAST : 256 * qb + 32 * wid;
    const int qpos = qbase + r32;
    const size_t qrow = SAMPLE ? (size_t)(MP + 16 * b + r32) : (size_t)b * SEQ + qpos;
    const bool live = SAMPLE ? (wid == 0) : true;
    const bool rvalid = SAMPLE ? (wid == 0 && r32 < 16) : true;
    const int jt_hi = SAMPLE ? 32 : 4 * qb + 3;
    const int coff = h * 128;
    bf16x8 qr[8];
#pragma unroll
    for (int ks = 0; ks < 8; ++ks) qr[ks] = *(const bf16x8*)(Qb + qrow * D + coff + ks * 16 + hi * 8);
    f32x16 o[4];
#pragma unroll
    for (int i = 0; i < 4; ++i) o[i] = f32x16{};
    float C = 0.f;
#define SB_TILE_PTRS(jt_, kp_, vp_) do { size_t off_; \
        if (!SAMPLE) { off_ = ((size_t)b * SEQ + 64 * (size_t)(jt_)) * D + coff; kp_ = Kb + off_; vp_ = Vb + off_; } \
        else if ((jt_) == 32) { off_ = (size_t)(MP + 16 * b) * D + coff; kp_ = Kb + off_; vp_ = Vb + off_; } \
        else { off_ = ((size_t)b * PAST + 64 * (size_t)(jt_)) * D + coff; kp_ = CK + off_; vp_ = CV + off_; } } while (0)
    int jt = jt_hi, it = 0;
    { const bf16 *kp, *vp; SB_TILE_PTRS(jt, kp, vp); st.issue(ring, kp, vp, wid); }
    VM_WAIT(); __syncthreads();
    bool wdone = !live;
    for (;;) {
        const lptr cur = ring + (it & 1) * BUF, nxt = ring + ((it & 1) ^ 1) * BUF;
        const bool has_next = jt > 0;
        if (has_next) { const bf16 *kp, *vp; SB_TILE_PTRS(jt - 1, kp, vp); st.issue(nxt, kp, vp, wid); }
        const int kmin = 64 * jt;
        if (!wdone && kmin < qbase + 31) {
            f32x16 p0 = f32x16{}, p1 = f32x16{};
            qkt1<256>(p0, cur, 0, qr, r32, hi); qkt1<256>(p1, cur + 32 * 256, 0, qr, r32, hi);
            f32x16 L0, L1;
#pragma unroll
            for (int r = 0; r < 16; ++r) {
                const float z0 = p0[r], z1 = p1[r];
                L0[r] = -(fmaxf(z0, 0.f) + __builtin_amdgcn_logf(1.0f + __builtin_amdgcn_exp2f(-fabsf(z0))));
                L1[r] = -(fmaxf(z1, 0.f) + __builtin_amdgcn_logf(1.0f + __builtin_amdgcn_exp2f(-fabsf(z1)))); }
            const bool need_mask = (kmin + 63 >= qbase);
            if (need_mask) {
                const float df = (float)(qpos - kmin - 4 * hi);
#pragma unroll
                for (int r = 0; r < 16; ++r) { const float c = (float)((r & 3) + 8 * (r >> 2));
                    const float f0 = __builtin_amdgcn_fmed3f(df - c, 0.f, 1.f), f1 = __builtin_amdgcn_fmed3f(df - (c + 32.f), 0.f, 1.f);
                    L0[r] *= f0; p0[r] += f0 * 1e30f - 1e30f; L1[r] *= f1; p1[r] += f1 * 1e30f - 1e30f; } }
            float T[8];
#pragma unroll
            for (int g = 0; g < 4; ++g) {
                L0[4 * g + 2] += L0[4 * g + 3]; L0[4 * g + 1] += L0[4 * g + 2]; L0[4 * g] += L0[4 * g + 1]; T[g] = L0[4 * g];
                L1[4 * g + 2] += L1[4 * g + 3]; L1[4 * g + 1] += L1[4 * g + 2]; L1[4 * g] += L1[4 * g + 1]; T[4 + g] = L1[4 * g]; }
            float off[8]; float run = 0.f;
#pragma unroll
            for (int g = 7; g >= 0; --g) { float t1; const float t0 = swap_lo(T[g], t1); off[g] = C + run + (hi == 0 ? t1 : 0.f); run += t0 + t1; }
#pragma unroll
            for (int g = 0; g < 4; ++g)
#pragma unroll
                for (int i = 0; i < 4; ++i) { const int r = 4 * g + i;
                    p0[r] = __builtin_amdgcn_exp2f(p0[r] + L0[r] + off[g]);
                    p1[r] = __builtin_amdgcn_exp2f(p1[r] + L1[r] + off[4 + g]); }
            C += run;
            bf16x8 pf[4]; pack_p(pf, p0); pack_p(pf + 2, p1);
            pv<4, 4, 4096>(o, cur + KBYTES, lane, pf);
            wdone = __all((!rvalid) || (C < SB_DONE));
        }
        if (lane == 0) flags[(it & 1) * 8 + wid] = wdone ? 1 : 0;
        VM_WAIT(); LDS_WAIT(); __syncthreads();
        if (!has_next) break;
        int all = 1;
#pragma unroll
        for (int w = 0; w < 8; ++w) all &= flags[(it & 1) * 8 + w];
        if (all) break;
        --jt; ++it;
    }
#undef SB_TILE_PTRS
    if (rvalid) {
#pragma unroll
        for (int db = 0; db < 4; ++db)
#pragma unroll
            for (int gq = 0; gq < 4; ++gq) { v2u w; w.x = pk2(o[db][4 * gq], o[db][4 * gq + 1]); w.y = pk2(o[db][4 * gq + 2], o[db][4 * gq + 3]);
                *(v2u*)(Ob + qrow * D + coff + 32 * db + 8 * gq + 4 * hi) = w; }
    }
}

template <bool SAMPLE>
__device__ __forceinline__ void diff_unit(lptr ring, const LAS float* gtab, const bf16* Qb, const bf16* Kb, const bf16* Vb, const bf16* CK, const bf16* CV, bf16* Ob,
                                          int b, int h8, int qb, float lam, int wid, int lane) {
    asm volatile("" : "+v"(lane));
    KVStage<256, 256, 32> st; st.init(wid, lane);
    constexpr int BUF = KVStage<256, 256, 32>::BUF, KBYTES = KVStage<256, 256, 32>::KBYTES, VDB = KVStage<256, 256, 32>::VDB;
    const int r32 = lane & 31, hi = lane >> 5, mp = wid >> 2, sb = wid & 3;
    const int qbase = SAMPLE ? PAST : 128 * qb + 32 * sb;
    const int qpos = qbase + r32;
    const size_t qrow = SAMPLE ? (size_t)(MP + 16 * b + r32) : (size_t)b * SEQ + qpos;
    const bool live = SAMPLE ? (sb == 0) : true;
    const bool rvalid = SAMPLE ? (sb == 0 && r32 < 16) : true;
    const int wchunk = SAMPLE ? 32 : (qbase >> 6);
    const int jt_hi = SAMPLE ? 64 : 4 * qb + 3;
    const int coff = h8 * 256;
    const float slope2 = __builtin_amdgcn_exp2f(-(float)(h8 + 1)) * LOG2E;
    const int xk = (r32 & 15) << 4;
    const lptr qs = ring + 65536 + wid * 8192 + lane * 16;
#pragma unroll
    for (int ks = 0; ks < 8; ++ks) *(LAS bf16x8*)(qs + ks * 1024) = *(const bf16x8*)(Qb + qrow * D + coff + mp * 128 + ks * 16 + hi * 8);
    f32x16 o[8];
#pragma unroll
    for (int i = 0; i < 8; ++i) o[i] = f32x16{};
    float m = -INFINITY, l = 0.f;
#define DF_TILE_PTRS(jt_, kp_, vp_) do { size_t off_; \
        if (!SAMPLE) { off_ = ((size_t)b * SEQ + 32 * (size_t)(jt_)) * D + coff; kp_ = Kb + off_; vp_ = Vb + off_; } \
        else if ((jt_) == 64) { off_ = (size_t)(MP + 16 * b) * D + coff; kp_ = Kb + off_; vp_ = Vb + off_; } \
        else { off_ = ((size_t)b * PAST + 32 * (size_t)(jt_)) * D + coff; kp_ = CK + off_; vp_ = CV + off_; } } while (0)
    { const bf16 *kp, *vp; DF_TILE_PTRS(jt_hi, kp, vp); st.issue(ring, kp, vp, wid); }
    VM_WAIT(); LDS_WAIT(); __syncthreads();
    int it = 0;
    for (int jt = jt_hi; jt >= 0; --jt, ++it) {
        const lptr cur = ring + (it & 1) * BUF, nxt = ring + ((it & 1) ^ 1) * BUF;
        if (jt > 0) { const bf16 *kp, *vp; DF_TILE_PTRS(jt - 1, kp, vp); st.issue(nxt, kp, vp, wid); }
        if (live && (jt >> 1) <= wchunk) {
            f32x16 p = f32x16{};
            { const LAS unsigned char* k0 = cur + r32 * 512 + mp * 256;
#pragma unroll
              for (int ks = 0; ks < 8; ++ks) { const int cb = (ks * 32 + hi * 16) ^ xk;
                  p = __builtin_amdgcn_mfma_f32_32x32x16_bf16(*(const LAS bf16x8*)(k0 + cb), *(const LAS bf16x8*)(qs + ks * 1024), p, 0, 0, 0); } }
            const float dqf = (float)(qpos - 32 * jt - 4 * hi);
#pragma unroll
            for (int r = 0; r < 16; ++r) { const float c = (float)((r & 3) + 8 * (r >> 2)); p[r] = fmaf(-slope2, fabsf(dqf - c), p[r]); }
            if (SAMPLE && jt == 64) {
#pragma unroll
                for (int r = 8; r < 16; ++r) p[r] = -INFINITY; }
            float tm = p[0];
#pragma unroll
            for (int r = 1; r < 16; ++r) tm = fmaxf(tm, p[r]);
            { float t1; const float t0 = swap_lo(tm, t1); tm = fmaxf(t0, t1); }
            if (__any(tm > m)) { const float mn = fmaxf(m, tm); const float alpha = __builtin_amdgcn_exp2f(m - mn); m = mn; l *= alpha;
#pragma unroll
                for (int db = 0; db < 8; ++db)
#pragma unroll
                    for (int r = 0; r < 16; ++r) o[db][r] *= alpha; }
            float ps = 0.f;
#pragma unroll
            for (int r = 0; r < 16; ++r) { p[r] = __builtin_amdgcn_exp2f(p[r] - m); ps += p[r]; }
            l += ps;
            bf16x8 pf[2]; pack_p(pf, p);
            pv<8, 2, VDB>(o, cur + KBYTES, lane, pf);
        }
        VM_WAIT(); LDS_WAIT(); __syncthreads();
    }
#undef DF_TILE_PTRS
    { float t1; const float t0 = swap_lo(l, t1); l = t0 + t1; }
    const float inv = live ? 1.0f / l : 0.f;
    const lptr xb = ring + sb * 32768 + lane * 16;
    if (mp == 1) { const float sc = lam * inv;
#pragma unroll
        for (int v = 0; v < 32; ++v) { const int db = v >> 2, gq = v & 3; f32x4 x = {o[db][4 * gq] * sc, o[db][4 * gq + 1] * sc, o[db][4 * gq + 2] * sc, o[db][4 * gq + 3] * sc};
            *(LAS f32x4*)(xb + v * 1024) = x; } }
    LDS_WAIT(); __syncthreads();
    if (mp == 0) { float ss = 0.f;
#pragma unroll
        for (int v = 0; v < 32; ++v) { const int db = v >> 2, gq = v & 3; const f32x4 x = *(const LAS f32x4*)(xb + v * 1024);
#pragma unroll
            for (int e = 0; e < 4; ++e) { const float y = o[db][4 * gq + e] * inv - x[e]; o[db][4 * gq + e] = y; ss += y * y; }
            if ((v & 3) == 3) asm volatile("" ::: "memory"); }
        { float t1; const float t0 = swap_lo(ss, t1); ss = t0 + t1; }
        const float rs = 1.0f / sqrtf(ss * (1.0f / 256.0f) + 1e-5f);
        if (rvalid) {
#pragma unroll
            for (int v = 0; v < 32; ++v) { const int db = v >> 2, gq = v & 3; const int d0 = 32 * db + 8 * gq + 4 * hi; const f32x4 g4 = *(const LAS f32x4*)(gtab + d0);
                v2u w; w.x = pk2(o[db][4 * gq] * rs * g4[0], o[db][4 * gq + 1] * rs * g4[1]); w.y = pk2(o[db][4 * gq + 2] * rs * g4[2], o[db][4 * gq + 3] * rs * g4[3]);
                *(v2u*)(Ob + qrow * D + coff + d0) = w;
                if ((v & 3) == 3) asm volatile("" ::: "memory"); } }
    }
    LDS_WAIT(); __syncthreads();
}
}
__device__ __forceinline__ void transpose_item(const float* W, int K, int N, bf16* WT, LAS float* scr, int item, int lane) {
    const int nblk = N / 32, kb = item / nblk, nb = item % nblk, k0 = 64 * kb, n0 = 32 * nb;
#pragma unroll 8
    for (int i = 0; i < 32; ++i) { const int kk = 2 * i + (lane >> 5); scr[kk * 33 + (lane & 31)] = W[(size_t)(k0 + kk) * N + n0 + (lane & 31)]; }
    LDS_WAIT(); asm volatile("" ::: "memory");
    const int c = lane & 7;
#pragma unroll
    for (int j = 0; j < 4; ++j) { const int n = (lane >> 3) + 8 * j; const LAS float* s = scr + (8 * c) * 33 + n;
        v4u o; o.x = pk2(s[0 * 33], s[1 * 33]); o.y = pk2(s[2 * 33], s[3 * 33]); o.z = pk2(s[4 * 33], s[5 * 33]); o.w = pk2(s[6 * 33], s[7 * 33]);
        *(v4u*)(WT + (size_t)(n0 + n) * K + k0 + 8 * c) = o; }
    LDS_WAIT(); asm volatile("" ::: "memory");
}
__device__ __forceinline__ void xn_rows(const float* srcp, const float* srcs, const float* g, bf16* XN, int gw, int NGW, int lane) {
    for (int m = gw; m < M; m += NGW) {
        v2u* o8 = (v2u*)(XN + (size_t)m * D) + lane;
        if (m < MV) {
            const f32x4* xr = (const f32x4*)(m < MP ? srcp + (size_t)m * D : srcs + (size_t)(m - MP) * D) + lane;
            f32x4 v[8]; float ss = 0.f;
#pragma unroll
            for (int j = 0; j < 8; ++j) { v[j] = xr[64 * j]; ss += (v[j].x * v[j].x + v[j].y * v[j].y) + (v[j].z * v[j].z + v[j].w * v[j].w); }
            const float rs = 1.0f / sqrtf(wave_sum(ss) * (1.0f / D) + 1e-6f);
#pragma unroll
            for (int j = 0; j < 8; ++j) { const f32x4 gv = ((const f32x4*)g)[lane + 64 * j]; v2u w; w.x = pk2(v[j].x * rs * gv.x, v[j].y * rs * gv.y); w.y = pk2(v[j].z * rs * gv.z, v[j].w * rs * gv.w); o8[64 * j] = w; }
        } else {
#pragma unroll
            for (int j = 0; j < 8; ++j) o8[64 * j] = (v2u){0u, 0u};
        }
    }
}
__device__ __forceinline__ void final_rows(float* X, const float* g, int gw, int NGW, int lane) {
    for (int m = gw; m < MV; m += NGW) {
        f32x4* xr = (f32x4*)(X + (size_t)m * D) + lane;
        f32x4 v[8]; float ss = 0.f;
#pragma unroll
        for (int j = 0; j < 8; ++j) { v[j] = xr[64 * j]; ss += (v[j].x * v[j].x + v[j].y * v[j].y) + (v[j].z * v[j].z + v[j].w * v[j].w); }
        const float rs = 1.0f / sqrtf(wave_sum(ss) * (1.0f / D) + 1e-6f);
#pragma unroll
        for (int j = 0; j < 8; ++j) { const f32x4 gv = ((const f32x4*)g)[lane + 64 * j]; xr[64 * j] = (v[j] * rs) * gv; }
    }
}
__device__ __forceinline__ void cache_convert(const float* ck, const float* cv, bf16* CK, bf16* CV, size_t gt, size_t NT) {
    constexpr size_t NCH = (size_t)DEC_B * PAST * D / 8;
    for (size_t i = gt; i < 2 * NCH; i += NT) { const bool t = i >= NCH; const size_t c = t ? i - NCH : i;
        const f32x4* s = (const f32x4*)((t ? cv : ck) + c * 8); const f32x4 a = s[0], b2 = s[1];
        v4u o; o.x = pk2(a.x, a.y); o.y = pk2(a.z, a.w); o.z = pk2(b2.x, b2.y); o.w = pk2(b2.z, b2.w);
        *(v4u*)((t ? CV : CK) + c * 8) = o; }
}

struct Args { const float* in[16]; float* out; unsigned char* ws; int ph_lo, ph_hi; };
template <int L>
__device__ __forceinline__ void layer_phases(const Args& args, LAS unsigned char* lds, volatile LAS int* flags, LAS float* gtab, const XcdBarrier& bar, int lo, int hi, int G, int vcu, int tid, int lane, int wave) {
#define IN(k) (lo <= (k) && (k) < hi)
#define SEAM(k) do { if (ONE_LAUNCH && IN(k) && IN((k) + 1)) xcd_barrier(bar); } while (0)
    unsigned char* ws = args.ws;
    const float* x_prompt = args.in[0]; const float* x_sample = args.in[1];
    float* X = args.out + OUT_Y;
    bf16* XN = (bf16*)(ws + WS_XN); bf16* CK = (bf16*)(ws + WS_CK); bf16* CV = (bf16*)(ws + WS_CV);
    bf16* Qb = (bf16*)(ws + WS_Q); bf16* Kb = (bf16*)(ws + WS_K); bf16* Vb = (bf16*)(ws + WS_V); bf16* Hb = (bf16*)(ws + WS_H);
    const int gw = vcu * NWAVES + wave, NGW = G * NWAVES;
    const size_t gt = (size_t)vcu * (NWAVES * 64) + tid, NT = (size_t)G * (NWAVES * 64);

        const int pb = 1 + 7 * L;
        unsigned char* wl = ws + WS_W + (size_t)L * W_LAYER;
        const bf16* Wqkv_t = (const bf16*)(wl + W_QKV); const bf16* Wo_t = (const bf16*)(wl + W_O); const bf16* Wup_t = (const bf16*)(wl + W_UP); const bf16* Wdn_t = (const bf16*)(wl + W_DN);
        if (IN(pb)) {
            pg8::Gemm g{XN, Wqkv_t, M, 3 * D, D}; pg8::StaticOrder S; S.init(M, 3 * D, G, (int)blockIdx.x);
            pg8::EpiQKV E{ws, args.out, L, att::QSCALE};
            pg8::gemm_phase<pg8::EpiQKV, pg8::StaticOrder, PG8_ALIGN, PG8_SP2>(lds + RING_OFF, g, S, E);
        }
        SEAM(pb);
        if (IN(pb + 1)) {
            if (L == 0) {
                for (int u = vcu; u < 2048; u += G) att::sb_unit<false>(lds + RING_OFF, flags, Qb, Kb, Vb, CK, CV, Qb, u >> 9, (u >> 5) & 15, u & 31, wave, lane);
                for (int u = vcu; u < 128; u += G) att::sb_unit<true>(lds + RING_OFF, flags, Qb, Kb, Vb, CK, CV, Qb, u >> 4, u & 15, 0, wave, lane);
            } else {
                constexpr float LAMBDA_INIT = 0.35550906759096926f;
                float s1 = args.in[7][lane] * args.in[8][lane] + args.in[7][lane + 64] * args.in[8][lane + 64];
                float s2 = args.in[9][lane] * args.in[10][lane] + args.in[9][lane + 64] * args.in[10][lane + 64];
                s1 = wave_sum(s1); s2 = wave_sum(s2);
                const float lam = expf(s1) - expf(s2) + LAMBDA_INIT;
                if (tid < 256) gtab[tid] = args.in[11][tid] * (1.0f - LAMBDA_INIT);
                LDS_WAIT(); __syncthreads();
                for (int idx = vcu; idx < 2048; idx += G) { const int ip = 7 - (idx >> 8), v = idx & 255, grp = v >> 3, s = v & 7; const int qb = 8 * ip + ((ip & 1) ? 7 - s : s);
                    att::diff_unit<false>(lds + RING_OFF, gtab, Qb, Kb, Vb, CK, CV, Qb, grp >> 3, grp & 7, qb, lam, wave, lane); }
                for (int v = vcu; v < 64; v += G) att::diff_unit<true>(lds + RING_OFF, gtab, Qb, Kb, Vb, CK, CV, Qb, v >> 3, v & 7, 0, lam, wave, lane);
            }
        }
        SEAM(pb + 1);
        if (IN(pb + 2)) {
            pg8::Gemm g{Qb, Wo_t, M, D, D}; pg8::StaticOrder S; S.init(M, D, G, (int)blockIdx.x);
            pg8::EpiResid E{L == 0 ? x_prompt : X, L == 0 ? x_sample : X + (size_t)MP * D, X};
            pg8::gemm_phase<pg8::EpiResid, pg8::StaticOrder, PG8_ALIGN, PG8_SP2>(lds + RING_OFF, g, S, E);
        }
        SEAM(pb + 2);
        if (IN(pb + 3)) xn_rows(X, X + (size_t)MP * D, args.in[12] + (size_t)L * D, XN, gw, NGW, lane);
        SEAM(pb + 3);
        if (IN(pb + 4)) {
            pg8::Gemm g{XN, Wup_t, M, FF, D}; pg8::StaticOrder S; S.init(M, FF, G, (int)blockIdx.x);
            pg8::EpiRelu2 E{Hb, FF};
            pg8::gemm_phase<pg8::EpiRelu2, pg8::StaticOrder, PG8_ALIGN, PG8_SP2>(lds + RING_OFF, g, S, E);
        }
        SEAM(pb + 4);
        if (IN(pb + 5)) {
            pg8::Gemm g{Hb, Wdn_t, M, D, FF}; pg8::StaticOrder S; S.init(M, D, G, (int)blockIdx.x);
            pg8::EpiResid E{X, X + (size_t)MP * D, X};
            pg8::gemm_phase<pg8::EpiResid, pg8::StaticOrder, PG8_ALIGN, PG8_SP2>(lds + RING_OFF, g, S, E);
        }
        SEAM(pb + 5);
        if (IN(pb + 6)) {
            if (L == 0) { cache_convert(args.in[2] + (size_t)DEC_B * PAST * D, args.in[3] + (size_t)DEC_B * PAST * D, CK, CV, gt, NT);
                          xn_rows(X, X + (size_t)MP * D, args.in[4] + D, XN, gw, NGW, lane); }
            else final_rows(X, args.in[15], gw, NGW, lane);
        }
        if (L == 0) SEAM(pb + 6);

#undef IN
#undef SEAM
}

__global__ void __launch_bounds__(NWAVES * 64, 2) fwd_kernel(Args args) {
    extern __shared__ __attribute__((aligned(16))) unsigned char lds_raw[];
    LAS unsigned char* lds = (LAS unsigned char*)lds_raw;
    volatile LAS unsigned* MISC = (volatile LAS unsigned*)(lds + LDSCTL_OFF);
    volatile LAS int* flags = (volatile LAS int*)(lds + LDSCTL_OFF + 128);
    LAS float* gtab = (LAS float*)(lds + GTAB_OFF);
    const int tid = threadIdx.x, lane = tid & 63, wave = __builtin_amdgcn_readfirstlane(tid >> 6);
    const int G = gridDim.x; const int bx = blockIdx.x; const int vcu = (G % 8 == 0) ? (bx % 8) * (G / 8) + bx / 8 : bx;
    for (int u = tid; u < 128; u += NWAVES * 64) ((LAS unsigned*)(lds + LDSCTL_OFF))[u] = 0u;
    __syncthreads();
    unsigned char* ws = args.ws;
    gu32* ctl = (gu32*)(ws + WS_CTL);
    XcdBarrier bar; bar.bar = (unsigned*)ctl + CW_BAR; bar.x = 0; bar.st = nullptr;
    if (ONE_LAUNCH) bar = xcd_barrier_post((unsigned*)ctl + CW_BAR, MISC + 8);
    const int lo = args.ph_lo, hi = args.ph_hi;
#define IN(k) (lo <= (k) && (k) < hi)
#define SEAM(k) do { if (ONE_LAUNCH && IN(k) && IN((k) + 1)) xcd_barrier(bar); } while (0)
    const float* x_prompt = args.in[0]; const float* x_sample = args.in[1];
    float* X = args.out + OUT_Y;
    bf16* XN = (bf16*)(ws + WS_XN); bf16* CK = (bf16*)(ws + WS_CK); bf16* CV = (bf16*)(ws + WS_CV);
    bf16* Qb = (bf16*)(ws + WS_Q); bf16* Kb = (bf16*)(ws + WS_K); bf16* Vb = (bf16*)(ws + WS_V); bf16* Hb = (bf16*)(ws + WS_H);
    const int gw = vcu * NWAVES + wave, NGW = G * NWAVES;
    const size_t gt = (size_t)vcu * (NWAVES * 64) + tid, NT = (size_t)G * (NWAVES * 64);

    if (IN(0)) {
        LAS float* scr = (LAS float*)(lds + RING_OFF + wave * 16384);
        constexpr int I_QKV = (D / 64) * (3 * D / 32), I_O = (D / 64) * (D / 32), I_UP = (D / 64) * (FF / 32), I_DN = (FF / 64) * (D / 32), I_L = I_QKV + I_O + I_UP + I_DN;
        for (int it = gw; it < 2 * I_L; it += NGW) {
            const int L = it / I_L; int r = it % I_L; unsigned char* wl = ws + WS_W + (size_t)L * W_LAYER;
            if (r < I_QKV) { transpose_item(args.in[5] + (size_t)L * D * 3 * D, D, 3 * D, (bf16*)(wl + W_QKV), scr, r, lane); continue; } r -= I_QKV;
            if (r < I_O) { transpose_item(args.in[6] + (size_t)L * D * D, D, D, (bf16*)(wl + W_O), scr, r, lane); continue; } r -= I_O;
            if (r < I_UP) { transpose_item(args.in[13] + (size_t)L * D * FF, D, FF, (bf16*)(wl + W_UP), scr, r, lane); continue; } r -= I_UP;
            transpose_item(args.in[14] + (size_t)L * FF * D, FF, D, (bf16*)(wl + W_DN), scr, r, lane);
        }
        cache_convert(args.in[2], args.in[3], CK, CV, gt, NT);
        xn_rows(x_prompt, x_sample, args.in[4], XN, gw, NGW, lane);
    }
    SEAM(0);

    layer_phases<0>(args, lds, flags, gtab, bar, lo, hi, G, vcu, tid, lane, wave);
    layer_phases<1>(args, lds, flags, gtab, bar, lo, hi, G, vcu, tid, lane, wave);
#undef IN
#undef SEAM
}

extern "C" void kernel_launch(void* const* d_in, const int* in_sizes, int n_in, void* d_out, int out_size, void* d_ws, size_t ws_size, hipStream_t stream) {
    static int grid = 0;
    if (grid == 0) {
        if (n_in != 16 || (size_t)out_size != OUT_END || ws_size < WS_END) { fprintf(stderr, "kernel_launch: unexpected shapes (n_in %d out %d ws %zu)\n", n_in, out_size, ws_size); grid = -1; return; }
        int dev = 0, cus = 0;
        if (hipGetDevice(&dev) != hipSuccess || hipDeviceGetAttribute(&cus, hipDeviceAttributeMultiprocessorCount, dev) != hipSuccess) { grid = -1; return; }
        if (hipFuncSetAttribute((const void*)fwd_kernel, hipFuncAttributeMaxDynamicSharedMemorySize, LDS_BYTES) != hipSuccess) { fprintf(stderr, "kernel_launch: hipFuncSetAttribute failed\n"); grid = -1; return; }
        int per_cu = 0;
        if (hipOccupancyMaxActiveBlocksPerMultiprocessor(&per_cu, (const void*)fwd_kernel, NWAVES * 64, LDS_BYTES) != hipSuccess || per_cu < 1) fprintf(stderr, "kernel_launch: occupancy query says %d\n", per_cu);
        (void)hipGetLastError();
        grid = cus;
    }
    if (grid < 0) return;
    (void)hipMemsetAsync((char*)d_ws + WS_CTL, 0, CTL_ZERO_BYTES, stream);
    Args a{};
    for (int i = 0; i < 16; ++i) a.in[i] = (const float*)d_in[i];
    a.out = (float*)d_out; a.ws = (unsigned char*)d_ws;
    if (ONE_LAUNCH) { a.ph_lo = 0; a.ph_hi = N_PHASES; hipLaunchKernelGGL(fwd_kernel, dim3(grid), dim3(NWAVES * 64), LDS_BYTES, stream, a); }
    else for (int p = 0; p < N_PHASES; ++p) { a.ph_lo = p; a.ph_hi = p + 1; hipLaunchKernelGGL(fwd_kernel, dim3(grid), dim3(NWAVES * 64), LDS_BYTES, stream, a); }
}
```

```cpp
#include <hip/hip_runtime.h>
#include <cstdio>
#include <cstdint>
constexpr int D = 2048, BATCH = 4, SEQ = 8192, DEC_B = 8, DEC_T = 16, PAST = 2048, FF = 8192;
constexpr int MP = BATCH * SEQ;
constexpr int MS = DEC_B * DEC_T;
constexpr int MV = MP + MS;
constexpr int M = 33024;
constexpr size_t QKV_WS_Q = (size_t)451 << 20, QKV_WS_STRIDE = (size_t)129 << 20;
constexpr size_t QKV_OUT_KP = (size_t)MV * D, QKV_OUT_VP = QKV_OUT_KP + 2 * (size_t)MP * D, QKV_OUT_KS = QKV_OUT_VP + 2 * (size_t)MP * D, QKV_OUT_VS = QKV_OUT_KS + 2 * (size_t)MS * D;
namespace pg8 {
#define PG8_LAS __attribute__((address_space(3)))
typedef unsigned short bf16_t;
typedef short bf16x8 __attribute__((ext_vector_type(8)));
typedef float f32x4 __attribute__((ext_vector_type(4)));
typedef unsigned u32x4 __attribute__((ext_vector_type(4)));
constexpr int BM = 256, BK = 64, HALF = 128, HTB = HALF * BK * 2  , STAGE_BYTES = 8 * HTB, NXCD = 8, WGM = 8;

__host__ __device__ __forceinline__ int lds_byte(int r, int c) { const int st = (r >> 4) * 2 + (c >> 5), rr = r & 15, cc = c & 31, ob = rr * 64 + cc * 2; return st * 1024 + (ob ^ (((ob >> 9) & 1) << 5)); }
__host__ __device__ __forceinline__ void stage_rc(int b, int& R, int& C) { const int st = b / 1024, sb = b % 1024, swz = sb ^ (((sb >> 9) & 1) << 5); R = (st >> 1) * 16 + swz / 64; C = (st & 1) * 32 + (swz % 64) / 2; }
__host__ __device__ __forceinline__ int perm32(int rho) { const int n = rho >> 4, i = rho & 15; return 8 * (i >> 2) + 4 * n + (i & 3); }

struct Unit { int pm, pn; };
struct Gemm { const bf16_t* A; const bf16_t* Bt; int M, N, K; };

struct StaticOrder {
    int nM, nN, nwg, G, c;
    __host__ __device__ void init(int M, int N, int G_, int c_) { nM = M / BM; nN = N / BM; nwg = nM * nN; G = G_; c = c_; }
    __host__ __device__ bool next(int i, Unit& u) const {
        const long L = (long)i * G + c; if (L >= nwg) return false;
        int wgid = (int)L; { const int q = nwg / NXCD, r = nwg % NXCD, xcd = wgid % NXCD, off = wgid / NXCD; wgid = (xcd < r ? xcd * (q + 1) : r * (q + 1) + (xcd - r) * q) + off; }
        const int nig = WGM * nN, gid = wgid / nig, fm = gid * WGM, gsz = (nM - fm) < WGM ? (nM - fm) : WGM;
        u.pm = fm + ((wgid % nig) % gsz); u.pn = (wgid % nig) / gsz; return true;
    }
    __device__ __forceinline__ void a_ready(const Unit&) const {}
    __device__ __forceinline__ void done(const Unit&) const {}
};

__device__ __forceinline__ unsigned cvt_pk_bf16(float lo, float hi) { unsigned r; asm volatile("v_cvt_pk_bf16_f32 %0, %1, %2" : "=v"(r) : "v"(lo), "v"(hi)); return r; }
typedef float f32x2 __attribute__((ext_vector_type(2)));
typedef unsigned u32x2 __attribute__((ext_vector_type(2)));
struct EpiQKV {
    static constexpr bool PERM = true, AFTER_DRAIN = false;
    unsigned char* ws; float* out; int L; float qscale;
    __device__ __forceinline__ void operator()(const f32x4 (&acc)[2][2][4][2], const Unit& u, int wr, int wc, int fr, int fq) const {
        const int row0 = u.pm * BM + wr * 64 + fr; const int t = u.pn >> 3; const int col0 = (u.pn & 7) * BM + wc * 32 + 8 * fq;
        bf16_t* ob = (bf16_t*)(ws + QKV_WS_Q + (size_t)t * QKV_WS_STRIDE);
        float* fp = out + (t == 1 ? QKV_OUT_KP : QKV_OUT_VP) + (size_t)L * MP * D; float* fs = out + (t == 1 ? QKV_OUT_KS : QKV_OUT_VS) + (size_t)L * MS * D;
        const float sc = t == 0 ? qscale : 1.f;
#pragma unroll
        for (int ai = 0; ai < 2; ++ai)
#pragma unroll
            for (int m = 0; m < 4; ++m) { const int row = row0 + ai * HALF + m * 16;
                float* frow = nullptr; if (t != 0) { if (row < MP) frow = fp + (size_t)row * D; else if (row < MV) frow = fs + (size_t)(row - MP) * D; }
                bf16_t* rowp = ob + (size_t)row * D + col0;
#pragma unroll
                for (int bj = 0; bj < 2; ++bj) { const f32x4 v0 = acc[ai][bj][m][0], v1 = acc[ai][bj][m][1];
                    u32x4 w; w.x = cvt_pk_bf16(v0[0] * sc, v0[1] * sc); w.y = cvt_pk_bf16(v0[2] * sc, v0[3] * sc); w.z = cvt_pk_bf16(v1[0] * sc, v1[1] * sc); w.w = cvt_pk_bf16(v1[2] * sc, v1[3] * sc);
                    *(u32x4*)(rowp + bj * HALF) = w;
                    if (frow) { *(f32x4*)(frow + col0 + bj * HALF) = v0; *(f32x4*)(frow + col0 + bj * HALF + 4) = v1; } } }
    }
};
struct EpiResid {
    static constexpr bool PERM = false, AFTER_DRAIN = false;
    const float* rp; const float* rs; float* out;
    __device__ __forceinline__ void operator()(const f32x4 (&acc)[2][2][4][2], const Unit& u, int wr, int wc, int fr, int fq) const {
        const int col0 = u.pn * BM + wc * 32 + 4 * fq;
#pragma unroll
        for (int ai = 0; ai < 2; ++ai)
#pragma unroll
            for (int m = 0; m < 4; ++m) { const int row = u.pm * BM + ai * HALF + wr * 64 + m * 16 + fr;
                if (row < MV) { const float* r = row < MP ? rp + (size_t)row * D : rs + (size_t)(row - MP) * D; float* o = out + (size_t)row * D;
#pragma unroll
                    for (int bj = 0; bj < 2; ++bj)
#pragma unroll
                        for (int n = 0; n < 2; ++n) { const int c = col0 + bj * HALF + n * 16; *(f32x4*)(o + c) = *(const f32x4*)(r + c) + acc[ai][bj][m][n]; } } }
    }
};
struct EpiRelu2 {
    static constexpr bool PERM = true, AFTER_DRAIN = false;
    bf16_t* O; int ldc;
    __device__ __forceinline__ void operator()(const f32x4 (&acc)[2][2][4][2], const Unit& u, int wr, int wc, int fr, int fq) const {
        const int row0 = u.pm * BM + wr * 64 + fr, col0 = u.pn * BM + wc * 32 + 8 * fq;
#pragma unroll
        for (int ai = 0; ai < 2; ++ai)
#pragma unroll
            for (int m = 0; m < 4; ++m) { bf16_t* rowp = O + (size_t)(row0 + ai * HALF + m * 16) * ldc + col0;
#pragma unroll
                for (int bj = 0; bj < 2; ++bj) { f32x4 v0 = acc[ai][bj][m][0], v1 = acc[ai][bj][m][1];
#pragma unroll
                    for (int e = 0; e < 4; ++e) { const float a = fmaxf(v0[e], 0.f), b = fmaxf(v1[e], 0.f); v0[e] = a * a; v1[e] = b * b; }
                    u32x4 w; w.x = cvt_pk_bf16(v0[0], v0[1]); w.y = cvt_pk_bf16(v0[2], v0[3]); w.z = cvt_pk_bf16(v1[0], v1[1]); w.w = cvt_pk_bf16(v1[2], v1[3]);
                    *(u32x4*)(rowp + bj * HALF) = w; } }
    }
};
template <class Epi, class Sched, bool ALIGN_EPI = false, bool SP2 = false>
__device__ __forceinline__ void gemm_phase(PG8_LAS unsigned char* lds, const Gemm g, const Sched& S, const Epi& E) {
    const int tid = threadIdx.x, wid = __builtin_amdgcn_readfirstlane(tid >> 6), lane = tid & 63, wr = wid >> 2, wc = wid & 3, fr = lane & 15, fq = lane >> 4;
    const int K = g.K, nt = K / BK;
    unsigned voffA[2], voffB[2];
#pragma unroll
    for (int i = 0; i < 2; ++i) { int R, C; stage_rc(tid * 16 + i * 8192, R, C); const int Rb = Epi::PERM ? ((R & ~31) + perm32(R & 31)) : R;
        voffA[i] = (unsigned)(R * K + C) * 2u; voffB[i] = (unsigned)(Rb * K + C) * 2u; }
    const size_t kstep = (size_t)(BK * 2);
    const size_t hstep = (size_t)HALF * K * 2;
    const size_t tstep = 2 * hstep;
    const unsigned ldsw = (unsigned)wid * 1024u;
    const int aoff = lds_byte(wr * 64 + fr, fq * 8), boff = lds_byte(wc * 32 + fr, fq * 8);
#define PG8_SA(b, h) (((b) * 2 + (h)) * HTB)
#define PG8_SB(b, h) ((4 + (b) * 2 + (h)) * HTB)
#define PG8_STAGE(bufoff, gbase, voff) do { _Pragma("unroll") for (int _i = 0; _i < 2; ++_i) \
        __builtin_amdgcn_global_load_lds((const unsigned*)((const char*)(gbase) + (voff)[_i]), (PG8_LAS unsigned*)(lds + (bufoff) + ldsw + _i * 8192), 16, 0, 0); } while (0)
#define PG8_LDA(dst, b, h) do { _Pragma("unroll") for (int m = 0; m < 4; ++m) _Pragma("unroll") for (int k = 0; k < 2; ++k) dst[m][k] = *(const PG8_LAS bf16x8*)(lds + PG8_SA(b, h) + aoff + m * 2048 + k * 1024); } while (0)
#define PG8_LDB(dst, b, h) do { _Pragma("unroll") for (int n = 0; n < 2; ++n) _Pragma("unroll") for (int k = 0; k < 2; ++k) dst[n][k] = *(const PG8_LAS bf16x8*)(lds + PG8_SB(b, h) + boff + n * 2048 + k * 1024); } while (0)
#define PG8_MMA(ai, bj, At, Bt) do { __builtin_amdgcn_s_setprio(1); _Pragma("unroll") for (int m = 0; m < 4; ++m) _Pragma("unroll") for (int n = 0; n < 2; ++n) _Pragma("unroll") for (int k = 0; k < 2; ++k) \
        acc[ai][bj][m][n] = __builtin_amdgcn_mfma_f32_16x16x32_bf16(Bt[n][k], At[m][k], acc[ai][bj][m][n], 0, 0, 0); __builtin_amdgcn_s_setprio(0); } while (0)
#define PG8_WAIT_V(n) asm volatile("s_waitcnt vmcnt(" #n ")" ::: "memory")
#define PG8_WAIT_L(n) asm volatile("s_waitcnt lgkmcnt(" #n ")" ::: "memory")
#define PG8_BAR __builtin_amdgcn_s_barrier()
#define PG8_SCHED __builtin_amdgcn_sched_barrier(0)
    Unit cur, nxt; int ui = 0;
    if (!S.next(0, cur)) return;
    f32x4 acc[2][2][4][2];
#pragma unroll
    for (int a = 0; a < 2; ++a)
#pragma unroll
        for (int b = 0; b < 2; ++b)
#pragma unroll
            for (int m = 0; m < 4; ++m)
#pragma unroll
                for (int n = 0; n < 2; ++n) acc[a][b][m][n] = (f32x4){0.f, 0.f, 0.f, 0.f};
    bf16x8 At[4][2], B0[2][2], B1[2][2];
    const char* cA = (const char*)g.A + (size_t)cur.pm * tstep; const char* cB = (const char*)g.Bt + (size_t)cur.pn * tstep;
    S.a_ready(cur);
    if constexpr (SP2) {
        PG8_STAGE(PG8_SB(0, 0), cB, voffB); PG8_STAGE(PG8_SB(0, 1), cB + hstep, voffB); PG8_STAGE(PG8_SA(0, 0), cA, voffA); PG8_STAGE(PG8_SA(0, 1), cA + hstep, voffA);
        if (wr == 1) PG8_BAR;
        PG8_WAIT_V(2); PG8_BAR;
        PG8_STAGE(PG8_SB(1, 0), cB + kstep, voffB); PG8_STAGE(PG8_SA(1, 0), cA + kstep, voffA); PG8_STAGE(PG8_SB(1, 1), cB + hstep + kstep, voffB);
        PG8_WAIT_V(6); PG8_BAR;
    } else {
        PG8_STAGE(PG8_SB(0, 0), cB, voffB); PG8_STAGE(PG8_SA(0, 0), cA, voffA); PG8_STAGE(PG8_SB(0, 1), cB + hstep, voffB); PG8_STAGE(PG8_SA(0, 1), cA + hstep, voffA);
        if (wr == 1) PG8_BAR;
        PG8_WAIT_V(4); PG8_BAR;
        PG8_STAGE(PG8_SB(1, 0), cB + kstep, voffB); PG8_STAGE(PG8_SA(1, 0), cA + kstep, voffA); PG8_STAGE(PG8_SB(1, 1), cB + hstep + kstep, voffB);
        PG8_WAIT_V(6); PG8_BAR;
    }
    for (;;) {
        const bool has_next = S.next(ui + 1, nxt);
        const char* nA = has_next ? (const char*)g.A + (size_t)nxt.pm * tstep : cA; const char* nB = has_next ? (const char*)g.Bt + (size_t)nxt.pn * tstep : cB;
        for (int t = 0; t < nt; t += 2) {
            const bool last = (t == nt - 2);
            const char* a1 = cA + (size_t)(t + 1) * kstep;
            const char* a2 = last ? nA : cA + (size_t)(t + 2) * kstep; const char* b2 = last ? nB : cB + (size_t)(t + 2) * kstep;
            const char* a3 = a2 + kstep; const char* b3 = b2 + kstep;
            if (last && has_next) S.a_ready(nxt);
            if constexpr (SP2) {
            PG8_LDB(B0, 0, 0); PG8_LDB(B1, 0, 1); PG8_SCHED; PG8_LDA(At, 0, 0); PG8_STAGE(PG8_SA(1, 1), a1 + hstep, voffA);
            PG8_WAIT_V(8); PG8_WAIT_L(0); PG8_BAR; PG8_MMA(0, 0, At, B0); PG8_MMA(0, 1, At, B1); PG8_BAR; PG8_SCHED;
            PG8_LDA(At, 0, 1); PG8_STAGE(PG8_SB(0, 0), b2, voffB); PG8_STAGE(PG8_SB(0, 1), b2 + hstep, voffB); PG8_STAGE(PG8_SA(0, 0), a2, voffA);
            PG8_WAIT_V(8); PG8_WAIT_L(0); PG8_BAR; PG8_MMA(1, 0, At, B0); PG8_MMA(1, 1, At, B1); PG8_BAR; PG8_SCHED;
            PG8_LDB(B0, 1, 0); PG8_LDB(B1, 1, 1); PG8_SCHED; PG8_LDA(At, 1, 0); PG8_STAGE(PG8_SA(0, 1), a2 + hstep, voffA);
            PG8_WAIT_V(8); PG8_WAIT_L(0); PG8_BAR; PG8_MMA(0, 0, At, B0); PG8_MMA(0, 1, At, B1); PG8_BAR; PG8_SCHED;
            PG8_LDA(At, 1, 1); PG8_STAGE(PG8_SB(1, 0), b3, voffB); PG8_STAGE(PG8_SB(1, 1), b3 + hstep, voffB); PG8_STAGE(PG8_SA(1, 0), a3, voffA);
            PG8_WAIT_V(8); PG8_WAIT_L(0); PG8_BAR; PG8_MMA(1, 0, At, B0); PG8_MMA(1, 1, At, B1); PG8_BAR; PG8_SCHED;
            } else {
            PG8_LDB(B0, 0, 0); PG8_SCHED; PG8_LDA(At, 0, 0); PG8_STAGE(PG8_SA(1, 1), a1 + hstep, voffA);
            PG8_WAIT_L(8); PG8_BAR; PG8_WAIT_L(0); PG8_MMA(0, 0, At, B0); PG8_BAR; PG8_SCHED;
            PG8_LDB(B1, 0, 1); PG8_STAGE(PG8_SB(0, 0), b2, voffB);
            PG8_BAR; PG8_WAIT_L(0); PG8_MMA(0, 1, At, B1); PG8_BAR;
            PG8_LDA(At, 0, 1); PG8_STAGE(PG8_SA(0, 0), a2, voffA);
            PG8_BAR; PG8_WAIT_L(0); PG8_MMA(1, 0, At, B0); PG8_BAR; PG8_SCHED;
            PG8_STAGE(PG8_SB(0, 1), b2 + hstep, voffB);
            PG8_WAIT_V(6); PG8_BAR; PG8_MMA(1, 1, At, B1); PG8_BAR;
            PG8_LDB(B0, 1, 0); PG8_SCHED; PG8_LDA(At, 1, 0); PG8_STAGE(PG8_SA(0, 1), a2 + hstep, voffA);
            PG8_WAIT_L(8); PG8_BAR; PG8_WAIT_L(0); PG8_MMA(0, 0, At, B0); PG8_BAR; PG8_SCHED;
            PG8_LDB(B1, 1, 1); PG8_STAGE(PG8_SB(1, 0), b3, voffB);
            PG8_BAR; PG8_WAIT_L(0); PG8_MMA(0, 1, At, B1); PG8_BAR;
            PG8_LDA(At, 1, 1); PG8_STAGE(PG8_SA(1, 0), a3, voffA);
            PG8_BAR; PG8_WAIT_L(0); PG8_MMA(1, 0, At, B0); PG8_BAR; PG8_SCHED;
            PG8_STAGE(PG8_SB(1, 1), b3 + hstep, voffB);
            PG8_WAIT_V(6); PG8_BAR; PG8_MMA(1, 1, At, B1); PG8_BAR;
            }
        }
        if constexpr (ALIGN_EPI) { if (wr == 0) PG8_BAR; }
        if constexpr (!Epi::AFTER_DRAIN) { E(acc, cur, wr, wc, fr, fq); S.done(cur); }
        if (!has_next) break;
#pragma unroll
        for (int a = 0; a < 2; ++a)
#pragma unroll
            for (int b = 0; b < 2; ++b)
#pragma unroll
                for (int m = 0; m < 4; ++m)
#pragma unroll
                    for (int n = 0; n < 2; ++n) acc[a][b][m][n] = (f32x4){0.f, 0.f, 0.f, 0.f};
        cur = nxt; cA = nA; cB = nB; ++ui;
        if constexpr (ALIGN_EPI) { if (wr == 1) PG8_BAR; }
    }
    PG8_WAIT_V(0);
    if constexpr (!ALIGN_EPI) { if (wr == 0) PG8_BAR; }
    PG8_BAR;
    if constexpr (Epi::AFTER_DRAIN) { E.fused(acc, cur, wr, wc, fr, fq, lds, wid, lane); S.done(cur); }
#undef PG8_SA
#undef PG8_SB
#undef PG8_STAGE
#undef PG8_LDA
#undef PG8_LDB
#undef PG8_MMA
#undef PG8_WAIT_V
#undef PG8_WAIT_L
#undef PG8_BAR
#undef PG8_SCHED
}
}
#ifndef PG8_SP2
#define PG8_SP2 true
#endif
#ifndef PG8_ALIGN
#define PG8_ALIGN true
#endif
constexpr int NWAVES = 8;
#ifndef MK_N_LAUNCHES
#define MK_N_LAUNCHES 1
#endif
constexpr int N_PHASES = 15;
constexpr bool ONE_LAUNCH = (MK_N_LAUNCHES == 1);

constexpr size_t MiB = 1u << 20;
constexpr size_t WS_CTL = 0, CTL_ZERO_BYTES = 1 * MiB;
constexpr size_t WS_W = 2 * MiB;
constexpr size_t W_LAYER = 96 * MiB, W_QKV = 0, W_O = 24 * MiB, W_UP = 32 * MiB, W_DN = 64 * MiB;
constexpr size_t WS_XN = 194 * MiB;
constexpr size_t WS_CK = 323 * MiB, WS_CV = 387 * MiB;
constexpr size_t WS_Q = 451 * MiB, WS_K = 580 * MiB, WS_V = 709 * MiB;
constexpr size_t WS_H = WS_Q;
constexpr size_t WS_END = 967 * MiB;
static_assert(WS_H + (size_t)M * FF * 2 <= WS_END && WS_V + (size_t)M * D * 2 <= WS_END && WS_XN + (size_t)M * D * 2 <= WS_CK && WS_W + 2 * W_LAYER <= WS_XN, "d_ws map");
static_assert(QKV_WS_Q == WS_Q && WS_K == WS_Q + QKV_WS_STRIDE && WS_V == WS_Q + 2 * QKV_WS_STRIDE, "QKV epilogue map");
constexpr int CW_TMO = 0;
constexpr int CW_BAR = 4096;

constexpr size_t OUT_Y = 0, OUT_KP = (size_t)MV * D, OUT_VP = OUT_KP + 2 * (size_t)MP * D, OUT_KS = OUT_VP + 2 * (size_t)MP * D, OUT_VS = OUT_KS + 2 * (size_t)MS * D, OUT_END = OUT_VS + 2 * (size_t)MS * D;
static_assert(OUT_KP == QKV_OUT_KP && OUT_VP == QKV_OUT_VP && OUT_KS == QKV_OUT_KS && OUT_VS == QKV_OUT_VS, "QKV epilogue map");

constexpr int RING_OFF = 0, RING_BYTES = 131072;
constexpr int LDSCTL_OFF = RING_BYTES;
constexpr int GTAB_OFF = LDSCTL_OFF + 1024;
constexpr int LDS_BYTES = 147456;
static_assert(GTAB_OFF + 1024 <= LDS_BYTES, "LDS map");

#define GAS __attribute__((address_space(1)))
#define LAS __attribute__((address_space(3)))
typedef unsigned short bf16;
typedef unsigned v4u __attribute__((ext_vector_type(4)));
typedef unsigned v2u __attribute__((ext_vector_type(2)));
typedef float f32x4 __attribute__((ext_vector_type(4)));
typedef GAS unsigned gu32;
#define RLX_AGENT __ATOMIC_RELAXED, __HIP_MEMORY_SCOPE_AGENT
#define LDS_WAIT() asm volatile("s_waitcnt lgkmcnt(0)" ::: "memory")
#define VM_WAIT() asm volatile("s_waitcnt vmcnt(0)" ::: "memory")
typedef float f32x2_t __attribute__((ext_vector_type(2))); typedef __bf16 bf16x2_t __attribute__((ext_vector_type(2)));
__device__ __forceinline__ unsigned pk2(float lo, float hi) { f32x2_t v = {lo, hi}; bf16x2_t b = __builtin_convertvector(v, bf16x2_t); return __builtin_bit_cast(unsigned, b); }
__device__ __forceinline__ float wave_sum(float v) {
#pragma unroll
    for (int o = 1; o < 64; o <<= 1) v += __shfl_xor(v, o);
    return v;
}
#define XB_TMO      128
#define XB_XCNT(j)  (256  + 64 * (j))
#define XB_XSUB(j)  (1280 + 64 * (j))
#define XB_XGEN(j)  (2304 + 64 * (j))
#define XB_TOP      3328
#define XB_TOPGEN   3392
#define XCD_BAR_WORDS 3456
#define XB_SPIN_CAP (1u << 18)

__device__ __forceinline__ unsigned xb_ld(unsigned* p)              { return __hip_atomic_load(p, __ATOMIC_RELAXED, __HIP_MEMORY_SCOPE_AGENT); }
__device__ __forceinline__ unsigned xb_add(unsigned* p, unsigned v) { return __hip_atomic_fetch_add(p, v, __ATOMIC_RELAXED, __HIP_MEMORY_SCOPE_AGENT); }
__device__ __forceinline__ unsigned xb_xcc_id() { return (unsigned)__builtin_amdgcn_s_getreg((3 << 11) | 20) & 0xFu; }
#define XB_SPIN(cond, bar) do { unsigned _sp = 0; while (cond) { __builtin_amdgcn_s_sleep(1); \
    if ((++_sp & 255u) == 0u) { if (xb_ld(&(bar)[XB_TMO])) break; if (_sp > XB_SPIN_CAP) { atomicAdd(&(bar)[XB_TMO], 1u); break; } } } } while (0)

struct XcdBarrier {
    unsigned* bar; unsigned x;
    volatile LAS unsigned* st;
};

__device__ __forceinline__ XcdBarrier xcd_barrier_post(unsigned* bar, volatile LAS unsigned* st) {
    XcdBarrier b; b.bar = bar; b.x = xb_xcc_id(); b.st = st;
    if (threadIdx.x == 0) (void)xb_add(&bar[XB_XCNT(b.x)], 1u);
    return b;
}
__device__ __forceinline__ void xcd_barrier_complete(unsigned* bar, unsigned x, unsigned& nloc, unsigned& nx) {
    const unsigned G = gridDim.x * gridDim.y * gridDim.z;
    unsigned sum, cnt, mine, sp = 0u;
    for (;;) {
        sum = 0u; cnt = 0u; mine = 0u;
#pragma unroll
        for (unsigned j = 0; j < 16; ++j) { const unsigned c = xb_ld(&bar[XB_XCNT(j)]); sum += c; cnt += (c > 0u) ? 1u : 0u; mine = (j == x) ? c : mine; }
        if (sum == G) break;
        __builtin_amdgcn_s_sleep(1);
        if ((++sp & 255u) == 0u) { if (xb_ld(&bar[XB_TMO])) break; if (sp > XB_SPIN_CAP) { atomicAdd(&bar[XB_TMO], 1u); break; } }
    }
    nloc = mine > 0u ? mine : 1u; nx = cnt > 0u ? cnt : 1u;
}

__device__ __forceinline__ void xcd_barrier(const XcdBarrier& b) {
    asm volatile("s_waitcnt vmcnt(0)" ::: "memory");
    __syncthreads();
    if (threadIdx.x == 0) {
        unsigned* bar = b.bar;
        __builtin_amdgcn_s_waitcnt(0);
        unsigned nloc = b.st[0], nx = b.st[1];
        if (nloc == 0u) { xcd_barrier_complete(bar, b.x, nloc, nx); b.st[0] = nloc; b.st[1] = nx; }
        const unsigned old = xb_add(&bar[XB_XSUB(b.x)], 1u);
        const unsigned gen = old / nloc;
        if (old + 1u == (gen + 1u) * nloc) {
            __builtin_amdgcn_fence(__ATOMIC_RELEASE, "agent");
            asm volatile("s_waitcnt vmcnt(0)" ::: "memory");
            const unsigned og = xb_add(&bar[XB_TOP], 1u);
            const unsigned tg = og / nx;
            if (og + 1u == (tg + 1u) * nx) xb_add(&bar[XB_TOPGEN], 1u);
            else XB_SPIN(xb_ld(&bar[XB_TOPGEN]) == tg, bar);
            __builtin_amdgcn_fence(__ATOMIC_ACQUIRE, "agent");
            xb_add(&bar[XB_XGEN(b.x)], 1u);
            asm volatile("s_waitcnt vmcnt(0)" ::: "memory");
        } else {
            XB_SPIN(xb_ld(&bar[XB_XGEN(b.x)]) == gen, bar);
            __builtin_amdgcn_fence(__ATOMIC_ACQUIRE, "agent");
            asm volatile("s_waitcnt vmcnt(0)" ::: "memory");
        }
    }
    __syncthreads();
}
namespace att {
typedef short bf16x8 __attribute__((ext_vector_type(8)));
typedef short s16x4 __attribute__((ext_vector_type(4)));
typedef short v4i16_t __attribute__((ext_vector_type(4)));
typedef float f32x16 __attribute__((ext_vector_type(16)));
typedef LAS unsigned char* lptr;
constexpr float LOG2E = 1.4426950408889634f;
constexpr float QSCALE = 0.08838834764831845f * 1.4426950408889634f;
constexpr float SB_DONE = -150.0f;

__device__ __forceinline__ s16x4 vtr(const LAS unsigned char* p) { return __builtin_bit_cast(s16x4, __builtin_amdgcn_ds_read_tr16_b64_v4i16((LAS v4i16_t*)p)); }
__device__ __forceinline__ float swap_lo(float x, float& other_hi) { auto rr = __builtin_amdgcn_permlane32_swap(__float_as_uint(x), __float_as_uint(x), false, false); other_hi = __uint_as_float(rr[1]); return __uint_as_float(rr[0]); }

template <int KW, int VW, int TK> struct KVStage {
    static constexpr int KBYTES = TK * KW * 2, VBYTES = TK * VW * 2, BUF = KBYTES + VBYTES, NK = KBYTES / 8192, NV = VBYTES / 8192, VDB = TK * 64  ;
    unsigned voffK[NK], voffV[NV];
    __device__ __forceinline__ void init(int wid, int lane) {
#pragma unroll
        for (int j = 0; j < NK; ++j) { const int pos = (wid * NK + j) * 64 + lane; int row, c16;
            if (KW == 128) { row = pos >> 4; c16 = (pos & 15) ^ (row & 15); } else { row = pos >> 5; c16 = ((pos >> 4) & 1) * 16 + ((pos & 15) ^ (row & 15)); }
            voffK[j] = (unsigned)(row * D + c16 * 8) * 2u; }
#pragma unroll
        for (int j = 0; j < NV; ++j) { const int pos = (wid * NV + j) * 64 + lane; const int dblk = pos / (TK * 4), row = (pos >> 2) % TK, sub = pos & 3;
            voffV[j] = (unsigned)(row * D + (dblk * 4 + sub) * 8) * 2u; }
    }
    __device__ __forceinline__ void issue(lptr buf, const bf16* kp, const bf16* vp, int wid) const {
#pragma unroll
        for (int j = 0; j < NK; ++j) __builtin_amdgcn_global_load_lds((const unsigned*)((const char*)kp + voffK[j]), (LAS unsigned*)(buf + (wid * NK + j) * 1024), 16, 0, 0);
#pragma unroll
        for (int j = 0; j < NV; ++j) __builtin_amdgcn_global_load_lds((const unsigned*)((const char*)vp + voffV[j]), (LAS unsigned*)(buf + KBYTES + (wid * NV + j) * 1024), 16, 0, 0);
    }
};

template <int KPITCH> __device__ __forceinline__ void qkt1(f32x16& p, const LAS unsigned char* Kb, int mp, const bf16x8* qr, int r32, int hi) {
    const int xk = (r32 & 15) << 4; const LAS unsigned char* k0 = Kb + r32 * KPITCH + mp * 256;
#pragma unroll
    for (int ks = 0; ks < 8; ++ks) { const int cb = (ks * 32 + hi * 16) ^ xk;
        const bf16x8 a0 = *(const LAS bf16x8*)(k0 + cb);
        p = __builtin_amdgcn_mfma_f32_32x32x16_bf16(a0, qr[ks], p, 0, 0, 0); }
}
template <int NDB, int NS, int VDB> __device__ __forceinline__ void pv(f32x16* o, const LAS unsigned char* Vb, int lane, const bf16x8* pf) {
    const LAS unsigned char* vb = Vb + (4 * (lane >> 5) + ((lane & 15) >> 2)) * 64 + ((lane >> 4) & 1) * 32 + (lane & 3) * 8;
#pragma unroll
    for (int db = 0; db < NDB; ++db)
#pragma unroll
        for (int s = 0; s < NS; ++s) { const s16x4 lo = vtr(vb + db * VDB + s * 1024), hi4 = vtr(vb + db * VDB + s * 1024 + 512);
            const bf16x8 vf = (bf16x8){lo[0], lo[1], lo[2], lo[3], hi4[0], hi4[1], hi4[2], hi4[3]};
            o[db] = __builtin_amdgcn_mfma_f32_32x32x16_bf16(vf, pf[s], o[db], 0, 0, 0);
            if (NDB == 8 && (db & 1) == 1 && s == NS - 1) __builtin_amdgcn_sched_barrier(0); }
}
__device__ __forceinline__ void pack_p(bf16x8* pf, const f32x16& p) {
#pragma unroll
    for (int s = 0; s < 2; ++s) { v4u a;
        a.x = pk2(p[8 * s + 0], p[8 * s + 1]); a.y = pk2(p[8 * s + 2], p[8 * s + 3]); a.z = pk2(p[8 * s + 4], p[8 * s + 5]); a.w = pk2(p[8 * s + 6], p[8 * s + 7]);
        pf[s] = __builtin_bit_cast(bf16x8, a); }
}

template <bool SAMPLE>
__device__ __forceinline__ void sb_unit(lptr ring, volatile LAS int* flags, const bf16* Qb, const bf16* Kb, const bf16* Vb, const bf16* CK, const bf16* CV, bf16* Ob,
                                        int b, int h, int qb, int wid, int lane) {
    KVStage<128, 128, 64> st; st.init(wid, lane);
    constexpr int BUF = KVStage<128, 128, 64>::BUF, KBYTES = KVStage<128, 128, 64>::KBYTES;
    const int r32 = lane & 31, hi = lane >> 5;
    const int qbase = SAMPLE ? PAST : 256 * qb + 32 * wid;
    const int qpos = qbase + r32;
    const size_t qrow = SAMPLE ? (size_t)(MP + 16 * b + r32) : (size_t)b * SEQ + qpos;
    const bool live = SAMPLE ? (wid == 0) : true;
    const bool rvalid = SAMPLE ? (wid == 0 && r32 < 16) : true;
    const int jt_hi = SAMPLE ? 32 : 4 * qb + 3;
    const int coff = h * 128;
    bf16x8 qr[8];
#pragma unroll
    for (int ks = 0; ks < 8; ++ks) qr[ks] = *(const bf16x8*)(Qb + qrow * D + coff + ks * 16 + hi * 8);
    f32x16 o[4];
#pragma unroll
    for (int i = 0; i < 4; ++i) o[i] = f32x16{};
    float C = 0.f;
#define SB_TILE_PTRS(jt_, kp_, vp_) do { size_t off_; \
        if (!SAMPLE) { off_ = ((size_t)b * SEQ + 64 * (size_t)(jt_)) * D + coff; kp_ = Kb + off_; vp_ = Vb + off_; } \
        else if ((jt_) == 32) { off_ = (size_t)(MP + 16 * b) * D + coff; kp_ = Kb + off_; vp_ = Vb + off_; } \
        else { off_ = ((size_t)b * PAST + 64 * (size_t)(jt_)) * D + coff; kp_ = CK + off_; vp_ = CV + off_; } } while (0)
    int jt = jt_hi, it = 0;
    { const bf16 *kp, *vp; SB_TILE_PTRS(jt, kp, vp); st.issue(ring, kp, vp, wid); }
    VM_WAIT(); __syncthreads();
    bool wdone = !live;
    for (;;) {
        const lptr cur = ring + (it & 1) * BUF, nxt = ring + ((it & 1) ^ 1) * BUF;
        const bool has_next = jt > 0;
        if (has_next) { const bf16 *kp, *vp; SB_TILE_PTRS(jt - 1, kp, vp); st.issue(nxt, kp, vp, wid); }
        const int kmin = 64 * jt;
        if (!wdone && kmin < qbase + 31) {
            f32x16 p0 = f32x16{}, p1 = f32x16{};
            qkt1<256>(p0, cur, 0, qr, r32, hi); qkt1<256>(p1, cur + 32 * 256, 0, qr, r32, hi);
            f32x16 L0, L1;
#pragma unroll
            for (int r = 0; r < 16; ++r) {
                const float z0 = p0[r], z1 = p1[r];
                L0[r] = -(fmaxf(z0, 0.f) + __builtin_amdgcn_logf(1.0f + __builtin_amdgcn_exp2f(-fabsf(z0))));
                L1[r] = -(fmaxf(z1, 0.f) + __builtin_amdgcn_logf(1.0f + __builtin_amdgcn_exp2f(-fabsf(z1)))); }
            const bool need_mask = (kmin + 63 >= qbase);
            if (need_mask) {
                const float df = (float)(qpos - kmin - 4 * hi);
#pragma unroll
                for (int r = 0; r < 16; ++r) { const float c = (float)((r & 3) + 8 * (r >> 2));
                    const float f0 = __builtin_amdgcn_fmed3f(df - c, 0.f, 1.f), f1 = __builtin_amdgcn_fmed3f(df - (c + 32.f), 0.f, 1.f);
                    L0[r] *= f0; p0[r] += f0 * 1e30f - 1e30f; L1[r] *= f1; p1[r] += f1 * 1e30f - 1e30f; } }
            float T[8];
#pragma unroll
            for (int g = 0; g < 4; ++g) {
                L0[4 * g + 2] += L0[4 * g + 3]; L0[4 * g + 1] += L0[4 * g + 2]; L0[4 * g] += L0[4 * g + 1]; T[g] = L0[4 * g];
                L1[4 * g + 2] += L1[4 * g + 3]; L1[4 * g + 1] += L1[4 * g + 2]; L1[4 * g] += L1[4 * g + 1]; T[4 + g] = L1[4 * g]; }
            float off[8]; float run = 0.f;
#pragma unroll
            for (int g = 7; g >= 0; --g) { float t1; const float t0 = swap_lo(T[g], t1); off[g] = C + run + (hi == 0 ? t1 : 0.f); run += t0 + t1; }
#pragma unroll
            for (int g = 0; g < 4; ++g)
#pragma unroll
                for (int i = 0; i < 4; ++i) { const int r = 4 * g + i;
                    p0[r] = __builtin_amdgcn_exp2f(p0[r] + L0[r] + off[g]);
                    p1[r] = __builtin_amdgcn_exp2f(p1[r] + L1[r] + off[4 + g]); }
            C += run;
            bf16x8 pf[4]; pack_p(pf, p0); pack_p(pf + 2, p1);
            pv<4, 4, 4096>(o, cur + KBYTES, lane, pf);
            wdone = __all((!rvalid) || (C < SB_DONE));
        }
        if (lane == 0) flags[(it & 1) * 8 + wid] = wdone ? 1 : 0;
        VM_WAIT(); LDS_WAIT(); __syncthreads();
        if (!has_next) break;
        int all = 1;
#pragma unroll
        for (int w = 0; w < 8; ++w) all &= flags[(it & 1) * 8 + w];
        if (all) break;
        --jt; ++it;
    }
#undef SB_TILE_PTRS
    if (rvalid) {
#pragma unroll
        for (int db = 0; db < 4; ++db)
#pragma unroll
            for (int gq = 0; gq < 4; ++gq) { v2u w; w.x = pk2(o[db][4 * gq], o[db][4 * gq + 1]); w.y = pk2(o[db][4 * gq + 2], o[db][4 * gq + 3]);
                *(v2u*)(Ob + qrow * D + coff + 32 * db + 8 * gq + 4 * hi) = w; }
    }
}

template <bool SAMPLE>
__device__ __forceinline__ void diff_unit(lptr ring, const LAS float* gtab, const bf16* Qb, const bf16* Kb, const bf16* Vb, const bf16* CK, const bf16* CV, bf16* Ob,
                                          int b, int h8, int qb, float lam, int wid, int lane) {
    asm volatile("" : "+v"(lane));
    KVStage<256, 256, 32> st; st.init(wid, lane);
    constexpr int BUF = KVStage<256, 256, 32>::BUF, KBYTES = KVStage<256, 256, 32>::KBYTES, VDB = KVStage<256, 256, 32>::VDB;
    const int r32 = lane & 31, hi = lane >> 5, mp = wid >> 2, sb = wid & 3;
    const int qbase = SAMPLE ? PAST : 128 * qb + 32 * sb;
    const int qpos = qbase + r32;
    const size_t qrow = SAMPLE ? (size_t)(MP + 16 * b + r32) : (size_t)b * SEQ + qpos;
    const bool live = SAMPLE ? (sb == 0) : true;
    const bool rvalid = SAMPLE ? (sb == 0 && r32 < 16) : true;
    const int wchunk = SAMPLE ? 32 : (qbase >> 6);
    const int jt_hi = SAMPLE ? 64 : 4 * qb + 3;
    const int coff = h8 * 256;
    const float slope2 = __builtin_amdgcn_exp2f(-(float)(h8 + 1)) * LOG2E;
    const int xk = (r32 & 15) << 4;
    const lptr qs = ring + 65536 + wid * 8192 + lane * 16;
#pragma unroll
    for (int ks = 0; ks < 8; ++ks) *(LAS bf16x8*)(qs + ks * 1024) = *(const bf16x8*)(Qb + qrow * D + coff + mp * 128 + ks * 16 + hi * 8);
    f32x16 o[8];
#pragma unroll
    for (int i = 0; i < 8; ++i) o[i] = f32x16{};
    float m = -INFINITY, l = 0.f;
#define DF_TILE_PTRS(jt_, kp_, vp_) do { size_t off_; \
        if (!SAMPLE) { off_ = ((size_t)b * SEQ + 32 * (size_t)(jt_)) * D + coff; kp_ = Kb + off_; vp_ = Vb + off_; } \
        else if ((jt_) == 64) { off_ = (size_t)(MP + 16 * b) * D + coff; kp_ = Kb + off_; vp_ = Vb + off_; } \
        else { off_ = ((size_t)b * PAST + 32 * (size_t)(jt_)) * D + coff; kp_ = CK + off_; vp_ = CV + off_; } } while (0)
    { const bf16 *kp, *vp; DF_TILE_PTRS(jt_hi, kp, vp); st.issue(ring, kp, vp, wid); }
    VM_WAIT(); LDS_WAIT(); __syncthreads();
    int it = 0;
    for (int jt = jt_hi; jt >= 0; --jt, ++it) {
        const lptr cur = ring + (it & 1) * BUF, nxt = ring + ((it & 1) ^ 1) * BUF;
        if (jt > 0) { const bf16 *kp, *vp; DF_TILE_PTRS(jt - 1, kp, vp); st.issue(nxt, kp, vp, wid); }
        if (live && (jt >> 1) <= wchunk) {
            f32x16 p = f32x16{};
            { const LAS unsigned char* k0 = cur + r32 * 512 + mp * 256;
#pragma unroll
              for (int ks = 0; ks < 8; ++ks) { const int cb = (ks * 32 + hi * 16) ^ xk;
                  p = __builtin_amdgcn_mfma_f32_32x32x16_bf16(*(const LAS bf16x8*)(k0 + cb), *(const LAS bf16x8*)(qs + ks * 1024), p, 0, 0, 0); } }
            const float dqf = (float)(qpos - 32 * jt - 4 * hi);
#pragma unroll
            for (int r = 0; r < 16; ++r) { const float c = (float)((r & 3) + 8 * (r >> 2)); p[r] = fmaf(-slope2, fabsf(dqf - c), p[r]); }
            if (SAMPLE && jt == 64) {
#pragma unroll
                for (int r = 8; r < 16; ++r) p[r] = -INFINITY; }
            float tm = p[0];
#pragma unroll
            for (int r = 1; r < 16; ++r) tm = fmaxf(tm, p[r]);
            { float t1; const float t0 = swap_lo(tm, t1); tm = fmaxf(t0, t1); }
            if (__any(tm > m)) { const float mn = fmaxf(m, tm); const float alpha = __builtin_amdgcn_exp2f(m - mn); m = mn; l *= alpha;
#pragma unroll
                for (int db = 0; db < 8; ++db)
#pragma unroll
                    for (int r = 0; r < 16; ++r) o[db][r] *= alpha; }
            float ps = 0.f;
#pragma unroll
            for (int r = 0; r < 16; ++r) { p[r] = __builtin_amdgcn_exp2f(p[r] - m); ps += p[r]; }
            l += ps;
            bf16x8 pf[2]; pack_p(pf, p);
            pv<8, 2, VDB>(o, cur + KBYTES, lane, pf);
        }
        VM_WAIT(); LDS_WAIT(); __syncthreads();
    }
#undef DF_TILE_PTRS
    { float t1; const float t0 = swap_lo(l, t1); l = t0 + t1; }
    const float inv = live ? 1.0f / l : 0.f;
    const lptr xb = ring + sb * 32768 + lane * 16;
    if (mp == 1) { const float sc = lam * inv;
#pragma unroll
        for (int v = 0; v < 32; ++v) { const int db = v >> 2, gq = v & 3; f32x4 x = {o[db][4 * gq] * sc, o[db][4 * gq + 1] * sc, o[db][4 * gq + 2] * sc, o[db][4 * gq + 3] * sc};
            *(LAS f32x4*)(xb + v * 1024) = x; } }
    LDS_WAIT(); __syncthreads();
    if (mp == 0) { float ss = 0.f;
#pragma unroll
        for (int v = 0; v < 32; ++v) { const int db = v >> 2, gq = v & 3; const f32x4 x = *(const LAS f32x4*)(xb + v * 1024);
#pragma unroll
            for (int e = 0; e < 4; ++e) { const float y = o[db][4 * gq + e] * inv - x[e]; o[db][4 * gq + e] = y; ss += y * y; }
            if ((v & 3) == 3) asm volatile("" ::: "memory"); }
        { float t1; const float t0 = swap_lo(ss, t1); ss = t0 + t1; }
        const float rs = 1.0f / sqrtf(ss * (1.0f / 256.0f) + 1e-5f);
        if (rvalid) {
#pragma unroll
            for (int v = 0; v < 32; ++v) { const int db = v >> 2, gq = v & 3; const int d0 = 32 * db + 8 * gq + 4 * hi; const f32x4 g4 = *(const LAS f32x4*)(gtab + d0);
                v2u w; w.x = pk2(o[db][4 * gq] * rs * g4[0], o[db][4 * gq + 1] * rs * g4[1]); w.y = pk2(o[db][4 * gq + 2] * rs * g4[2], o[db][4 * gq + 3] * rs * g4[3]);
                *(v2u*)(Ob + qrow * D + coff + d0) = w;
                if ((v & 3) == 3) asm volatile("" ::: "memory"); } }
    }
    LDS_WAIT(); __syncthreads();
}
}
__device__ __forceinline__ void transpose_item(const float* W, int K, int N, bf16* WT, LAS float* scr, int item, int lane) {
    const int nblk = N / 32, kb = item / nblk, nb = item % nblk, k0 = 64 * kb, n0 = 32 * nb;
#pragma unroll 8
    for (int i = 0; i < 32; ++i) { const int kk = 2 * i + (lane >> 5); scr[kk * 33 + (lane & 31)] = W[(size_t)(k0 + kk) * N + n0 + (lane & 31)]; }
    LDS_WAIT(); asm volatile("" ::: "memory");
    const int c = lane & 7;
#pragma unroll
    for (int j = 0; j < 4; ++j) { const int n = (lane >> 3) + 8 * j; const LAS float* s = scr + (8 * c) * 33 + n;
        v4u o; o.x = pk2(s[0 * 33], s[1 * 33]); o.y = pk2(s[2 * 33], s[3 * 33]); o.z = pk2(s[4 * 33], s[5 * 33]); o.w = pk2(s[6 * 33], s[7 * 33]);
        *(v4u*)(WT + (size_t)(n0 + n) * K + k0 + 8 * c) = o; }
    LDS_WAIT(); asm volatile("" ::: "memory");
}
__device__ __forceinline__ void xn_rows(const float* srcp, const float* srcs, const float* g, bf16* XN, int gw, int NGW, int lane) {
    for (int m = gw; m < M; m += NGW) {
        v2u* o8 = (v2u*)(XN + (size_t)m * D) + lane;
        if (m < MV) {
            const f32x4* xr = (const f32x4*)(m < MP ? srcp + (size_t)m * D : srcs + (size_t)(m - MP) * D) + lane;
            f32x4 v[8]; float ss = 0.f;
#pragma unroll
            for (int j = 0; j < 8; ++j) { v[j] = xr[64 * j]; ss += (v[j].x * v[j].x + v[j].y * v[j].y) + (v[j].z * v[j].z + v[j].w * v[j].w); }
            const float rs = 1.0f / sqrtf(wave_sum(ss) * (1.0f / D) + 1e-6f);
#pragma unroll
            for (int j = 0; j < 8; ++j) { const f32x4 gv = ((const f32x4*)g)[lane + 64 * j]; v2u w; w.x = pk2(v[j].x * rs * gv.x, v[j].y * rs * gv.y); w.y = pk2(v[j].z * rs * gv.z, v[j].w * rs * gv.w); o8[64 * j] = w; }
        } else {
#pragma unroll
            for (int j = 0; j < 8; ++j) o8[64 * j] = (v2u){0u, 0u};
        }
    }
}
__device__ __forceinline__ void final_rows(float* X, const float* g, int gw, int NGW, int lane) {
    for (int m = gw; m < MV; m += NGW) {
        f32x4* xr = (f32x4*)(X + (size_t)m * D) + lane;
        f32x4 v[8]; float ss = 0.f;
#pragma unroll
        for (int j = 0; j < 8; ++j) { v[j] = xr[64 * j]; ss += (v[j].x * v[j].x + v[j].y * v[j].y) + (v[j].z * v[j].z + v[j].w * v[j].w); }
        const float rs = 1.0f / sqrtf(wave_sum(ss) * (1.0f / D) + 1e-6f);
#pragma unroll
        for (int j = 0; j < 8; ++j) { const f32x4 gv = ((const f32x4*)g)[lane + 64 * j]; xr[64 * j] = (v[j] * rs) * gv; }
    }
}
__device__ __forceinline__ void cache_convert(const float* ck, const float* cv, bf16* CK, bf16* CV, size_t gt, size_t NT) {
    constexpr size_t NCH = (size_t)DEC_B * PAST * D / 8;
    for (size_t i = gt; i < 2 * NCH; i += NT) { const bool t = i >= NCH; const size_t c = t ? i - NCH : i;
        const f32x4* s = (const f32x4*)((t ? cv : ck) + c * 8); const f32x4 a = s[0], b2 = s[1];
        v4u o; o.x = pk2(a.x, a.y); o.y = pk2(a.z, a.w); o.z = pk2(b2.x, b2.y); o.w = pk2(b2.z, b2.w);
        *(v4u*)((t ? CV : CK) + c * 8) = o; }
}

struct Args { const float* in[16]; float* out; unsigned char* ws; int ph_lo, ph_hi; };
template <int L>
__device__ __forceinline__ void layer_phases(const Args& args, LAS unsigned char* lds, volatile LAS int* flags, LAS float* gtab, const XcdBarrier& bar, int lo, int hi, int G, int vcu, int tid, int lane, int wave) {
#define IN(k) (lo <= (k) && (k) < hi)
#define SEAM(k) do { if (ONE_LAUNCH && IN(k) && IN((k) + 1)) xcd_barrier(bar); } while (0)
    unsigned char* ws = args.ws;
    const float* x_prompt = args.in[0]; const float* x_sample = args.in[1];
    float* X = args.out + OUT_Y;
    bf16* XN = (bf16*)(ws + WS_XN); bf16* CK = (bf16*)(ws + WS_CK); bf16* CV = (bf16*)(ws + WS_CV);
    bf16* Qb = (bf16*)(ws + WS_Q); bf16* Kb = (bf16*)(ws + WS_K); bf16* Vb = (bf16*)(ws + WS_V); bf16* Hb = (bf16*)(ws + WS_H);
    const int gw = vcu * NWAVES + wave, NGW = G * NWAVES;
    const size_t gt = (size_t)vcu * (NWAVES * 64) + tid, NT = (size_t)G * (NWAVES * 64);

        const int pb = 1 + 7 * L;
        unsigned char* wl = ws + WS_W + (size_t)L * W_LAYER;
        const bf16* Wqkv_t = (const bf16*)(wl + W_QKV); const bf16* Wo_t = (const bf16*)(wl + W_O); const bf16* Wup_t = (const bf16*)(wl + W_UP); const bf16* Wdn_t = (const bf16*)(wl + W_DN);
        if (IN(pb)) {
            pg8::Gemm g{XN, Wqkv_t, M, 3 * D, D}; pg8::StaticOrder S; S.init(M, 3 * D, G, (int)blockIdx.x);
            pg8::EpiQKV E{ws, args.out, L, att::QSCALE};
            pg8::gemm_phase<pg8::EpiQKV, pg8::StaticOrder, PG8_ALIGN, PG8_SP2>(lds + RING_OFF, g, S, E);
        }
        SEAM(pb);
        if (IN(pb + 1)) {
            if (L == 0) {
                for (int u = vcu; u < 2048; u += G) att::sb_unit<false>(lds + RING_OFF, flags, Qb, Kb, Vb, CK, CV, Qb, u >> 9, (u >> 5) & 15, u & 31, wave, lane);
                for (int u = vcu; u < 128; u += G) att::sb_unit<true>(lds + RING_OFF, flags, Qb, Kb, Vb, CK, CV, Qb, u >> 4, u & 15, 0, wave, lane);
            } else {
                constexpr float LAMBDA_INIT = 0.35550906759096926f;
                float s1 = args.in[7][lane] * args.in[8][lane] + args.in[7][lane + 64] * args.in[8][lane + 64];
                float s2 = args.in[9][lane] * args.in[10][lane] + args.in[9][lane + 64] * args.in[10][lane + 64];
                s1 = wave_sum(s1); s2 = wave_sum(s2);
                const float lam = expf(s1) - expf(s2) + LAMBDA_INIT;
                if (tid < 256) gtab[tid] = args.in[11][tid] * (1.0f - LAMBDA_INIT);
                LDS_WAIT(); __syncthreads();
                for (int idx = vcu; idx < 2048; idx += G) { const int ip = 7 - (idx >> 8), v = idx & 255, grp = v >> 3, s = v & 7; const int qb = 8 * ip + ((ip & 1) ? 7 - s : s);
                    att::diff_unit<false>(lds + RING_OFF, gtab, Qb, Kb, Vb, CK, CV, Qb, grp >> 3, grp & 7, qb, lam, wave, lane); }
                for (int v = vcu; v < 64; v += G) att::diff_unit<true>(lds + RING_OFF, gtab, Qb, Kb, Vb, CK, CV, Qb, v >> 3, v & 7, 0, lam, wave, lane);
            }
        }
        SEAM(pb + 1);
        if (IN(pb + 2)) {
            pg8::Gemm g{Qb, Wo_t, M, D, D}; pg8::StaticOrder S; S.init(M, D, G, (int)blockIdx.x);
            pg8::EpiResid E{L == 0 ? x_prompt : X, L == 0 ? x_sample : X + (size_t)MP * D, X};
            pg8::gemm_phase<pg8::EpiResid, pg8::StaticOrder, PG8_ALIGN, PG8_SP2>(lds + RING_OFF, g, S, E);
        }
        SEAM(pb + 2);
        if (IN(pb + 3)) xn_rows(X, X + (size_t)MP * D, args.in[12] + (size_t)L * D, XN, gw, NGW, lane);
        SEAM(pb + 3);
        if (IN(pb + 4)) {
            pg8::Gemm g{XN, Wup_t, M, FF, D}; pg8::StaticOrder S; S.init(M, FF, G, (int)blockIdx.x);
            pg8::EpiRelu2 E{Hb, FF};
            pg8::gemm_phase<pg8::EpiRelu2, pg8::StaticOrder, PG8_ALIGN, PG8_SP2>(lds + RING_OFF, g, S, E);
        }
        SEAM(pb + 4);
        if (IN(pb + 5)) {
            pg8::Gemm g{Hb, Wdn_t, M, D, FF}; pg8::StaticOrder S; S.init(M, D, G, (int)blockIdx.x);
            pg8::EpiResid E{X, X + (size_t)MP * D, X};
            pg8::gemm_phase<pg8::EpiResid, pg8::StaticOrder, PG8_ALIGN, PG8_SP2>(lds + RING_OFF, g, S, E);
        }
        SEAM(pb + 5);
        if (IN(pb + 6)) {
            if (L == 0) { cache_convert(args.in[2] + (size_t)DEC_B * PAST * D, args.in[3] + (size_t)DEC_B * PAST * D, CK, CV, gt, NT);
                          xn_rows(X, X + (size_t)MP * D, args.in[4] + D, XN, gw, NGW, lane); }
            else final_rows(X, args.in[15], gw, NGW, lane);
        }
        if (L == 0) SEAM(pb + 6);

#undef IN
#undef SEAM
}

__global__ void __launch_bounds__(NWAVES * 64, 2) fwd_kernel(Args args) {
    extern __shared__ __attribute__((aligned(16))) unsigned char lds_raw[];
    LAS unsigned char* lds = (LAS unsigned char*)lds_raw;
    volatile LAS unsigned* MISC = (volatile LAS unsigned*)(lds + LDSCTL_OFF);
    volatile LAS int* flags = (volatile LAS int*)(lds + LDSCTL_OFF + 128);
    LAS float* gtab = (LAS float*)(lds + GTAB_OFF);
    const int tid = threadIdx.x, lane = tid & 63, wave = __builtin_amdgcn_readfirstlane(tid >> 6);
    const int G = gridDim.x; const int bx = blockIdx.x; const int vcu = (G % 8 == 0) ? (bx % 8) * (G / 8) + bx / 8 : bx;
    for (int u = tid; u < 128; u += NWAVES * 64) ((LAS unsigned*)(lds + LDSCTL_OFF))[u] = 0u;
    __syncthreads();
    unsigned char* ws = args.ws;
    gu32* ctl = (gu32*)(ws + WS_CTL);
    XcdBarrier bar; bar.bar = (unsigned*)ctl + CW_BAR; bar.x = 0; bar.st = nullptr;
    if (ONE_LAUNCH) bar = xcd_barrier_post((unsigned*)ctl + CW_BAR, MISC + 8);
    const int lo = args.ph_lo, hi = args.ph_hi;
#define IN(k) (lo <= (k) && (k) < hi)
#define SEAM(k) do { if (ONE_LAUNCH && IN(k) && IN((k) + 1)) xcd_barrier(bar); } while (0)
    const float* x_prompt = args.in[0]; const float* x_sample = args.in[1];
    float* X = args.out + OUT_Y;
    bf16* XN = (bf16*)(ws + WS_XN); bf16* CK = (bf16*)(ws + WS_CK); bf16* CV = (bf16*)(ws + WS_CV);
    bf16* Qb = (bf16*)(ws + WS_Q); bf16* Kb = (bf16*)(ws + WS_K); bf16* Vb = (bf16*)(ws + WS_V); bf16* Hb = (bf16*)(ws + WS_H);
    const int gw = vcu * NWAVES + wave, NGW = G * NWAVES;
    const size_t gt = (size_t)vcu * (NWAVES * 64) + tid, NT = (size_t)G * (NWAVES * 64);

    if (IN(0)) {
        LAS float* scr = (LAS float*)(lds + RING_OFF + wave * 16384);
        constexpr int I_QKV = (D / 64) * (3 * D / 32), I_O = (D / 64) * (D / 32), I_UP = (D / 64) * (FF / 32), I_DN = (FF / 64) * (D / 32), I_L = I_QKV + I_O + I_UP + I_DN;
        for (int it = gw; it < 2 * I_L; it += NGW) {
            const int L = it / I_L; int r = it % I_L; unsigned char* wl = ws + WS_W + (size_t)L * W_LAYER;
            if (r < I_QKV) { transpose_item(args.in[5] + (size_t)L * D * 3 * D, D, 3 * D, (bf16*)(wl + W_QKV), scr, r, lane); continue; } r -= I_QKV;
            if (r < I_O) { transpose_item(args.in[6] + (size_t)L * D * D, D, D, (bf16*)(wl + W_O), scr, r, lane); continue; } r -= I_O;
            if (r < I_UP) { transpose_item(args.in[13] + (size_t)L * D * FF, D, FF, (bf16*)(wl + W_UP), scr, r, lane); continue; } r -= I_UP;
            transpose_item(args.in[14] + (size_t)L * FF * D, FF, D, (bf16*)(wl + W_DN), scr, r, lane);
        }
        cache_convert(args.in[2], args.in[3], CK, CV, gt, NT);
        xn_rows(x_prompt, x_sample, args.in[4], XN, gw, NGW, lane);
    }
    SEAM(0);

    layer_phases<0>(args, lds, flags, gtab, bar, lo, hi, G, vcu, tid, lane, wave);
    layer_phases<1>(args, lds, flags, gtab, bar, lo, hi, G, vcu, tid, lane, wave);
#undef IN
#undef SEAM
}

extern "C" void kernel_launch(void* const* d_in, const int* in_sizes, int n_in, void* d_out, int out_size, void* d_ws, size_t ws_size, hipStream_t stream) {
    static int grid = 0;
    if (grid == 0) {
        if (n_in != 16 || (size_t)out_size != OUT_END || ws_size < WS_END) { fprintf(stderr, "kernel_launch: unexpected shapes (n_in %d out %d ws %zu)\n", n_in, out_size, ws_size); grid = -1; return; }
        int dev = 0, cus = 0;
        if (hipGetDevice(&dev) != hipSuccess || hipDeviceGetAttribute(&cus, hipDeviceAttributeMultiprocessorCount, dev) != hipSuccess) { grid = -1; return; }
        if (hipFuncSetAttribute((const void*)fwd_kernel, hipFuncAttributeMaxDynamicSharedMemorySize, LDS_BYTES) != hipSuccess) { fprintf(stderr, "kernel_launch: hipFuncSetAttribute failed\n"); grid = -1; return; }
        int per_cu = 0;
        if (hipOccupancyMaxActiveBlocksPerMultiprocessor(&per_cu, (const void*)fwd_kernel, NWAVES * 64, LDS_BYTES) != hipSuccess || per_cu < 1) fprintf(stderr, "kernel_launch: occupancy query says %d\n", per_cu);
        (void)hipGetLastError();
        grid = cus;
    }
    if (grid < 0) return;
    (void)hipMemsetAsync((char*)d_ws + WS_CTL, 0, CTL_ZERO_BYTES, stream);
    Args a{};
    for (int i = 0; i < 16; ++i) a.in[i] = (const float*)d_in[i];
    a.out = (float*)d_out; a.ws = (unsigned char*)d_ws;
    if (ONE_LAUNCH) { a.ph_lo = 0; a.ph_hi = N_PHASES; hipLaunchKernelGGL(fwd_kernel, dim3(grid), dim3(NWAVES * 64), LDS_BYTES, stream, a); }
    else for (int p = 0; p < N_PHASES; ++p) { a.ph_lo = p; a.ph_hi = p + 1; hipLaunchKernelGGL(fwd_kernel, dim3(grid), dim3(NWAVES * 64), LDS_BYTES, stream, a); }
}
```

```cpp
#include <hip/hip_runtime.h>
#include <cstdio>
#include <cstdint>
constexpr int D = 2048, BATCH = 4, SEQ = 8192, DEC_B = 8, DEC_T = 16, PAST = 2048, FF = 8192;
constexpr int MP = BATCH * SEQ;
constexpr int MS = DEC_B * DEC_T;
constexpr int MV = MP + MS;
constexpr int M = 33024;
constexpr size_t QKV_WS_Q = (size_t)451 << 20, QKV_WS_STRIDE = (size_t)129 << 20;
constexpr size_t QKV_OUT_KP = (size_t)MV * D, QKV_OUT_VP = QKV_OUT_KP + 2 * (size_t)MP * D, QKV_OUT_KS = QKV_OUT_VP + 2 * (size_t)MP * D, QKV_OUT_VS = QKV_OUT_KS + 2 * (size_t)MS * D;
namespace pg8 {
#define PG8_LAS __attribute__((address_space(3)))
typedef unsigned short bf16_t;
typedef short bf16x8 __attribute__((ext_vector_type(8)));
typedef float f32x4 __attribute__((ext_vector_type(4)));
typedef unsigned u32x4 __attribute__((ext_vector_type(4)));
constexpr int BM = 256, BK = 64, HALF = 128, HTB = HALF * BK * 2  , STAGE_BYTES = 8 * HTB, NXCD = 8, WGM = 8;

__host__ __device__ __forceinline__ int lds_byte(int r, int c) { const int st = (r >> 4) * 2 + (c >> 5), rr = r & 15, cc = c & 31, ob = rr * 64 + cc * 2; return st * 1024 + (ob ^ (((ob >> 9) & 1) << 5)); }
__host__ __device__ __forceinline__ void stage_rc(int b, int& R, int& C) { const int st = b / 1024, sb = b % 1024, swz = sb ^ (((sb >> 9) & 1) << 5); R = (st >> 1) * 16 + swz / 64; C = (st & 1) * 32 + (swz % 64) / 2; }
__host__ __device__ __forceinline__ int perm32(int rho) { const int n = rho >> 4, i = rho & 15; return 8 * (i >> 2) + 4 * n + (i & 3); }

struct Unit { int pm, pn; };
struct Gemm { const bf16_t* A; const bf16_t* Bt; int M, N, K; };

struct StaticOrder {
    int nM, nN, nwg, G, c;
    __host__ __device__ void init(int M, int N, int G_, int c_) { nM = M / BM; nN = N / BM; nwg = nM * nN; G = G_; c = c_; }
    __host__ __device__ bool next(int i, Unit& u) const {
        const long L = (long)i * G + c; if (L >= nwg) return false;
        int wgid = (int)L; { const int q = nwg / NXCD, r = nwg % NXCD, xcd = wgid % NXCD, off = wgid / NXCD; wgid = (xcd < r ? xcd * (q + 1) : r * (q + 1) + (xcd - r) * q) + off; }
        const int nig = WGM * nN, gid = wgid / nig, fm = gid * WGM, gsz = (nM - fm) < WGM ? (nM - fm) : WGM;
        u.pm = fm + ((wgid % nig) % gsz); u.pn = (wgid % nig) / gsz; return true;
    }
    __device__ __forceinline__ void a_ready(const Unit&) const {}
    __device__ __forceinline__ void done(const Unit&) const {}
};

__device__ __forceinline__ unsigned cvt_pk_bf16(float lo, float hi) { unsigned r; asm volatile("v_cvt_pk_bf16_f32 %0, %1, %2" : "=v"(r) : "v"(lo), "v"(hi)); return r; }
typedef float f32x2 __attribute__((ext_vector_type(2)));
typedef unsigned u32x2 __attribute__((ext_vector_type(2)));
struct EpiQKV {
    static constexpr bool PERM = true, AFTER_DRAIN = false;
    unsigned char* ws; float* out; int L; float qscale;
    __device__ __forceinline__ void operator()(const f32x4 (&acc)[2][2][4][2], const Unit& u, int wr, int wc, int fr, int fq) const {
        const int row0 = u.pm * BM + wr * 64 + fr; const int t = u.pn >> 3; const int col0 = (u.pn & 7) * BM + wc * 32 + 8 * fq;
        bf16_t* ob = (bf16_t*)(ws + QKV_WS_Q + (size_t)t * QKV_WS_STRIDE);
        float* fp = out + (t == 1 ? QKV_OUT_KP : QKV_OUT_VP) + (size_t)L * MP * D; float* fs = out + (t == 1 ? QKV_OUT_KS : QKV_OUT_VS) + (size_t)L * MS * D;
        const float sc = t == 0 ? qscale : 1.f;
#pragma unroll
        for (int ai = 0; ai < 2; ++ai)
#pragma unroll
            for (int m = 0; m < 4; ++m) { const int row = row0 + ai * HALF + m * 16;
                float* frow = nullptr; if (t != 0) { if (row < MP) frow = fp + (size_t)row * D; else if (row < MV) frow = fs + (size_t)(row - MP) * D; }
                bf16_t* rowp = ob + (size_t)row * D + col0;
#pragma unroll
                for (int bj = 0; bj < 2; ++bj) { const f32x4 v0 = acc[ai][bj][m][0], v1 = acc[ai][bj][m][1];
                    u32x4 w; w.x = cvt_pk_bf16(v0[0] * sc, v0[1] * sc); w.y = cvt_pk_bf16(v0[2] * sc, v0[3] * sc); w.z = cvt_pk_bf16(v1[0] * sc, v1[1] * sc); w.w = cvt_pk_bf16(v1[2] * sc, v1[3] * sc);
                    *(u32x4*)(rowp + bj * HALF) = w;
                    if (frow) { *(f32x4*)(frow + col0 + bj * HALF) = v0; *(f32x4*)(frow + col0 + bj * HALF + 4) = v1; } } }
    }
};
struct EpiResid {
    static constexpr bool PERM = false, AFTER_DRAIN = false;
    const float* rp; const float* rs; float* out;
    __device__ __forceinline__ void operator()(const f32x4 (&acc)[2][2][4][2], const Unit& u, int wr, int wc, int fr, int fq) const {
        const int col0 = u.pn * BM + wc * 32 + 4 * fq;
#pragma unroll
        for (int ai = 0; ai < 2; ++ai)
#pragma unroll
            for (int m = 0; m < 4; ++m) { const int row = u.pm * BM + ai * HALF + wr * 64 + m * 16 + fr;
                if (row < MV) { const float* r = row < MP ? rp + (size_t)row * D : rs + (size_t)(row - MP) * D; float* o = out + (size_t)row * D;
#pragma unroll
                    for (int bj = 0; bj < 2; ++bj)
#pragma unroll
                        for (int n = 0; n < 2; ++n) { const int c = col0 + bj * HALF + n * 16; *(f32x4*)(o + c) = *(const f32x4*)(r + c) + acc[ai][bj][m][n]; } } }
    }
};
struct EpiRelu2 {
    static constexpr bool PERM = true, AFTER_DRAIN = false;
    bf16_t* O; int ldc;
    __device__ __forceinline__ void operator()(const f32x4 (&acc)[2][2][4][2], const Unit& u, int wr, int wc, int fr, int fq) const {
        const int row0 = u.pm * BM + wr * 64 + fr, col0 = u.pn * BM + wc * 32 + 8 * fq;
#pragma unroll
        for (int ai = 0; ai < 2; ++ai)
#pragma unroll
            for (int m = 0; m < 4; ++m) { bf16_t* rowp = O + (size_t)(row0 + ai * HALF + m * 16) * ldc + col0;
#pragma unroll
                for (int bj = 0; bj < 2; ++bj) { f32x4 v0 = acc[ai][bj][m][0], v1 = acc[ai][bj][m][1];
#pragma unroll
                    for (int e = 0; e < 4; ++e) { const float a = fmaxf(v0[e], 0.f), b = fmaxf(v1[e], 0.f); v0[e] = a * a; v1[e] = b * b; }
                    u32x4 w; w.x = cvt_pk_bf16(v0[0], v0[1]); w.y = cvt_pk_bf16(v0[2], v0[3]); w.z = cvt_pk_bf16(v1[0], v1[1]); w.w = cvt_pk_bf16(v1[2], v1[3]);
                    *(u32x4*)(rowp + bj * HALF) = w; } }
    }
};
template <class Epi, class Sched, bool ALIGN_EPI = false, bool SP2 = false>
__device__ __forceinline__ void gemm_phase(PG8_LAS unsigned char* lds, const Gemm g, const Sched& S, const Epi& E) {
    const int tid = threadIdx.x, wid = __builtin_amdgcn_readfirstlane(tid >> 6), lane = tid & 63, wr = wid >> 2, wc = wid & 3, fr = lane & 15, fq = lane >> 4;
    const int K = g.K, nt = K / BK;
    unsigned voffA[2], voffB[2];
#pragma unroll
    for (int i = 0; i < 2; ++i) { int R, C; stage_rc(tid * 16 + i * 8192, R, C); const int Rb = Epi::PERM ? ((R & ~31) + perm32(R & 31)) : R;
        voffA[i] = (unsigned)(R * K + C) * 2u; voffB[i] = (unsigned)(Rb * K + C) * 2u; }
    const size_t kstep = (size_t)(BK * 2);
    const size_t hstep = (size_t)HALF * K * 2;
    const size_t tstep = 2 * hstep;
    const unsigned ldsw = (unsigned)wid * 1024u;
    const int aoff = lds_byte(wr * 64 + fr, fq * 8), boff = lds_byte(wc * 32 + fr, fq * 8);
#define PG8_SA(b, h) (((b) * 2 + (h)) * HTB)
#define PG8_SB(b, h) ((4 + (b) * 2 + (h)) * HTB)
#define PG8_STAGE(bufoff, gbase, voff) do { _Pragma("unroll") for (int _i = 0; _i < 2; ++_i) \
        __builtin_amdgcn_global_load_lds((const unsigned*)((const char*)(gbase) + (voff)[_i]), (PG8_LAS unsigned*)(lds + (bufoff) + ldsw + _i * 8192), 16, 0, 0); } while (0)
#define PG8_LDA(dst, b, h) do { _Pragma("unroll") for (int m = 0; m < 4; ++m) _Pragma("unroll") for (int k = 0; k < 2; ++k) dst[m][k] = *(const PG8_LAS bf16x8*)(lds + PG8_SA(b, h) + aoff + m * 2048 + k * 1024); } while (0)
#define PG8_LDB(dst, b, h) do { _Pragma("unroll") for (int n = 0; n < 2; ++n) _Pragma("unroll") for (int k = 0; k < 2; ++k) dst[n][k] = *(const PG8_LAS bf16x8*)(lds + PG8_SB(b, h) + boff + n * 2048 + k * 1024); } while (0)
#define PG8_MMA(ai, bj, At, Bt) do { __builtin_amdgcn_s_setprio(1); _Pragma("unroll") for (int m = 0; m < 4; ++m) _Pragma("unroll") for (int n = 0; n < 2; ++n) _Pragma("unroll") for (int k = 0; k < 2; ++k) \
        acc[ai][bj][m][n] = __builtin_amdgcn_mfma_f32_16x16x32_bf16(Bt[n][k], At[m][k], acc[ai][bj][m][n], 0, 0, 0); __builtin_amdgcn_s_setprio(0); } while (0)
#define PG8_WAIT_V(n) asm volatile("s_waitcnt vmcnt(" #n ")" ::: "memory")
#define PG8_WAIT_L(n) asm volatile("s_waitcnt lgkmcnt(" #n ")" ::: "memory")
#define PG8_BAR __builtin_amdgcn_s_barrier()
#define PG8_SCHED __builtin_amdgcn_sched_barrier(0)
    Unit cur, nxt; int ui = 0;
    if (!S.next(0, cur)) return;
    f32x4 acc[2][2][4][2];
#pragma unroll
    for (int a = 0; a < 2; ++a)
#pragma unroll
        for (int b = 0; b < 2; ++b)
#pragma unroll
            for (int m = 0; m < 4; ++m)
#pragma unroll
                for (int n = 0; n < 2; ++n) acc[a][b][m][n] = (f32x4){0.f, 0.f, 0.f, 0.f};
    bf16x8 At[4][2], B0[2][2], B1[2][2];
    const char* cA = (const char*)g.A + (size_t)cur.pm * tstep; const char* cB = (const char*)g.Bt + (size_t)cur.pn * tstep;
    S.a_ready(cur);
    if constexpr (SP2) {
        PG8_STAGE(PG8_SB(0, 0), cB, voffB); PG8_STAGE(PG8_SB(0, 1), cB + hstep, voffB); PG8_STAGE(PG8_SA(0, 0), cA, voffA); PG8_STAGE(PG8_SA(0, 1), cA + hstep, voffA);
        if (wr == 1) PG8_BAR;
        PG8_WAIT_V(2); PG8_BAR;
        PG8_STAGE(PG8_SB(1, 0), cB + kstep, voffB); PG8_STAGE(PG8_SA(1, 0), cA + kstep, voffA); PG8_STAGE(PG8_SB(1, 1), cB + hstep + kstep, voffB);
        PG8_WAIT_V(6); PG8_BAR;
    } else {
        PG8_STAGE(PG8_SB(0, 0), cB, voffB); PG8_STAGE(PG8_SA(0, 0), cA, voffA); PG8_STAGE(PG8_SB(0, 1), cB + hstep, voffB); PG8_STAGE(PG8_SA(0, 1), cA + hstep, voffA);
        if (wr == 1) PG8_BAR;
        PG8_WAIT_V(4); PG8_BAR;
        PG8_STAGE(PG8_SB(1, 0), cB + kstep, voffB); PG8_STAGE(PG8_SA(1, 0), cA + kstep, voffA); PG8_STAGE(PG8_SB(1, 1), cB + hstep + kstep, voffB);
        PG8_WAIT_V(6); PG8_BAR;
    }
    for (;;) {
        const bool has_next = S.next(ui + 1, nxt);
        const char* nA = has_next ? (const char*)g.A + (size_t)nxt.pm * tstep : cA; const char* nB = has_next ? (const char*)g.Bt + (size_t)nxt.pn * tstep : cB;
        for (int t = 0; t < nt; t += 2) {
            const bool last = (t == nt - 2);
            const char* a1 = cA + (size_t)(t + 1) * kstep;
            const char* a2 = last ? nA : cA + (size_t)(t + 2) * kstep; const char* b2 = last ? nB : cB + (size_t)(t + 2) * kstep;
            const char* a3 = a2 + kstep; const char* b3 = b2 + kstep;
            if (last && has_next) S.a_ready(nxt);
            if constexpr (SP2) {
            PG8_LDB(B0, 0, 0); PG8_LDB(B1, 0, 1); PG8_SCHED; PG8_LDA(At, 0, 0); PG8_STAGE(PG8_SA(1, 1), a1 + hstep, voffA);
            PG8_WAIT_V(8); PG8_WAIT_L(0); PG8_BAR; PG8_MMA(0, 0, At, B0); PG8_MMA(0, 1, At, B1); PG8_BAR; PG8_SCHED;
            PG8_LDA(At, 0, 1); PG8_STAGE(PG8_SB(0, 0), b2, voffB); PG8_STAGE(PG8_SB(0, 1), b2 + hstep, voffB); PG8_STAGE(PG8_SA(0, 0), a2, voffA);
            PG8_WAIT_V(8); PG8_WAIT_L(0); PG8_BAR; PG8_MMA(1, 0, At, B0); PG8_MMA(1, 1, At, B1); PG8_BAR; PG8_SCHED;
            PG8_LDB(B0, 1, 0); PG8_LDB(B1, 1, 1); PG8_SCHED; PG8_LDA(At, 1, 0); PG8_STAGE(PG8_SA(0, 1), a2 + hstep, voffA);
            PG8_WAIT_V(8); PG8_WAIT_L(0); PG8_BAR; PG8_MMA(0, 0, At, B0); PG8_MMA(0, 1, At, B1); PG8_BAR; PG8_SCHED;
            PG8_LDA(At, 1, 1); PG8_STAGE(PG8_SB(1, 0), b3, voffB); PG8_STAGE(PG8_SB(1, 1), b3 + hstep, voffB); PG8_STAGE(PG8_SA(1, 0), a3, voffA);
            PG8_WAIT_V(8); PG8_WAIT_L(0); PG8_BAR; PG8_MMA(1, 0, At, B0); PG8_MMA(1, 1, At, B1); PG8_BAR; PG8_SCHED;
            } else {
            PG8_LDB(B0, 0, 0); PG8_SCHED; PG8_LDA(At, 0, 0); PG8_STAGE(PG8_SA(1, 1), a1 + hstep, voffA);
            PG8_WAIT_L(8); PG8_BAR; PG8_WAIT_L(0); PG8_MMA(0, 0, At, B0); PG8_BAR; PG8_SCHED;
            PG8_LDB(B1, 0, 1); PG8_STAGE(PG8_SB(0, 0), b2, voffB);
            PG8_BAR; PG8_WAIT_L(0); PG8_MMA(0, 1, At, B1); PG8_BAR;
            PG8_LDA(At, 0, 1); PG8_STAGE(PG8_SA(0, 0), a2, voffA);
            PG8_BAR; PG8_WAIT_L(0); PG8_MMA(1, 0, At, B0); PG8_BAR; PG8_SCHED;
            PG8_STAGE(PG8_SB(0, 1), b2 + hstep, voffB);
            PG8_WAIT_V(6); PG8_BAR; PG8_MMA(1, 1, At, B1); PG8_BAR;
            PG8_LDB(B0, 1, 0); PG8_SCHED; PG8_LDA(At, 1, 0); PG8_STAGE(PG8_SA(0, 1), a2 + hstep, voffA);
            PG8_WAIT_L(8); PG8_BAR; PG8_WAIT_L(0); PG8_MMA(0, 0, At, B0); PG8_BAR; PG8_SCHED;
            PG8_LDB(B1, 1, 1); PG8_STAGE(PG8_SB(1, 0), b3, voffB);
            PG8_BAR; PG8_WAIT_L(0); PG8_MMA(0, 1, At, B1); PG8_BAR;
            PG8_LDA(At, 1, 1); PG8_STAGE(PG8_SA(1, 0), a3, voffA);
            PG8_BAR; PG8_WAIT_L(0); PG8_MMA(1, 0, At, B0); PG8_BAR; PG8_SCHED;
            PG8_STAGE(PG8_SB(1, 1), b3 + hstep, voffB);
            PG8_WAIT_V(6); PG8_BAR; PG8_MMA(1, 1, At, B1); PG8_BAR;
            }
        }
        if constexpr (ALIGN_EPI) { if (wr == 0) PG8_BAR; }
        if constexpr (!Epi::AFTER_DRAIN) { E(acc, cur, wr, wc, fr, fq); S.done(cur); }
        if (!has_next) break;
#pragma unroll
        for (int a = 0; a < 2; ++a)
#pragma unroll
            for (int b = 0; b < 2; ++b)
#pragma unroll
                for (int m = 0; m < 4; ++m)
#pragma unroll
                    for (int n = 0; n < 2; ++n) acc[a][b][m][n] = (f32x4){0.f, 0.f, 0.f, 0.f};
        cur = nxt; cA = nA; cB = nB; ++ui;
        if constexpr (ALIGN_EPI) { if (wr == 1) PG8_BAR; }
    }
    PG8_WAIT_V(0);
    if constexpr (!ALIGN_EPI) { if (wr == 0) PG8_BAR; }
    PG8_BAR;
    if constexpr (Epi::AFTER_DRAIN) { E.fused(acc, cur, wr, wc, fr, fq, lds, wid, lane); S.done(cur); }
#undef PG8_SA
#undef PG8_SB
#undef PG8_STAGE
#undef PG8_LDA
#undef PG8_LDB
#undef PG8_MMA
#undef PG8_WAIT_V
#undef PG8_WAIT_L
#undef PG8_BAR
#undef PG8_SCHED
}
}
#ifndef PG8_SP2
#define PG8_SP2 true
#endif
#ifndef PG8_ALIGN
#define PG8_ALIGN true
#endif
constexpr int NWAVES = 8;
#ifndef MK_N_LAUNCHES
#define MK_N_LAUNCHES 1
#endif
constexpr int N_PHASES = 15;
constexpr bool ONE_LAUNCH = (MK_N_LAUNCHES == 1);

constexpr size_t MiB = 1u << 20;
constexpr size_t WS_CTL = 0, CTL_ZERO_BYTES = 1 * MiB;
constexpr size_t WS_W = 2 * MiB;
constexpr size_t W_LAYER = 96 * MiB, W_QKV = 0, W_O = 24 * MiB, W_UP = 32 * MiB, W_DN = 64 * MiB;
constexpr size_t WS_XN = 194 * MiB;
constexpr size_t WS_CK = 323 * MiB, WS_CV = 387 * MiB;
constexpr size_t WS_Q = 451 * MiB, WS_K = 580 * MiB, WS_V = 709 * MiB;
constexpr size_t WS_H = WS_Q;
constexpr size_t WS_END = 967 * MiB;
static_assert(WS_H + (size_t)M * FF * 2 <= WS_END && WS_V + (size_t)M * D * 2 <= WS_END && WS_XN + (size_t)M * D * 2 <= WS_CK && WS_W + 2 * W_LAYER <= WS_XN, "d_ws map");
static_assert(QKV_WS_Q == WS_Q && WS_K == WS_Q + QKV_WS_STRIDE && WS_V == WS_Q + 2 * QKV_WS_STRIDE, "QKV epilogue map");
constexpr int CW_TMO = 0;
constexpr int CW_BAR = 4096;

constexpr size_t OUT_Y = 0, OUT_KP = (size_t)MV * D, OUT_VP = OUT_KP + 2 * (size_t)MP * D, OUT_KS = OUT_VP + 2 * (size_t)MP * D, OUT_VS = OUT_KS + 2 * (size_t)MS * D, OUT_END = OUT_VS + 2 * (size_t)MS * D;
static_assert(OUT_KP == QKV_OUT_KP && OUT_VP == QKV_OUT_VP && OUT_KS == QKV_OUT_KS && OUT_VS == QKV_OUT_VS, "QKV epilogue map");

constexpr int RING_OFF = 0, RING_BYTES = 131072;
constexpr int LDSCTL_OFF = RING_BYTES;
constexpr int GTAB_OFF = LDSCTL_OFF + 1024;
constexpr int LDS_BYTES = 147456;
static_assert(GTAB_OFF + 1024 <= LDS_BYTES, "LDS map");

#define GAS __attribute__((address_space(1)))
#define LAS __attribute__((address_space(3)))
typedef unsigned short bf16;
typedef unsigned v4u __attribute__((ext_vector_type(4)));
typedef unsigned v2u __attribute__((ext_vector_type(2)));
typedef float f32x4 __attribute__((ext_vector_type(4)));
typedef GAS unsigned gu32;
#define RLX_AGENT __ATOMIC_RELAXED, __HIP_MEMORY_SCOPE_AGENT
#define LDS_WAIT() asm volatile("s_waitcnt lgkmcnt(0)" ::: "memory")
#define VM_WAIT() asm volatile("s_waitcnt vmcnt(0)" ::: "memory")
typedef float f32x2_t __attribute__((ext_vector_type(2))); typedef __bf16 bf16x2_t __attribute__((ext_vector_type(2)));
__device__ __forceinline__ unsigned pk2(float lo, float hi) { f32x2_t v = {lo, hi}; bf16x2_t b = __builtin_convertvector(v, bf16x2_t); return __builtin_bit_cast(unsigned, b); }
__device__ __forceinline__ float wave_sum(float v) {
#pragma unroll
    for (int o = 1; o < 64; o <<= 1) v += __shfl_xor(v, o);
    return v;
}
#define XB_TMO      128
#define XB_XCNT(j)  (256  + 64 * (j))
#define XB_XSUB(j)  (1280 + 64 * (j))
#define XB_XGEN(j)  (2304 + 64 * (j))
#define XB_TOP      3328
#define XB_TOPGEN   3392
#define XCD_BAR_WORDS 3456
#define XB_SPIN_CAP (1u << 18)

__device__ __forceinline__ unsigned xb_ld(unsigned* p)              { return __hip_atomic_load(p, __ATOMIC_RELAXED, __HIP_MEMORY_SCOPE_AGENT); }
__device__ __forceinline__ unsigned xb_add(unsigned* p, unsigned v) { return __hip_atomic_fetch_add(p, v, __ATOMIC_RELAXED, __HIP_MEMORY_SCOPE_AGENT); }
__device__ __forceinline__ unsigned xb_xcc_id() { return (unsigned)__builtin_amdgcn_s_getreg((3 << 11) | 20) & 0xFu; }
#define XB_SPIN(cond, bar) do { unsigned _sp = 0; while (cond) { __builtin_amdgcn_s_sleep(1); \
    if ((++_sp & 255u) == 0u) { if (xb_ld(&(bar)[XB_TMO])) break; if (_sp > XB_SPIN_CAP) { atomicAdd(&(bar)[XB_TMO], 1u); break; } } } } while (0)

struct XcdBarrier {
    unsigned* bar; unsigned x;
    volatile LAS unsigned* st;
};

__device__ __forceinline__ XcdBarrier xcd_barrier_post(unsigned* bar, volatile LAS unsigned* st) {
    XcdBarrier b; b.bar = bar; b.x = xb_xcc_id(); b.st = st;
    if (threadIdx.x == 0) (void)xb_add(&bar[XB_XCNT(b.x)], 1u);
    return b;
}
__device__ __forceinline__ void xcd_barrier_complete(unsigned* bar, unsigned x, unsigned& nloc, unsigned& nx) {
    const unsigned G = gridDim.x * gridDim.y * gridDim.z;
    unsigned sum, cnt, mine, sp = 0u;
    for (;;) {
        sum = 0u; cnt = 0u; mine = 0u;
#pragma unroll
        for (unsigned j = 0; j < 16; ++j) { const unsigned c = xb_ld(&bar[XB_XCNT(j)]); sum += c; cnt += (c > 0u) ? 1u : 0u; mine = (j == x) ? c : mine; }
        if (sum == G) break;
        __builtin_amdgcn_s_sleep(1);
        if ((++sp & 255u) == 0u) { if (xb_ld(&bar[XB_TMO])) break; if (sp > XB_SPIN_CAP) { atomicAdd(&bar[XB_TMO], 1u); break; } }
    }
    nloc = mine > 0u ? mine : 1u; nx = cnt > 0u ? cnt : 1u;
}

__device__ __forceinline__ void xcd_barrier(const XcdBarrier& b) {
    asm volatile("s_waitcnt vmcnt(0)" ::: "memory");
    __syncthreads();
    if (threadIdx.x == 0) {
        unsigned* bar = b.bar;
        __builtin_amdgcn_s_waitcnt(0);
        unsigned nloc = b.st[0], nx = b.st[1];
        if (nloc == 0u) { xcd_barrier_complete(bar, b.x, nloc, nx); b.st[0] = nloc; b.st[1] = nx; }
        const unsigned old = xb_add(&bar[XB_XSUB(b.x)], 1u);
        const unsigned gen = old / nloc;
        if (old + 1u == (gen + 1u) * nloc) {
            __builtin_amdgcn_fence(__ATOMIC_RELEASE, "agent");
            asm volatile("s_waitcnt vmcnt(0)" ::: "memory");
            const unsigned og = xb_add(&bar[XB_TOP], 1u);
            const unsigned tg = og / nx;
            if (og + 1u == (tg + 1u) * nx) xb_add(&bar[XB_TOPGEN], 1u);
            else XB_SPIN(xb_ld(&bar[XB_TOPGEN]) == tg, bar);
            __builtin_amdgcn_fence(__ATOMIC_ACQUIRE, "agent");
            xb_add(&bar[XB_XGEN(b.x)], 1u);
            asm volatile("s_waitcnt vmcnt(0)" ::: "memory");
        } else {
            XB_SPIN(xb_ld(&bar[XB_XGEN(b.x)]) == gen, bar);
            __builtin_amdgcn_fence(__ATOMIC_ACQUIRE, "agent");
            asm volatile("s_waitcnt vmcnt(0)" ::: "memory");
        }
    }
    __syncthreads();
}
namespace att {
typedef short bf16x8 __attribute__((ext_vector_type(8)));
typedef short s16x4 __attribute__((ext_vector_type(4)));
typedef short v4i16_t __attribute__((ext_vector_type(4)));
typedef float f32x16 __attribute__((ext_vector_type(16)));
typedef LAS unsigned char* lptr;
constexpr float LOG2E = 1.4426950408889634f;
constexpr float QSCALE = 0.08838834764831845f * 1.4426950408889634f;
constexpr float SB_DONE = -150.0f;

__device__ __forceinline__ s16x4 vtr(const LAS unsigned char* p) { return __builtin_bit_cast(s16x4, __builtin_amdgcn_ds_read_tr16_b64_v4i16((LAS v4i16_t*)p)); }
__device__ __forceinline__ float swap_lo(float x, float& other_hi) { auto rr = __builtin_amdgcn_permlane32_swap(__float_as_uint(x), __float_as_uint(x), false, false); other_hi = __uint_as_float(rr[1]); return __uint_as_float(rr[0]); }

template <int KW, int VW, int TK> struct KVStage {
    static constexpr int KBYTES = TK * KW * 2, VBYTES = TK * VW * 2, BUF = KBYTES + VBYTES, NK = KBYTES / 8192, NV = VBYTES / 8192, VDB = TK * 64  ;
    unsigned voffK[NK], voffV[NV];
    __device__ __forceinline__ void init(int wid, int lane) {
#pragma unroll
        for (int j = 0; j < NK; ++j) { const int pos = (wid * NK + j) * 64 + lane; int row, c16;
            if (KW == 128) { row = pos >> 4; c16 = (pos & 15) ^ (row & 15); } else { row = pos >> 5; c16 = ((pos >> 4) & 1) * 16 + ((pos & 15) ^ (row & 15)); }
            voffK[j] = (unsigned)(row * D + c16 * 8) * 2u; }
#pragma unroll
        for (int j = 0; j < NV; ++j) { const int pos = (wid * NV + j) * 64 + lane; const int dblk = pos / (TK * 4), row = (pos >> 2) % TK, sub = pos & 3;
            voffV[j] = (unsigned)(row * D + (dblk * 4 + sub) * 8) * 2u; }
    }
    __device__ __forceinline__ void issue(lptr buf, const bf16* kp, const bf16* vp, int wid) const {
#pragma unroll
        for (int j = 0; j < NK; ++j) __builtin_amdgcn_global_load_lds((const unsigned*)((const char*)kp + voffK[j]), (LAS unsigned*)(buf + (wid * NK + j) * 1024), 16, 0, 0);
#pragma unroll
        for (int j = 0; j < NV; ++j) __builtin_amdgcn_global_load_lds((const unsigned*)((const char*)vp + voffV[j]), (LAS unsigned*)(buf + KBYTES + (wid * NV + j) * 1024), 16, 0, 0);
    }
};

template <int KPITCH> __device__ __forceinline__ void qkt1(f32x16& p, const LAS unsigned char* Kb, int mp, const bf16x8* qr, int r32, int hi) {
    const int xk = (r32 & 15) << 4; const LAS unsigned char* k0 = Kb + r32 * KPITCH + mp * 256;
#pragma unroll
    for (int ks = 0; ks < 8; ++ks) { const int cb = (ks * 32 + hi * 16) ^ xk;
        const bf16x8 a0 = *(const LAS bf16x8*)(k0 + cb);
        p = __builtin_amdgcn_mfma_f32_32x32x16_bf16(a0, qr[ks], p, 0, 0, 0); }
}
template <int NDB, int NS, int VDB> __device__ __forceinline__ void pv(f32x16* o, const LAS unsigned char* Vb, int lane, const bf16x8* pf) {
    const LAS unsigned char* vb = Vb + (4 * (lane >> 5) + ((lane & 15) >> 2)) * 64 + ((lane >> 4) & 1) * 32 + (lane & 3) * 8;
#pragma unroll
    for (int db = 0; db < NDB; ++db)
#pragma unroll
        for (int s = 0; s < NS; ++s) { const s16x4 lo = vtr(vb + db * VDB + s * 1024), hi4 = vtr(vb + db * VDB + s * 1024 + 512);
            const bf16x8 vf = (bf16x8){lo[0], lo[1], lo[2], lo[3], hi4[0], hi4[1], hi4[2], hi4[3]};
            o[db] = __builtin_amdgcn_mfma_f32_32x32x16_bf16(vf, pf[s], o[db], 0, 0, 0);
            if (NDB == 8 && (db & 1) == 1 && s == NS - 1) __builtin_amdgcn_sched_barrier(0); }
}
__device__ __forceinline__ void pack_p(bf16x8* pf, const f32x16& p) {
#pragma unroll
    for (int s = 0; s < 2; ++s) { v4u a;
        a.x = pk2(p[8 * s + 0], p[8 * s + 1]); a.y = pk2(p[8 * s + 2], p[8 * s + 3]); a.z = pk2(p[8 * s + 4], p[8 * s + 5]); a.w = pk2(p[8 * s + 6], p[8 * s + 7]);
        pf[s] = __builtin_bit_cast(bf16x8, a); }
}

template <bool SAMPLE>
__device__ __forceinline__ void sb_unit(lptr ring, volatile LAS int* flags, const bf16* Qb, const bf16* Kb, const bf16* Vb, const bf16* CK, const bf16* CV, bf16* Ob,
                                        int b, int h, int qb, int wid, int lane) {
    KVStage<128, 128, 64> st; st.init(wid, lane);
    constexpr int BUF = KVStage<128, 128, 64>::BUF, KBYTES = KVStage<128, 128, 64>::KBYTES;
    const int r32 = lane & 31, hi = lane >> 5;
    const int qbase = SAMPLE ? PAST : 256 * qb + 32 * wid;
    const int qpos = qbase + r32;
    const size_t qrow = SAMPLE ? (size_t)(MP + 16 * b + r32) : (size_t)b * SEQ + qpos;
    const bool live = SAMPLE ? (wid == 0) : true;
    const bool rvalid = SAMPLE ? (wid == 0 && r32 < 16) : true;
    const int jt_hi = SAMPLE ? 32 : 4 * qb + 3;
    const int coff = h * 128;
    bf16x8 qr[8];
#pragma unroll
    for (int ks = 0; ks < 8; ++ks) qr[ks] = *(const bf16x8*)(Qb + qrow * D + coff + ks * 16 + hi * 8);
    f32x16 o[4];
#pragma unroll
    for (int i = 0; i < 4; ++i) o[i] = f32x16{};
    float C = 0.f;
#define SB_TILE_PTRS(jt_, kp_, vp_) do { size_t off_; \
        if (!SAMPLE) { off_ = ((size_t)b * SEQ + 64 * (size_t)(jt_)) * D + coff; kp_ = Kb + off_; vp_ = Vb + off_; } \
        else if ((jt_) == 32) { off_ = (size_t)(MP + 16 * b) * D + coff; kp_ = Kb + off_; vp_ = Vb + off_; } \
        else { off_ = ((size_t)b * PAST + 64 * (size_t)(jt_)) * D + coff; kp_ = CK + off_; vp_ = CV + off_; } } while (0)
    int jt = jt_hi, it = 0;
    { const bf16 *kp, *vp; SB_TILE_PTRS(jt, kp, vp); st.issue(ring, kp, vp, wid); }
    VM_WAIT(); __syncthreads();
    bool wdone = !live;
    for (;;) {
        const lptr cur = ring + (it & 1) * BUF, nxt = ring + ((it & 1) ^ 1) * BUF;
        const bool has_next = jt > 0;
        if (has_next) { const bf16 *kp, *vp; SB_TILE_PTRS(jt - 1, kp, vp); st.issue(nxt, kp, vp, wid); }
        const int kmin = 64 * jt;
        if (!wdone && kmin < qbase + 31) {
            f32x16 p0 = f32x16{}, p1 = f32x16{};
            qkt1<256>(p0, cur, 0, qr, r32, hi); qkt1<256>(p1, cur + 32 * 256, 0, qr, r32, hi);
            f32x16 L0, L1;
#pragma unroll
            for (int r = 0; r < 16; ++r) {
                const float z0 = p0[r], z1 = p1[r];
                L0[r] = -(fmaxf(z0, 0.f) + __builtin_amdgcn_logf(1.0f + __builtin_amdgcn_exp2f(-fabsf(z0))));
                L1[r] = -(fmaxf(z1, 0.f) + __builtin_amdgcn_logf(1.0f + __builtin_amdgcn_exp2f(-fabsf(z1)))); }
            const bool need_mask = (kmin + 63 >= qbase);
            if (need_mask) {
                const float df = (float)(qpos - kmin - 4 * hi);
#pragma unroll
                for (int r = 0; r < 16; ++r) { const float c = (float)((r & 3) + 8 * (r >> 2));
                    const float f0 = __builtin_amdgcn_fmed3f(df - c, 0.f, 1.f), f1 = __builtin_amdgcn_fmed3f(df - (c + 32.f), 0.f, 1.f);
                    L0[r] *= f0; p0[r] += f0 * 1e30f - 1e30f; L1[r] *= f1; p1[r] += f1 * 1e30f - 1e30f; } }
            float T[8];
#pragma unroll
            for (int g = 0; g < 4; ++g) {
                L0[4 * g + 2] += L0[4 * g + 3]; L0[4 * g + 1] += L0[4 * g + 2]; L0[4 * g] += L0[4 * g + 1]; T[g] = L0[4 * g];
                L1[4 * g + 2] += L1[4 * g + 3]; L1[4 * g + 1] += L1[4 * g + 2]; L1[4 * g] += L1[4 * g + 1]; T[4 + g] = L1[4 * g]; }
            float off[8]; float run = 0.f;
#pragma unroll
            for (int g = 7; g >= 0; --g) { float t1; const float t0 = swap_lo(T[g], t1); off[g] = C + run + (hi == 0 ? t1 : 0.f); run += t0 + t1; }
#pragma unroll
            for (int g = 0; g < 4; ++g)
#pragma unroll
                for (int i = 0; i < 4; ++i) { const int r = 4 * g + i;
                    p0[r] = __builtin_amdgcn_exp2f(p0[r] + L0[r] + off[g]);
                    p1[r] = __builtin_amdgcn_exp2f(p1[r] + L1[r] + off[4 + g]); }
            C += run;
            bf16x8 pf[4]; pack_p(pf, p0); pack_p(pf + 2, p1);
            pv<4, 4, 4096>(o, cur + KBYTES, lane, pf);
            wdone = __all((!rvalid) || (C < SB_DONE));
        }
        if (lane == 0) flags[(it & 1) * 8 + wid] = wdone ? 1 : 0;
        VM_WAIT(); LDS_WAIT(); __syncthreads();
        if (!has_next) break;
        int all = 1;
#pragma unroll
        for (int w = 0; w < 8; ++w) all &= flags[(it & 1) * 8 + w];
        if (all) break;
        --jt; ++it;
    }
#undef SB_TILE_PTRS
    if (rvalid) {
#pragma unroll
        for (int db = 0; db < 4; ++db)
#pragma unroll
            for (int gq = 0; gq < 4; ++gq) { v2u w; w.x = pk2(o[db][4 * gq], o[db][4 * gq + 1]); w.y = pk2(o[db][4 * gq + 2], o[db][4 * gq + 3]);
                *(v2u*)(Ob + qrow * D + coff + 32 * db + 8 * gq + 4 * hi) = w; }
    }
}

template <bool SAMPLE>
__device__ __forceinline__ void diff_unit(lptr ring, const LAS float* gtab, const bf16* Qb, const bf16* Kb, const bf16* Vb, const bf16* CK, const bf16* CV, bf16* Ob,
                                          int b, int h8, int qb, float lam, int wid, int lane) {
    asm volatile("" : "+v"(lane));
    KVStage<256, 256, 32> st; st.init(wid, lane);
    constexpr int BUF = KVStage<256, 256, 32>::BUF, KBYTES = KVStage<256, 256, 32>::KBYTES, VDB = KVStage<256, 256, 32>::VDB;
    const int r32 = lane & 31, hi = lane >> 5, mp = wid >> 2, sb = wid & 3;
    const int qbase = SAMPLE ? PAST : 128 * qb + 32 * sb;
    const int qpos = qbase + r32;
    const size_t qrow = SAMPLE ? (size_t)(MP + 16 * b + r32) : (size_t)b * SEQ + qpos;
    const bool live = SAMPLE ? (sb == 0) : true;
    const bool rvalid = SAMPLE ? (sb == 0 && r32 < 16) : true;
    const int wchunk = SAMPLE ? 32 : (qbase >> 6);
    const int jt_hi = SAMPLE ? 64 : 4 * qb + 3;
    const int coff = h8 * 256;
    const float slope2 = __builtin_amdgcn_exp2f(-(float)(h8 + 1)) * LOG2E;
    const int xk = (r32 & 15) << 4;
    const lptr qs = ring + 65536 + wid * 8192 + lane * 16;
#pragma unroll
    for (int ks = 0; ks < 8; ++ks) *(LAS bf16x8*)(qs + ks * 1024) = *(const bf16x8*)(Qb + qrow * D + coff + mp * 128 + ks * 16 + hi * 8);
    f32x16 o[8];
#pragma unroll
    for (int i = 0; i < 8; ++i) o[i] = f32x16{};
    float m = -INFINITY, l = 0.f;
#define DF_TILE_PTRS(jt_, kp_, vp_) do { size_t off_; \
        if (!SAMPLE) { off_ = ((size_t)b * SEQ + 32 * (size_t)(jt_)) * D + coff; kp_ = Kb + off_; vp_ = Vb + off_; } \
        else if ((jt_) == 64) { off_ = (size_t)(MP + 16 * b) * D + coff; kp_ = Kb + off_; vp_ = Vb + off_; } \
        else { off_ = ((size_t)b * PAST + 32 * (size_t)(jt_)) * D + coff; kp_ = CK + off_; vp_ = CV + off_; } } while (0)
    { const bf16 *kp, *vp; DF_TILE_PTRS(jt_hi, kp, vp); st.issue(ring, kp, vp, wid); }
    VM_WAIT(); LDS_WAIT(); __syncthreads();
    int it = 0;
    for (int jt = jt_hi; jt >= 0; --jt, ++it) {
        const lptr cur = ring + (it & 1) * BUF, nxt = ring + ((it & 1) ^ 1) * BUF;
        if (jt > 0) { const bf16 *kp, *vp; DF_TILE_PTRS(jt - 1, kp, vp); st.issue(nxt, kp, vp, wid); }
        if (live && (jt >> 1) <= wchunk) {
            f32x16 p = f32x16{};
            { const LAS unsigned char* k0 = cur + r32 * 512 + mp * 256;
#pragma unroll
              for (int ks = 0; ks < 8; ++ks) { const int cb = (ks * 32 + hi * 16) ^ xk;
                  p = __builtin_amdgcn_mfma_f32_32x32x16_bf16(*(const LAS bf16x8*)(k0 + cb), *(const LAS bf16x8*)(qs + ks * 1024), p, 0, 0, 0);
                  if ((ks & 1) == 1) __builtin_amdgcn_sched_barrier(0); } }
            const float dqf = (float)(qpos - 32 * jt - 4 * hi);
#pragma unroll
            for (int r = 0; r < 16; ++r) { const float c = (float)((r & 3) + 8 * (r >> 2)); p[r] = fmaf(-slope2, fabsf(dqf - c), p[r]); }
            if (SAMPLE && jt == 64) {
#pragma unroll
                for (int r = 8; r < 16; ++r) p[r] = -INFINITY; }
            float tm = p[0];
#pragma unroll
            for (int r = 1; r < 16; ++r) tm = fmaxf(tm, p[r]);
            { float t1; const float t0 = swap_lo(tm, t1); tm = fmaxf(t0, t1); }
            if (__any(tm > m)) { const float mn = fmaxf(m, tm); const float alpha = __builtin_amdgcn_exp2f(m - mn); m = mn; l *= alpha;
#pragma unroll
                for (int db = 0; db < 8; ++db)
#pragma unroll
                    for (int r = 0; r < 16; ++r) o[db][r] *= alpha; }
            float ps = 0.f;
#pragma unroll
            for (int r = 0; r < 16; ++r) { p[r] = __builtin_amdgcn_exp2f(p[r] - m); ps += p[r]; }
            l += ps;
            bf16x8 pf[2]; pack_p(pf, p);
            pv<8, 2, VDB>(o, cur + KBYTES, lane, pf);
        }
        VM_WAIT(); LDS_WAIT(); __syncthreads();
    }
#undef DF_TILE_PTRS
    { float t1; const float t0 = swap_lo(l, t1); l = t0 + t1; }
    const float inv = live ? 1.0f / l : 0.f;
    const lptr xb = ring + sb * 32768 + lane * 16;
    if (mp == 1) { const float sc = lam * inv;
#pragma unroll
        for (int v = 0; v < 32; ++v) { const int db = v >> 2, gq = v & 3; f32x4 x = {o[db][4 * gq] * sc, o[db][4 * gq + 1] * sc, o[db][4 * gq + 2] * sc, o[db][4 * gq + 3] * sc};
            *(LAS f32x4*)(xb + v * 1024) = x; } }
    LDS_WAIT(); __syncthreads();
    if (mp == 0) { float ss = 0.f;
#pragma unroll
        for (int v = 0; v < 32; ++v) { const int db = v >> 2, gq = v & 3; const f32x4 x = *(const LAS f32x4*)(xb + v * 1024);
#pragma unroll
            for (int e = 0; e < 4; ++e) { const float y = o[db][4 * gq + e] * inv - x[e]; o[db][4 * gq + e] = y; ss += y * y; }
            if ((v & 3) == 3) asm volatile("" ::: "memory"); }
        { float t1; const float t0 = swap_lo(ss, t1); ss = t0 + t1; }
        const float rs = 1.0f / sqrtf(ss * (1.0f / 256.0f) + 1e-5f);
        if (rvalid) {
#pragma unroll
            for (int v = 0; v < 32; ++v) { const int db = v >> 2, gq = v & 3; const int d0 = 32 * db + 8 * gq + 4 * hi; const f32x4 g4 = *(const LAS f32x4*)(gtab + d0);
                v2u w; w.x = pk2(o[db][4 * gq] * rs * g4[0], o[db][4 * gq + 1] * rs * g4[1]); w.y = pk2(o[db][4 * gq + 2] * rs * g4[2], o[db][4 * gq + 3] * rs * g4[3]);
                *(v2u*)(Ob + qrow * D + coff + d0) = w;
                if ((v & 3) == 3) asm volatile("" ::: "memory"); } }
    }
    LDS_WAIT(); __syncthreads();
}
}
__device__ __forceinline__ void transpose_item(const float* W, int K, int N, bf16* WT, LAS float* scr, int item, int lane) {
    const int nblk = N / 32, kb = item / nblk, nb = item % nblk, k0 = 64 * kb, n0 = 32 * nb;
#pragma unroll 8
    for (int i = 0; i < 32; ++i) { const int kk = 2 * i + (lane >> 5); scr[kk * 33 + (lane & 31)] = W[(size_t)(k0 + kk) * N + n0 + (lane & 31)]; }
    LDS_WAIT(); asm volatile("" ::: "memory");
    const int c = lane & 7;
#pragma unroll
    for (int j = 0; j < 4; ++j) { const int n = (lane >> 3) + 8 * j; const LAS float* s = scr + (8 * c) * 33 + n;
        v4u o; o.x = pk2(s[0 * 33], s[1 * 33]); o.y = pk2(s[2 * 33], s[3 * 33]); o.z = pk2(s[4 * 33], s[5 * 33]); o.w = pk2(s[6 * 33], s[7 * 33]);
        *(v4u*)(WT + (size_t)(n0 + n) * K + k0 + 8 * c) = o; }
    LDS_WAIT(); asm volatile("" ::: "memory");
}
__device__ __forceinline__ void xn_rows(const float* srcp, const float* srcs, const float* g, bf16* XN, int gw, int NGW, int lane) {
    for (int m = gw; m < M; m += NGW) {
        v2u* o8 = (v2u*)(XN + (size_t)m * D) + lane;
        if (m < MV) {
            const f32x4* xr = (const f32x4*)(m < MP ? srcp + (size_t)m * D : srcs + (size_t)(m - MP) * D) + lane;
            f32x4 v[8]; float ss = 0.f;
#pragma unroll
            for (int j = 0; j < 8; ++j) { v[j] = xr[64 * j]; ss += (v[j].x * v[j].x + v[j].y * v[j].y) + (v[j].z * v[j].z + v[j].w * v[j].w); }
            const float rs = 1.0f / sqrtf(wave_sum(ss) * (1.0f / D) + 1e-6f);
#pragma unroll
            for (int j = 0; j < 8; ++j) { const f32x4 gv = ((const f32x4*)g)[lane + 64 * j]; v2u w; w.x = pk2(v[j].x * rs * gv.x, v[j].y * rs * gv.y); w.y = pk2(v[j].z * rs * gv.z, v[j].w * rs * gv.w); o8[64 * j] = w; }
        } else {
#pragma unroll
            for (int j = 0; j < 8; ++j) o8[64 * j] = (v2u){0u, 0u};
        }
    }
}
__device__ __forceinline__ void final_rows(float* X, const float* g, int gw, int NGW, int lane) {
    for (int m = gw; m < MV; m += NGW) {
        f32x4* xr = (f32x4*)(X + (size_t)m * D) + lane;
        f32x4 v[8]; float ss = 0.f;
#pragma unroll
        for (int j = 0; j < 8; ++j) { v[j] = xr[64 * j]; ss += (v[j].x * v[j].x + v[j].y * v[j].y) + (v[j].z * v[j].z + v[j].w * v[j].w); }
        const float rs = 1.0f / sqrtf(wave_sum(ss) * (1.0f / D) + 1e-6f);
#pragma unroll
        for (int j = 0; j < 8; ++j) { const f32x4 gv = ((const f32x4*)g)[lane + 64 * j]; xr[64 * j] = (v[j] * rs) * gv; }
    }
}
__device__ __forceinline__ void cache_convert(const float* ck, const float* cv, bf16* CK, bf16* CV, size_t gt, size_t NT) {
    constexpr size_t NCH = (size_t)DEC_B * PAST * D / 8;
    for (size_t i = gt; i < 2 * NCH; i += NT) { const bool t = i >= NCH; const size_t c = t ? i - NCH : i;
        const f32x4* s = (const f32x4*)((t ? cv : ck) + c * 8); const f32x4 a = s[0], b2 = s[1];
        v4u o; o.x = pk2(a.x, a.y); o.y = pk2(a.z, a.w); o.z = pk2(b2.x, b2.y); o.w = pk2(b2.z, b2.w);
        *(v4u*)((t ? CV : CK) + c * 8) = o; }
}

struct Args { const float* in[16]; float* out; unsigned char* ws; int ph_lo, ph_hi; };
struct SkQKV { unsigned char* ws; float* out; int L; float qscale;
    __device__ __forceinline__ void operator()(int row, int col, float v) const { const int t = col >> 11, c = col & 2047;
        bf16* ob = (bf16*)(ws + QKV_WS_Q + (size_t)t * QKV_WS_STRIDE) + (size_t)row * D + c;
        const float sv = t == 0 ? v * qscale : v; *ob = (bf16)(pk2(sv, 0.f) & 0xffffu);
        if (t != 0) { float* fs = out + (t == 1 ? QKV_OUT_KS : QKV_OUT_VS) + (size_t)L * MS * D; fs[(size_t)(row - MP) * D + c] = v; } } };
struct SkResid { const float* rs; float* out;
    __device__ __forceinline__ void operator()(int row, int col, float v) const { const size_t i = (size_t)(row - MP) * D + col; out[i] = rs[i] + v; } };
struct SkRelu2 { bf16* O; int ldc;
    __device__ __forceinline__ void operator()(int row, int col, float v) const { const float a = fmaxf(v, 0.f); O[(size_t)row * ldc + col] = (bf16)(pk2(a * a, 0.f) & 0xffffu); } };
template <class Epi>
__device__ __forceinline__ void skinny_phase(LAS unsigned char* ring, const bf16* A, const bf16* Bt, int N, int K, const Epi& E, int vcu, int G, int wave, int lane) {
    typedef short bf16x8 __attribute__((ext_vector_type(8))); typedef float f32x16 __attribute__((ext_vector_type(16)));
    const int ntile = 4 * (N / 32), r32 = lane & 31, hi = lane >> 5, kw = K / 8;
    LAS float* red = (LAS float*)ring;
    for (int t = vcu; t < ntile; t += G) {
        const int mb = t & 3, nb = t >> 2;
        const bf16* ap = A + (size_t)(MP + 32 * mb + r32) * K + wave * kw + hi * 8;
        const bf16* bp = Bt + (size_t)(32 * nb + r32) * K + wave * kw + hi * 8;
        f32x16 acc = f32x16{};
        for (int k0 = 0; k0 < kw; k0 += 256) {
            bf16x8 a[16], b[16];
#pragma unroll
            for (int j = 0; j < 16; ++j) { a[j] = *(const bf16x8*)(ap + k0 + 16 * j); b[j] = *(const bf16x8*)(bp + k0 + 16 * j); }
#pragma unroll
            for (int j = 0; j < 16; ++j) acc = __builtin_amdgcn_mfma_f32_32x32x16_bf16(a[j], b[j], acc, 0, 0, 0);
        }
#pragma unroll
        for (int r = 0; r < 16; ++r) red[(wave * 16 + r) * 64 + lane] = acc[r];
        LDS_WAIT(); __syncthreads();
        float v0 = 0.f, v1 = 0.f;
#pragma unroll
        for (int w = 0; w < 8; ++w) { v0 += red[(w * 16 + 2 * wave) * 64 + lane]; v1 += red[(w * 16 + 2 * wave + 1) * 64 + lane]; }
        const int r0 = 2 * wave, row0 = MP + 32 * mb + (r0 & 3) + 8 * (r0 >> 2) + 4 * hi, col = 32 * nb + r32;
        E(row0, col, v0); E(row0 + 1, col, v1);
        LDS_WAIT(); __syncthreads();
    }
}

#ifndef PROBE_DUP
#define PROBE_DUP 0
#endif
template <int L>
__device__ __forceinline__ void layer_phases(const Args& args, LAS unsigned char* lds, volatile LAS int* flags, LAS float* gtab, const XcdBarrier& bar, int lo, int hi, int G, int vcu, int tid0, int lane0, int wave) {
#define PHASE_LOCALS int tid = tid0, lane = lane0; asm volatile("" : "+v"(tid), "+v"(lane));
#define IN(k) (lo <= (k) && (k) < hi)
#define SEAM(k) do { if (ONE_LAUNCH && IN(k) && IN((k) + 1)) xcd_barrier(bar); } while (0)
    unsigned char* ws = args.ws;
    const float* x_prompt = args.in[0]; const float* x_sample = args.in[1];
    float* X = args.out + OUT_Y;
    bf16* XN = (bf16*)(ws + WS_XN); bf16* CK = (bf16*)(ws + WS_CK); bf16* CV = (bf16*)(ws + WS_CV);
    bf16* Qb = (bf16*)(ws + WS_Q); bf16* Kb = (bf16*)(ws + WS_K); bf16* Vb = (bf16*)(ws + WS_V); bf16* Hb = (bf16*)(ws + WS_H);
    const int gw = vcu * NWAVES + wave, NGW = G * NWAVES;

        const int pb = 1 + 7 * L;
        unsigned char* wl = ws + WS_W + (size_t)L * W_LAYER;
        const bf16* Wqkv_t = (const bf16*)(wl + W_QKV); const bf16* Wo_t = (const bf16*)(wl + W_O); const bf16* Wup_t = (const bf16*)(wl + W_UP); const bf16* Wdn_t = (const bf16*)(wl + W_DN);
        constexpr bool DUPG = (L == 0) && (PROBE_DUP & 2), DUPA = (L == 0 ? (PROBE_DUP & 8) : (PROBE_DUP & 4)) != 0, DUPT = (L == 0) && (PROBE_DUP & 16);
        bf16* const DUMMY_O = (bf16*)(ws + WS_V + (size_t)M * D * 2);
        float* const DUMMY_X = (float*)(ws + WS_XN);
        if (IN(pb)) { PHASE_LOCALS
#pragma unroll
            for (int rep = 0; rep < (DUPG ? 2 : 1); ++rep) {
            pg8::Gemm g{XN, Wqkv_t, MP, 3 * D, D}; pg8::StaticOrder S; S.init(MP, 3 * D, G, (int)blockIdx.x);
            pg8::EpiQKV E{ws, args.out, L, att::QSCALE};
            pg8::gemm_phase<pg8::EpiQKV, pg8::StaticOrder, PG8_ALIGN, PG8_SP2>(lds + RING_OFF, g, S, E);
            skinny_phase(lds + RING_OFF, XN, Wqkv_t, 3 * D, D, SkQKV{ws, args.out, L, att::QSCALE}, vcu, G, wave, lane);
            }
        }
        SEAM(pb);
        if (IN(pb + 1)) { PHASE_LOCALS
            if (L == 0) {
#pragma unroll
                for (int rep = 0; rep < (DUPA ? 2 : 1); ++rep) { bf16* const Ob = (DUPA && rep == 0) ? DUMMY_O : Qb;
                for (int u = vcu; u < 2048; u += G) att::sb_unit<false>(lds + RING_OFF, flags, Qb, Kb, Vb, CK, CV, Ob, u >> 9, (u >> 5) & 15, u & 31, wave, lane);
                for (int u = vcu; u < 128; u += G) att::sb_unit<true>(lds + RING_OFF, flags, Qb, Kb, Vb, CK, CV, Ob, u >> 4, u & 15, 0, wave, lane);
                }
            } else {
                constexpr float LAMBDA_INIT = 0.35550906759096926f;
                float s1 = args.in[7][lane] * args.in[8][lane] + args.in[7][lane + 64] * args.in[8][lane + 64];
                float s2 = args.in[9][lane] * args.in[10][lane] + args.in[9][lane + 64] * args.in[10][lane + 64];
                s1 = wave_sum(s1); s2 = wave_sum(s2);
                const float lam = expf(s1) - expf(s2) + LAMBDA_INIT;
                if (tid < 256) gtab[tid] = args.in[11][tid] * (1.0f - LAMBDA_INIT);
                LDS_WAIT(); __syncthreads();
#pragma unroll
                for (int rep = 0; rep < (DUPA ? 2 : 1); ++rep) { bf16* const Ob = (DUPA && rep == 0) ? DUMMY_O : Qb;
                for (int idx = vcu; idx < 2048; idx += G) { const int ip = 7 - (idx >> 8), v = idx & 255, grp = v >> 3, s = v & 7; const int qb = 8 * ip + ((ip & 1) ? 7 - s : s);
                    att::diff_unit<false>(lds + RING_OFF, gtab, Qb, Kb, Vb, CK, CV, Ob, grp >> 3, grp & 7, qb, lam, wave, lane); }
                for (int v = vcu; v < 64; v += G) att::diff_unit<true>(lds + RING_OFF, gtab, Qb, Kb, Vb, CK, CV, Ob, v >> 3, v & 7, 0, lam, wave, lane);
                }
            }
        }
        SEAM(pb + 1);
        if (IN(pb + 2)) { PHASE_LOCALS
#pragma unroll
            for (int rep = 0; rep < (DUPG ? 2 : 1); ++rep) {
            pg8::Gemm g{Qb, Wo_t, MP, D, D}; pg8::StaticOrder S; S.init(MP, D, G, (int)blockIdx.x);
            pg8::EpiResid E{L == 0 ? x_prompt : X, L == 0 ? x_sample : X + (size_t)MP * D, X};
            pg8::gemm_phase<pg8::EpiResid, pg8::StaticOrder, PG8_ALIGN, PG8_SP2>(lds + RING_OFF, g, S, E);
            skinny_phase(lds + RING_OFF, Qb, Wo_t, D, D, SkResid{L == 0 ? x_sample : X + (size_t)MP * D, X + (size_t)MP * D}, vcu, G, wave, lane);
            }
        }
        SEAM(pb + 2);
        if (IN(pb + 3)) { PHASE_LOCALS xn_rows(X, X + (size_t)MP * D, args.in[12] + (size_t)L * D, XN, gw, NGW, lane); if (DUPT) xn_rows(X, X + (size_t)MP * D, args.in[12] + (size_t)L * D, XN, gw, NGW, lane); }
        SEAM(pb + 3);
        if (IN(pb + 4)) { PHASE_LOCALS
#pragma unroll
            for (int rep = 0; rep < (DUPG ? 2 : 1); ++rep) {
            pg8::Gemm g{XN, Wup_t, MP, FF, D}; pg8::StaticOrder S; S.init(MP, FF, G, (int)blockIdx.x);
            pg8::EpiRelu2 E{Hb, FF};
            pg8::gemm_phase<pg8::EpiRelu2, pg8::StaticOrder, PG8_ALIGN, PG8_SP2>(lds + RING_OFF, g, S, E);
            skinny_phase(lds + RING_OFF, XN, Wup_t, FF, D, SkRelu2{Hb, FF}, vcu, G, wave, lane);
            }
        }
        SEAM(pb + 4);
        if (IN(pb + 5)) { PHASE_LOCALS
#pragma unroll
            for (int rep = 0; rep < (DUPG ? 2 : 1); ++rep) {
            pg8::Gemm g{Hb, Wdn_t, MP, D, FF}; pg8::StaticOrder S; S.init(MP, D, G, (int)blockIdx.x);
            pg8::EpiResid E{X, X + (size_t)MP * D, (DUPG && rep == 0) ? DUMMY_X : X};
            pg8::gemm_phase<pg8::EpiResid, pg8::StaticOrder, PG8_ALIGN, PG8_SP2>(lds + RING_OFF, g, S, E);
            skinny_phase(lds + RING_OFF, Hb, Wdn_t, D, FF, SkResid{X + (size_t)MP * D, ((DUPG && rep == 0) ? DUMMY_X : X) + (size_t)MP * D}, vcu, G, wave, lane);
            }
        }
        SEAM(pb + 5);
        if (IN(pb + 6)) { PHASE_LOCALS
            if (L == 0) {
#pragma unroll
                for (int rep = 0; rep < (DUPT ? 2 : 1); ++rep) {
                cache_convert(args.in[2] + (size_t)DEC_B * PAST * D, args.in[3] + (size_t)DEC_B * PAST * D, CK, CV, (size_t)vcu * (NWAVES * 64) + tid, (size_t)G * (NWAVES * 64));
                xn_rows(X, X + (size_t)MP * D, args.in[4] + D, XN, gw, NGW, lane); } }
            else final_rows(X, args.in[15], gw, NGW, lane);
        }
        if (L == 0) SEAM(pb + 6);

#undef PHASE_LOCALS
#undef IN
#undef SEAM
}

__global__ void __launch_bounds__(NWAVES * 64, 2) fwd_kernel(Args args) {
    extern __shared__ __attribute__((aligned(16))) unsigned char lds_raw[];
    LAS unsigned char* lds = (LAS unsigned char*)lds_raw;
    volatile LAS unsigned* MISC = (volatile LAS unsigned*)(lds + LDSCTL_OFF);
    volatile LAS int* flags = (volatile LAS int*)(lds + LDSCTL_OFF + 128);
    LAS float* gtab = (LAS float*)(lds + GTAB_OFF);
    const int tid = threadIdx.x, lane = tid & 63, wave = __builtin_amdgcn_readfirstlane(tid >> 6);
    const int G = gridDim.x; const int bx = blockIdx.x; const int vcu = (G % 8 == 0) ? (bx % 8) * (G / 8) + bx / 8 : bx;
    for (int u = tid; u < 128; u += NWAVES * 64) ((LAS unsigned*)(lds + LDSCTL_OFF))[u] = 0u;
    __syncthreads();
    unsigned char* ws = args.ws;
    gu32* ctl = (gu32*)(ws + WS_CTL);
    XcdBarrier bar; bar.bar = (unsigned*)ctl + CW_BAR; bar.x = 0; bar.st = nullptr;
    if (ONE_LAUNCH) bar = xcd_barrier_post((unsigned*)ctl + CW_BAR, MISC + 8);
    const int lo = args.ph_lo, hi = args.ph_hi;
#define IN(k) (lo <= (k) && (k) < hi)
#define SEAM(k) do { if (ONE_LAUNCH && IN(k) && IN((k) + 1)) xcd_barrier(bar); } while (0)
    const float* x_prompt = args.in[0]; const float* x_sample = args.in[1];
    float* X = args.out + OUT_Y;
    bf16* XN = (bf16*)(ws + WS_XN); bf16* CK = (bf16*)(ws + WS_CK); bf16* CV = (bf16*)(ws + WS_CV);
    bf16* Qb = (bf16*)(ws + WS_Q); bf16* Kb = (bf16*)(ws + WS_K); bf16* Vb = (bf16*)(ws + WS_V); bf16* Hb = (bf16*)(ws + WS_H);
    const int gw = vcu * NWAVES + wave, NGW = G * NWAVES;

    if (IN(0)) {
#pragma unroll
        for (int rep = 0; rep < ((PROBE_DUP & 1) ? 2 : 1); ++rep) {
        LAS float* scr = (LAS float*)(lds + RING_OFF + wave * 16384);
        constexpr int I_QKV = (D / 64) * (3 * D / 32), I_O = (D / 64) * (D / 32), I_UP = (D / 64) * (FF / 32), I_DN = (FF / 64) * (D / 32), I_L = I_QKV + I_O + I_UP + I_DN;
        for (int it = gw; it < 2 * I_L; it += NGW) {
            const int L = it / I_L; int r = it % I_L; unsigned char* wl = ws + WS_W + (size_t)L * W_LAYER;
            if (r < I_QKV) { transpose_item(args.in[5] + (size_t)L * D * 3 * D, D, 3 * D, (bf16*)(wl + W_QKV), scr, r, lane); continue; } r -= I_QKV;
            if (r < I_O) { transpose_item(args.in[6] + (size_t)L * D * D, D, D, (bf16*)(wl + W_O), scr, r, lane); continue; } r -= I_O;
            if (r < I_UP) { transpose_item(args.in[13] + (size_t)L * D * FF, D, FF, (bf16*)(wl + W_UP), scr, r, lane); continue; } r -= I_UP;
            transpose_item(args.in[14] + (size_t)L * FF * D, FF, D, (bf16*)(wl + W_DN), scr, r, lane);
        }
        cache_convert(args.in[2], args.in[3], CK, CV, (size_t)vcu * (NWAVES * 64) + tid, (size_t)G * (NWAVES * 64));
        xn_rows(x_prompt, x_sample, args.in[4], XN, gw, NGW, lane);
        for (int i = vcu * (NWAVES * 64) + tid; i < 3 * (M - MV) * D / 8; i += G * (NWAVES * 64)) { const int t = i / ((M - MV) * D / 8), c = i % ((M - MV) * D / 8);
            *(v4u*)(ws + WS_Q + (size_t)t * (WS_K - WS_Q) + ((size_t)MV * D + (size_t)c * 8) * 2) = (v4u){0u, 0u, 0u, 0u}; }
        }
    }
    SEAM(0);

    layer_phases<0>(args, lds, flags, gtab, bar, lo, hi, G, vcu, tid, lane, wave);
    layer_phases<1>(args, lds, flags, gtab, bar, lo, hi, G, vcu, tid, lane, wave);
#undef IN
#undef SEAM
}

extern "C" void kernel_launch(void* const* d_in, const int* in_sizes, int n_in, void* d_out, int out_size, void* d_ws, size_t ws_size, hipStream_t stream) {
    static int grid = 0;
    if (grid == 0) {
        if (n_in != 16 || (size_t)out_size != OUT_END || ws_size < WS_END) { fprintf(stderr, "kernel_launch: unexpected shapes (n_in %d out %d ws %zu)\n", n_in, out_size, ws_size); grid = -1; return; }
        int dev = 0, cus = 0;
        if (hipGetDevice(&dev) != hipSuccess || hipDeviceGetAttribute(&cus, hipDeviceAttributeMultiprocessorCount, dev) != hipSuccess) { grid = -1; return; }
        if (hipFuncSetAttribute((const void*)fwd_kernel, hipFuncAttributeMaxDynamicSharedMemorySize, LDS_BYTES) != hipSuccess) { fprintf(stderr, "kernel_launch: hipFuncSetAttribute failed\n"); grid = -1; return; }
        int per_cu = 0;
        if (hipOccupancyMaxActiveBlocksPerMultiprocessor(&per_cu, (const void*)fwd_kernel, NWAVES * 64, LDS_BYTES) != hipSuccess || per_cu < 1) fprintf(stderr, "kernel_launch: occupancy query says %d\n", per_cu);
        (void)hipGetLastError();
        grid = cus;
    }
    if (grid < 0) return;
    (void)hipMemsetAsync((char*)d_ws + WS_CTL, 0, CTL_ZERO_BYTES, stream);
    Args a{};
    for (int i = 0; i < 16; ++i) a.in[i] = (const float*)d_in[i];
    a.out = (float*)d_out; a.ws = (unsigned char*)d_ws;
    if (ONE_LAUNCH) { a.ph_lo = 0; a.ph_hi = N_PHASES; hipLaunchKernelGGL(fwd_kernel, dim3(grid), dim3(NWAVES * 64), LDS_BYTES, stream, a); }
    else for (int p = 0; p < N_PHASES; ++p) { a.ph_lo = p; a.ph_hi = p + 1; hipLaunchKernelGGL(fwd_kernel, dim3(grid), dim3(NWAVES * 64), LDS_BYTES, stream, a); }
}
```

```cpp
#include <hip/hip_runtime.h>
#include <cstdio>
#include <cstdint>
constexpr int D = 2048, BATCH = 4, SEQ = 8192, DEC_B = 8, DEC_T = 16, PAST = 2048, FF = 8192;
constexpr int MP = BATCH * SEQ;
constexpr int MS = DEC_B * DEC_T;
constexpr int MV = MP + MS;
constexpr int M = 33024;
constexpr size_t QKV_WS_Q = (size_t)451 << 20, QKV_WS_STRIDE = (size_t)129 << 20;
constexpr size_t QKV_OUT_KP = (size_t)MV * D, QKV_OUT_VP = QKV_OUT_KP + 2 * (size_t)MP * D, QKV_OUT_KS = QKV_OUT_VP + 2 * (size_t)MP * D, QKV_OUT_VS = QKV_OUT_KS + 2 * (size_t)MS * D;
namespace pg8 {
#define PG8_LAS __attribute__((address_space(3)))
typedef unsigned short bf16_t;
typedef short bf16x8 __attribute__((ext_vector_type(8)));
typedef float f32x4 __attribute__((ext_vector_type(4)));
typedef unsigned u32x4 __attribute__((ext_vector_type(4)));
constexpr int BM = 256, BK = 64, HALF = 128, HTB = HALF * BK * 2  , STAGE_BYTES = 8 * HTB, NXCD = 8, WGM = 8;

__host__ __device__ __forceinline__ int lds_byte(int r, int c) { const int st = (r >> 4) * 2 + (c >> 5), rr = r & 15, cc = c & 31, ob = rr * 64 + cc * 2; return st * 1024 + (ob ^ (((ob >> 9) & 1) << 5)); }
__host__ __device__ __forceinline__ void stage_rc(int b, int& R, int& C) { const int st = b / 1024, sb = b % 1024, swz = sb ^ (((sb >> 9) & 1) << 5); R = (st >> 1) * 16 + swz / 64; C = (st & 1) * 32 + (swz % 64) / 2; }
__host__ __device__ __forceinline__ int perm32(int rho) { const int n = rho >> 4, i = rho & 15; return 8 * (i >> 2) + 4 * n + (i & 3); }

struct Unit { int pm, pn; };
struct Gemm { const bf16_t* A; const bf16_t* Bt; int M, N, K; };

struct StaticOrder {
    int nM, nN, nwg, G, c;
    __host__ __device__ void init(int M, int N, int G_, int c_) { nM = M / BM; nN = N / BM; nwg = nM * nN; G = G_; c = c_; }
    __host__ __device__ bool next(int i, Unit& u) const {
        const long L = (long)i * G + c; if (L >= nwg) return false;
        int wgid = (int)L; { const int q = nwg / NXCD, r = nwg % NXCD, xcd = wgid % NXCD, off = wgid / NXCD; wgid = (xcd < r ? xcd * (q + 1) : r * (q + 1) + (xcd - r) * q) + off; }
        const int nig = WGM * nN, gid = wgid / nig, fm = gid * WGM, gsz = (nM - fm) < WGM ? (nM - fm) : WGM;
        u.pm = fm + ((wgid % nig) % gsz); u.pn = (wgid % nig) / gsz; return true;
    }
    __device__ __forceinline__ void a_ready(const Unit&) const {}
    __device__ __forceinline__ void done(const Unit&) const {}
};

__device__ __forceinline__ unsigned cvt_pk_bf16(float lo, float hi) { unsigned r; asm volatile("v_cvt_pk_bf16_f32 %0, %1, %2" : "=v"(r) : "v"(lo), "v"(hi)); return r; }
typedef float f32x2 __attribute__((ext_vector_type(2)));
typedef unsigned u32x2 __attribute__((ext_vector_type(2)));
struct EpiQKV {
    static constexpr bool PERM = true, AFTER_DRAIN = false;
    unsigned char* ws; float* out; int L; float qscale; unsigned* kn;
    __device__ __forceinline__ void operator()(const f32x4 (&acc)[2][2][4][2], const Unit& u, int wr, int wc, int fr, int fq) const {
        const int row0 = u.pm * BM + wr * 64 + fr; const int t = u.pn >> 3; const int col0 = (u.pn & 7) * BM + wc * 32 + 8 * fq;
        bf16_t* ob = (bf16_t*)(ws + QKV_WS_Q + (size_t)t * QKV_WS_STRIDE);
        float* fp = out + (t == 1 ? QKV_OUT_KP : QKV_OUT_VP) + (size_t)L * MP * D; float* fs = out + (t == 1 ? QKV_OUT_KS : QKV_OUT_VS) + (size_t)L * MS * D;
        const float sc = t == 0 ? qscale : 1.f;
#pragma unroll
        for (int ai = 0; ai < 2; ++ai)
#pragma unroll
            for (int m = 0; m < 4; ++m) { const int row = row0 + ai * HALF + m * 16;
                float* frow = nullptr; if (t != 0) { if (row < MP) frow = fp + (size_t)row * D; else if (row < MV) frow = fs + (size_t)(row - MP) * D; }
                bf16_t* rowp = ob + (size_t)row * D + col0;
#pragma unroll
                for (int bj = 0; bj < 2; ++bj) { const f32x4 v0 = acc[ai][bj][m][0], v1 = acc[ai][bj][m][1];
                    u32x4 w; w.x = cvt_pk_bf16(v0[0] * sc, v0[1] * sc); w.y = cvt_pk_bf16(v0[2] * sc, v0[3] * sc); w.z = cvt_pk_bf16(v1[0] * sc, v1[1] * sc); w.w = cvt_pk_bf16(v1[2] * sc, v1[3] * sc);
                    *(u32x4*)(rowp + bj * HALF) = w;
                    if (frow) { *(f32x4*)(frow + col0 + bj * HALF) = v0; *(f32x4*)(frow + col0 + bj * HALF + 4) = v1; } } }
        if (L == 1 && t == 1 && u.pm * BM < MP) {
#pragma unroll
            for (int bj = 0; bj < 2; ++bj) { float mx = 0.f;
#pragma unroll
                for (int ai = 0; ai < 2; ++ai)
#pragma unroll
                    for (int m = 0; m < 4; ++m) { const f32x4 v0 = acc[ai][bj][m][0], v1 = acc[ai][bj][m][1];
                        float sq = (v0[0] * v0[0] + v0[1] * v0[1]) + (v0[2] * v0[2] + v0[3] * v0[3]) + (v1[0] * v1[0] + v1[1] * v1[1]) + (v1[2] * v1[2] + v1[3] * v1[3]);
                        sq += __shfl_xor(sq, 16); sq += __shfl_xor(sq, 32); mx = fmaxf(mx, sq); }
                mx = fmaxf(mx, __shfl_xor(mx, 1)); mx = fmaxf(mx, __shfl_xor(mx, 2)); mx = fmaxf(mx, __shfl_xor(mx, 4)); mx = fmaxf(mx, __shfl_xor(mx, 8));
                if (fr == 0 && fq == 0) atomicMax(kn + (((u.pm * BM) / SEQ) * 16 + (u.pn & 7) * 2 + bj) * 4 + wc, __float_as_uint(mx)); }
        }
    }
};
struct EpiResid {
    static constexpr bool PERM = false, AFTER_DRAIN = false;
    const float* rp; const float* rs; float* out;
    __device__ __forceinline__ void operator()(const f32x4 (&acc)[2][2][4][2], const Unit& u, int wr, int wc, int fr, int fq) const {
        const int col0 = u.pn * BM + wc * 32 + 4 * fq;
#pragma unroll
        for (int ai = 0; ai < 2; ++ai)
#pragma unroll
            for (int m = 0; m < 4; ++m) { const int row = u.pm * BM + ai * HALF + wr * 64 + m * 16 + fr;
                if (row < MV) { const float* r = row < MP ? rp + (size_t)row * D : rs + (size_t)(row - MP) * D; float* o = out + (size_t)row * D;
#pragma unroll
                    for (int bj = 0; bj < 2; ++bj)
#pragma unroll
                        for (int n = 0; n < 2; ++n) { const int c = col0 + bj * HALF + n * 16; *(f32x4*)(o + c) = *(const f32x4*)(r + c) + acc[ai][bj][m][n]; } } }
    }
};
struct EpiRelu2 {
    static constexpr bool PERM = true, AFTER_DRAIN = false;
    bf16_t* O; int ldc;
    __device__ __forceinline__ void operator()(const f32x4 (&acc)[2][2][4][2], const Unit& u, int wr, int wc, int fr, int fq) const {
        const int row0 = u.pm * BM + wr * 64 + fr, col0 = u.pn * BM + wc * 32 + 8 * fq;
#pragma unroll
        for (int ai = 0; ai < 2; ++ai)
#pragma unroll
            for (int m = 0; m < 4; ++m) { bf16_t* rowp = O + (size_t)(row0 + ai * HALF + m * 16) * ldc + col0;
#pragma unroll
                for (int bj = 0; bj < 2; ++bj) { f32x4 v0 = acc[ai][bj][m][0], v1 = acc[ai][bj][m][1];
#pragma unroll
                    for (int e = 0; e < 4; ++e) { const float a = fmaxf(v0[e], 0.f), b = fmaxf(v1[e], 0.f); v0[e] = a * a; v1[e] = b * b; }
                    u32x4 w; w.x = cvt_pk_bf16(v0[0], v0[1]); w.y = cvt_pk_bf16(v0[2], v0[3]); w.z = cvt_pk_bf16(v1[0], v1[1]); w.w = cvt_pk_bf16(v1[2], v1[3]);
                    *(u32x4*)(rowp + bj * HALF) = w; } }
    }
};
template <class Epi, class Sched, bool ALIGN_EPI = false, bool SP2 = false>
__device__ __forceinline__ void gemm_phase(PG8_LAS unsigned char* lds, const Gemm g, const Sched& S, const Epi& E, int wid_in, int lane_in) {
    const int wid = wid_in, lane = lane_in, tid = wid_in * 64 + lane_in,     wr = wid >> 2, wc = wid & 3, fr = lane & 15, fq = lane >> 4;
    const int K = g.K, nt = K / BK;
    unsigned voffA[2], voffB[2];
#pragma unroll
    for (int i = 0; i < 2; ++i) { int R, C; stage_rc(tid * 16 + i * 8192, R, C); const int Rb = Epi::PERM ? ((R & ~31) + perm32(R & 31)) : R;
        voffA[i] = (unsigned)(R * K + C) * 2u; voffB[i] = (unsigned)(Rb * K + C) * 2u; }
    const size_t kstep = (size_t)(BK * 2);
    const size_t hstep = (size_t)HALF * K * 2;
    const size_t tstep = 2 * hstep;
    const unsigned ldsw = (unsigned)wid * 1024u;
    const int aoff = lds_byte(wr * 64 + fr, fq * 8), boff = lds_byte(wc * 32 + fr, fq * 8);
#define PG8_SA(b, h) (((b) * 2 + (h)) * HTB)
#define PG8_SB(b, h) ((4 + (b) * 2 + (h)) * HTB)
#define PG8_STAGE(bufoff, gbase, voff) do { _Pragma("unroll") for (int _i = 0; _i < 2; ++_i) \
        __builtin_amdgcn_global_load_lds((const unsigned*)((const char*)(gbase) + (voff)[_i]), (PG8_LAS unsigned*)(lds + (bufoff) + ldsw + _i * 8192), 16, 0, 0); } while (0)
#define PG8_LDA(dst, b, h) do { _Pragma("unroll") for (int m = 0; m < 4; ++m) _Pragma("unroll") for (int k = 0; k < 2; ++k) dst[m][k] = *(const PG8_LAS bf16x8*)(lds + PG8_SA(b, h) + aoff + m * 2048 + k * 1024); } while (0)
#define PG8_LDB(dst, b, h) do { _Pragma("unroll") for (int n = 0; n < 2; ++n) _Pragma("unroll") for (int k = 0; k < 2; ++k) dst[n][k] = *(const PG8_LAS bf16x8*)(lds + PG8_SB(b, h) + boff + n * 2048 + k * 1024); } while (0)
#define PG8_MMA(ai, bj, At, Bt) do { __builtin_amdgcn_s_setprio(1); _Pragma("unroll") for (int m = 0; m < 4; ++m) _Pragma("unroll") for (int n = 0; n < 2; ++n) _Pragma("unroll") for (int k = 0; k < 2; ++k) \
        acc[ai][bj][m][n] = __builtin_amdgcn_mfma_f32_16x16x32_bf16(Bt[n][k], At[m][k], acc[ai][bj][m][n], 0, 0, 0); __builtin_amdgcn_s_setprio(0); } while (0)
#define PG8_WAIT_V(n) asm volatile("s_waitcnt vmcnt(" #n ")" ::: "memory")
#define PG8_WAIT_L(n) asm volatile("s_waitcnt lgkmcnt(" #n ")" ::: "memory")
#define PG8_BAR __builtin_amdgcn_s_barrier()
#define PG8_SCHED __builtin_amdgcn_sched_barrier(0)
    Unit cur, nxt; int ui = 0;
    if (!S.next(0, cur)) return;
    f32x4 acc[2][2][4][2];
#pragma unroll
    for (int a = 0; a < 2; ++a)
#pragma unroll
        for (int b = 0; b < 2; ++b)
#pragma unroll
            for (int m = 0; m < 4; ++m)
#pragma unroll
                for (int n = 0; n < 2; ++n) acc[a][b][m][n] = (f32x4){0.f, 0.f, 0.f, 0.f};
    bf16x8 At[4][2], B0[2][2], B1[2][2];
    const char* cA = (const char*)g.A + (size_t)cur.pm * tstep; const char* cB = (const char*)g.Bt + (size_t)cur.pn * tstep;
    S.a_ready(cur);
    if constexpr (SP2) {
        PG8_STAGE(PG8_SB(0, 0), cB, voffB); PG8_STAGE(PG8_SB(0, 1), cB + hstep, voffB); PG8_STAGE(PG8_SA(0, 0), cA, voffA); PG8_STAGE(PG8_SA(0, 1), cA + hstep, voffA);
        if (wr == 1) PG8_BAR;
        PG8_WAIT_V(2); PG8_BAR;
        PG8_STAGE(PG8_SB(1, 0), cB + kstep, voffB); PG8_STAGE(PG8_SA(1, 0), cA + kstep, voffA); PG8_STAGE(PG8_SB(1, 1), cB + hstep + kstep, voffB);
        PG8_WAIT_V(6); PG8_BAR;
    } else {
        PG8_STAGE(PG8_SB(0, 0), cB, voffB); PG8_STAGE(PG8_SA(0, 0), cA, voffA); PG8_STAGE(PG8_SB(0, 1), cB + hstep, voffB); PG8_STAGE(PG8_SA(0, 1), cA + hstep, voffA);
        if (wr == 1) PG8_BAR;
        PG8_WAIT_V(4); PG8_BAR;
        PG8_STAGE(PG8_SB(1, 0), cB + kstep, voffB); PG8_STAGE(PG8_SA(1, 0), cA + kstep, voffA); PG8_STAGE(PG8_SB(1, 1), cB + hstep + kstep, voffB);
        PG8_WAIT_V(6); PG8_BAR;
    }
    for (;;) {
        const bool has_next = S.next(ui + 1, nxt);
        const char* nA = has_next ? (const char*)g.A + (size_t)nxt.pm * tstep : cA; const char* nB = has_next ? (const char*)g.Bt + (size_t)nxt.pn * tstep : cB;
        for (int t = 0; t < nt; t += 2) {
            const bool last = (t == nt - 2);
            const char* a1 = cA + (size_t)(t + 1) * kstep;
            const char* a2 = last ? nA : cA + (size_t)(t + 2) * kstep; const char* b2 = last ? nB : cB + (size_t)(t + 2) * kstep;
            const char* a3 = a2 + kstep; const char* b3 = b2 + kstep;
            if (last && has_next) S.a_ready(nxt);
            if constexpr (SP2) {
            PG8_LDB(B0, 0, 0); PG8_LDB(B1, 0, 1); PG8_SCHED; PG8_LDA(At, 0, 0); PG8_STAGE(PG8_SA(1, 1), a1 + hstep, voffA);
            PG8_WAIT_V(8); PG8_WAIT_L(0); PG8_BAR; PG8_MMA(0, 0, At, B0); PG8_MMA(0, 1, At, B1); PG8_BAR; PG8_SCHED;
            PG8_LDA(At, 0, 1); PG8_STAGE(PG8_SB(0, 0), b2, voffB); PG8_STAGE(PG8_SB(0, 1), b2 + hstep, voffB); PG8_STAGE(PG8_SA(0, 0), a2, voffA);
            PG8_WAIT_V(8); PG8_WAIT_L(0); PG8_BAR; PG8_MMA(1, 0, At, B0); PG8_MMA(1, 1, At, B1); PG8_BAR; PG8_SCHED;
            PG8_LDB(B0, 1, 0); PG8_LDB(B1, 1, 1); PG8_SCHED; PG8_LDA(At, 1, 0); PG8_STAGE(PG8_SA(0, 1), a2 + hstep, voffA);
            PG8_WAIT_V(8); PG8_WAIT_L(0); PG8_BAR; PG8_MMA(0, 0, At, B0); PG8_MMA(0, 1, At, B1); PG8_BAR; PG8_SCHED;
            PG8_LDA(At, 1, 1); PG8_STAGE(PG8_SB(1, 0), b3, voffB); PG8_STAGE(PG8_SB(1, 1), b3 + hstep, voffB); PG8_STAGE(PG8_SA(1, 0), a3, voffA);
            PG8_WAIT_V(8); PG8_WAIT_L(0); PG8_BAR; PG8_MMA(1, 0, At, B0); PG8_MMA(1, 1, At, B1); PG8_BAR; PG8_SCHED;
            } else {
            PG8_LDB(B0, 0, 0); PG8_SCHED; PG8_LDA(At, 0, 0); PG8_STAGE(PG8_SA(1, 1), a1 + hstep, voffA);
            PG8_WAIT_L(8); PG8_BAR; PG8_WAIT_L(0); PG8_MMA(0, 0, At, B0); PG8_BAR; PG8_SCHED;
            PG8_LDB(B1, 0, 1); PG8_STAGE(PG8_SB(0, 0), b2, voffB);
            PG8_BAR; PG8_WAIT_L(0); PG8_MMA(0, 1, At, B1); PG8_BAR;
            PG8_LDA(At, 0, 1); PG8_STAGE(PG8_SA(0, 0), a2, voffA);
            PG8_BAR; PG8_WAIT_L(0); PG8_MMA(1, 0, At, B0); PG8_BAR; PG8_SCHED;
            PG8_STAGE(PG8_SB(0, 1), b2 + hstep, voffB);
            PG8_WAIT_V(6); PG8_BAR; PG8_MMA(1, 1, At, B1); PG8_BAR;
            PG8_LDB(B0, 1, 0); PG8_SCHED; PG8_LDA(At, 1, 0); PG8_STAGE(PG8_SA(0, 1), a2 + hstep, voffA);
            PG8_WAIT_L(8); PG8_BAR; PG8_WAIT_L(0); PG8_MMA(0, 0, At, B0); PG8_BAR; PG8_SCHED;
            PG8_LDB(B1, 1, 1); PG8_STAGE(PG8_SB(1, 0), b3, voffB);
            PG8_BAR; PG8_WAIT_L(0); PG8_MMA(0, 1, At, B1); PG8_BAR;
            PG8_LDA(At, 1, 1); PG8_STAGE(PG8_SA(1, 0), a3, voffA);
            PG8_BAR; PG8_WAIT_L(0); PG8_MMA(1, 0, At, B0); PG8_BAR; PG8_SCHED;
            PG8_STAGE(PG8_SB(1, 1), b3 + hstep, voffB);
            PG8_WAIT_V(6); PG8_BAR; PG8_MMA(1, 1, At, B1); PG8_BAR;
            }
        }
        if constexpr (ALIGN_EPI) { if (wr == 0) PG8_BAR; }
        if constexpr (!Epi::AFTER_DRAIN) { E(acc, cur, wr, wc, fr, fq); S.done(cur); }
        if (!has_next) break;
#pragma unroll
        for (int a = 0; a < 2; ++a)
#pragma unroll
            for (int b = 0; b < 2; ++b)
#pragma unroll
                for (int m = 0; m < 4; ++m)
#pragma unroll
                    for (int n = 0; n < 2; ++n) acc[a][b][m][n] = (f32x4){0.f, 0.f, 0.f, 0.f};
        cur = nxt; cA = nA; cB = nB; ++ui;
        if constexpr (ALIGN_EPI) { if (wr == 1) PG8_BAR; }
    }
    PG8_WAIT_V(0);
    if constexpr (!ALIGN_EPI) { if (wr == 0) PG8_BAR; }
    PG8_BAR;
    if constexpr (Epi::AFTER_DRAIN) { E.fused(acc, cur, wr, wc, fr, fq, lds, wid, lane); S.done(cur); }
#undef PG8_SA
#undef PG8_SB
#undef PG8_STAGE
#undef PG8_LDA
#undef PG8_LDB
#undef PG8_MMA
#undef PG8_WAIT_V
#undef PG8_WAIT_L
#undef PG8_BAR
#undef PG8_SCHED
}
}
#ifndef PG8_SP2
#define PG8_SP2 true
#endif
#ifndef PG8_ALIGN
#define PG8_ALIGN true
#endif
constexpr int NWAVES = 8;
#ifndef MK_N_LAUNCHES
#define MK_N_LAUNCHES 1
#endif
constexpr int N_PHASES = 15;
constexpr bool ONE_LAUNCH = (MK_N_LAUNCHES == 1);

constexpr size_t MiB = 1u << 20;
constexpr size_t WS_CTL = 0, CTL_ZERO_BYTES = 1 * MiB;
constexpr size_t WS_W = 2 * MiB;
constexpr size_t W_LAYER = 96 * MiB, W_QKV = 0, W_O = 24 * MiB, W_UP = 32 * MiB, W_DN = 64 * MiB;
constexpr size_t WS_XN = 194 * MiB;
constexpr size_t WS_CK = 323 * MiB, WS_CV = 387 * MiB;
constexpr size_t WS_Q = 451 * MiB, WS_K = 580 * MiB, WS_V = 709 * MiB;
constexpr size_t WS_H = WS_Q;
constexpr size_t WS_END = 967 * MiB;
static_assert(WS_H + (size_t)M * FF * 2 <= WS_END && WS_V + (size_t)M * D * 2 <= WS_END && WS_XN + (size_t)M * D * 2 <= WS_CK && WS_W + 2 * W_LAYER <= WS_XN, "d_ws map");
static_assert(QKV_WS_Q == WS_Q && WS_K == WS_Q + QKV_WS_STRIDE && WS_V == WS_Q + 2 * QKV_WS_STRIDE, "QKV epilogue map");
constexpr int CW_TMO = 0;
constexpr int CW_KN = 1024;
constexpr int CW_QH = 2048;
constexpr int CW_BAR = 4096;

constexpr size_t OUT_Y = 0, OUT_KP = (size_t)MV * D, OUT_VP = OUT_KP + 2 * (size_t)MP * D, OUT_KS = OUT_VP + 2 * (size_t)MP * D, OUT_VS = OUT_KS + 2 * (size_t)MS * D, OUT_END = OUT_VS + 2 * (size_t)MS * D;
static_assert(OUT_KP == QKV_OUT_KP && OUT_VP == QKV_OUT_VP && OUT_KS == QKV_OUT_KS && OUT_VS == QKV_OUT_VS, "QKV epilogue map");

constexpr int RING_OFF = 0, RING_BYTES = 131072;
constexpr int LDSCTL_OFF = RING_BYTES;
constexpr int GTAB_OFF = LDSCTL_OFF + 1024;
constexpr int LDS_BYTES = 147456;
static_assert(GTAB_OFF + 1024 <= LDS_BYTES, "LDS map");

#define GAS __attribute__((address_space(1)))
#define LAS __attribute__((address_space(3)))
typedef unsigned short bf16;
typedef unsigned v4u __attribute__((ext_vector_type(4)));
typedef unsigned v2u __attribute__((ext_vector_type(2)));
typedef float f32x4 __attribute__((ext_vector_type(4)));
typedef GAS unsigned gu32;
#define RLX_AGENT __ATOMIC_RELAXED, __HIP_MEMORY_SCOPE_AGENT
#define LDS_WAIT() asm volatile("s_waitcnt lgkmcnt(0)" ::: "memory")
#define VM_WAIT() asm volatile("s_waitcnt vmcnt(0)" ::: "memory")
typedef float f32x2_t __attribute__((ext_vector_type(2))); typedef __bf16 bf16x2_t __attribute__((ext_vector_type(2)));
__device__ __forceinline__ unsigned pk2(float lo, float hi) { f32x2_t v = {lo, hi}; bf16x2_t b = __builtin_convertvector(v, bf16x2_t); return __builtin_bit_cast(unsigned, b); }
__device__ __forceinline__ float wave_sum(float v) {
#pragma unroll
    for (int o = 1; o < 64; o <<= 1) v += __shfl_xor(v, o);
    return v;
}
#define XB_TMO      128
#define XB_XCNT(j)  (256  + 64 * (j))
#define XB_XSUB(j)  (1280 + 64 * (j))
#define XB_XGEN(j)  (2304 + 64 * (j))
#define XB_TOP      3328
#define XB_TOPGEN   3392
#define XCD_BAR_WORDS 3456
#define XB_SPIN_CAP (1u << 18)

__device__ __forceinline__ unsigned xb_ld(unsigned* p)              { return __hip_atomic_load(p, __ATOMIC_RELAXED, __HIP_MEMORY_SCOPE_AGENT); }
__device__ __forceinline__ unsigned xb_add(unsigned* p, unsigned v) { return __hip_atomic_fetch_add(p, v, __ATOMIC_RELAXED, __HIP_MEMORY_SCOPE_AGENT); }
__device__ __forceinline__ unsigned xb_xcc_id() { return (unsigned)__builtin_amdgcn_s_getreg((3 << 11) | 20) & 0xFu; }
#define XB_SPIN(cond, bar) do { unsigned _sp = 0; while (cond) { __builtin_amdgcn_s_sleep(1); \
    if ((++_sp & 255u) == 0u) { if (xb_ld(&(bar)[XB_TMO])) break; if (_sp > XB_SPIN_CAP) { atomicAdd(&(bar)[XB_TMO], 1u); break; } } } } while (0)

struct XcdBarrier {
    unsigned* bar; unsigned x; int wave;
    volatile LAS unsigned* st;
};

__device__ __forceinline__ bool xb_thread0(int wave) { return wave == 0 && __builtin_amdgcn_mbcnt_hi(~0u, __builtin_amdgcn_mbcnt_lo(~0u, 0u)) == 0u; }
__device__ __forceinline__ XcdBarrier xcd_barrier_post(unsigned* bar, volatile LAS unsigned* st, int wave) {
    XcdBarrier b; b.bar = bar; b.x = xb_xcc_id(); b.st = st; b.wave = wave;
    if (xb_thread0(wave)) (void)xb_add(&bar[XB_XCNT(b.x)], 1u);
    return b;
}
__device__ __forceinline__ void xcd_barrier_complete(unsigned* bar, unsigned x, unsigned& nloc, unsigned& nx) {
    const unsigned G = gridDim.x * gridDim.y * gridDim.z;
    unsigned sum, cnt, mine, sp = 0u;
    for (;;) {
        sum = 0u; cnt = 0u; mine = 0u;
#pragma unroll
        for (unsigned j = 0; j < 16; ++j) { const unsigned c = xb_ld(&bar[XB_XCNT(j)]); sum += c; cnt += (c > 0u) ? 1u : 0u; mine = (j == x) ? c : mine; }
        if (sum == G) break;
        __builtin_amdgcn_s_sleep(1);
        if ((++sp & 255u) == 0u) { if (xb_ld(&bar[XB_TMO])) break; if (sp > XB_SPIN_CAP) { atomicAdd(&bar[XB_TMO], 1u); break; } }
    }
    nloc = mine > 0u ? mine : 1u; nx = cnt > 0u ? cnt : 1u;
}

__device__ __forceinline__ void xcd_barrier(const XcdBarrier& b) {
    asm volatile("s_waitcnt vmcnt(0)" ::: "memory");
    __syncthreads();
    if (xb_thread0(b.wave)) {
        unsigned* bar = b.bar;
        __builtin_amdgcn_s_waitcnt(0);
        unsigned nloc = b.st[0], nx = b.st[1];
        if (nloc == 0u) { xcd_barrier_complete(bar, b.x, nloc, nx); b.st[0] = nloc; b.st[1] = nx; }
        const unsigned old = xb_add(&bar[XB_XSUB(b.x)], 1u);
        const unsigned gen = old / nloc;
        if (old + 1u == (gen + 1u) * nloc) {
            __builtin_amdgcn_fence(__ATOMIC_RELEASE, "agent");
            asm volatile("s_waitcnt vmcnt(0)" ::: "memory");
            const unsigned og = xb_add(&bar[XB_TOP], 1u);
            const unsigned tg = og / nx;
            if (og + 1u == (tg + 1u) * nx) xb_add(&bar[XB_TOPGEN], 1u);
            else XB_SPIN(xb_ld(&bar[XB_TOPGEN]) == tg, bar);
            __builtin_amdgcn_fence(__ATOMIC_ACQUIRE, "agent");
            xb_add(&bar[XB_XGEN(b.x)], 1u);
            asm volatile("s_waitcnt vmcnt(0)" ::: "memory");
        } else {
            XB_SPIN(xb_ld(&bar[XB_XGEN(b.x)]) == gen, bar);
            __builtin_amdgcn_fence(__ATOMIC_ACQUIRE, "agent");
            asm volatile("s_waitcnt vmcnt(0)" ::: "memory");
        }
    }
    __syncthreads();
}
namespace att {
typedef short bf16x8 __attribute__((ext_vector_type(8)));
typedef short s16x4 __attribute__((ext_vector_type(4)));
typedef short v4i16_t __attribute__((ext_vector_type(4)));
typedef float f32x16 __attribute__((ext_vector_type(16)));
typedef LAS unsigned char* lptr;
constexpr float LOG2E = 1.4426950408889634f;
constexpr float QSCALE = 0.08838834764831845f * 1.4426950408889634f;
constexpr float SB_DONE = -150.0f;

__device__ __forceinline__ s16x4 vtr(const LAS unsigned char* p) { return __builtin_bit_cast(s16x4, __builtin_amdgcn_ds_read_tr16_b64_v4i16((LAS v4i16_t*)p)); }
__device__ __forceinline__ float swap_lo(float x, float& other_hi) { auto rr = __builtin_amdgcn_permlane32_swap(__float_as_uint(x), __float_as_uint(x), false, false); other_hi = __uint_as_float(rr[1]); return __uint_as_float(rr[0]); }

template <int KW, int VW, int TK> struct KVStage {
    static constexpr int KBYTES = TK * KW * 2, VBYTES = TK * VW * 2, BUF = KBYTES + VBYTES, NK = KBYTES / 8192, NV = VBYTES / 8192, VDB = TK * 64  ;
    unsigned voffK[NK], voffV[NV];
    __device__ __forceinline__ void init(int wid, int lane) {
#pragma unroll
        for (int j = 0; j < NK; ++j) { const int pos = (wid * NK + j) * 64 + lane; int row, c16;
            if (KW == 128) { row = pos >> 4; c16 = (pos & 15) ^ (row & 15); } else { row = pos >> 5; c16 = ((pos >> 4) & 1) * 16 + ((pos & 15) ^ (row & 15)); }
            voffK[j] = (unsigned)(row * D + c16 * 8) * 2u; }
#pragma unroll
        for (int j = 0; j < NV; ++j) { const int pos = (wid * NV + j) * 64 + lane; const int dblk = pos / (TK * 4), row = (pos >> 2) % TK, sub = pos & 3;
            voffV[j] = (unsigned)(row * D + (dblk * 4 + sub) * 8) * 2u; }
    }
    __device__ __forceinline__ void issue(lptr buf, const bf16* kp, const bf16* vp, int wid) const {
#pragma unroll
        for (int j = 0; j < NK; ++j) __builtin_amdgcn_global_load_lds((const unsigned*)((const char*)kp + voffK[j]), (LAS unsigned*)(buf + (wid * NK + j) * 1024), 16, 0, 0);
#pragma unroll
        for (int j = 0; j < NV; ++j) __builtin_amdgcn_global_load_lds((const unsigned*)((const char*)vp + voffV[j]), (LAS unsigned*)(buf + KBYTES + (wid * NV + j) * 1024), 16, 0, 0);
    }
};

template <int KPITCH> __device__ __forceinline__ void qkt1(f32x16& p, const LAS unsigned char* Kb, int mp, const bf16x8* qr, int r32, int hi) {
    const int xk = (r32 & 15) << 4; const LAS unsigned char* k0 = Kb + r32 * KPITCH + mp * 256;
#pragma unroll
    for (int ks = 0; ks < 8; ++ks) { const int cb = (ks * 32 + hi * 16) ^ xk;
        const bf16x8 a0 = *(const LAS bf16x8*)(k0 + cb);
        p = __builtin_amdgcn_mfma_f32_32x32x16_bf16(a0, qr[ks], p, 0, 0, 0); }
}
template <int NDB, int NS, int VDB> __device__ __forceinline__ void pv(f32x16* o, const LAS unsigned char* Vb, int lane, const bf16x8* pf) {
    const LAS unsigned char* vb = Vb + (4 * (lane >> 5) + ((lane & 15) >> 2)) * 64 + ((lane >> 4) & 1) * 32 + (lane & 3) * 8;
#pragma unroll
    for (int db = 0; db < NDB; ++db)
#pragma unroll
        for (int s = 0; s < NS; ++s) { const s16x4 lo = vtr(vb + db * VDB + s * 1024), hi4 = vtr(vb + db * VDB + s * 1024 + 512);
            const bf16x8 vf = (bf16x8){lo[0], lo[1], lo[2], lo[3], hi4[0], hi4[1], hi4[2], hi4[3]};
            o[db] = __builtin_amdgcn_mfma_f32_32x32x16_bf16(vf, pf[s], o[db], 0, 0, 0);
            if (NDB == 8 && (db & 1) == 1 && s == NS - 1) __builtin_amdgcn_sched_barrier(0); }
}
__device__ __forceinline__ void pack_p(bf16x8* pf, const f32x16& p) {
#pragma unroll
    for (int s = 0; s < 2; ++s) { v4u a;
        a.x = pk2(p[8 * s + 0], p[8 * s + 1]); a.y = pk2(p[8 * s + 2], p[8 * s + 3]); a.z = pk2(p[8 * s + 4], p[8 * s + 5]); a.w = pk2(p[8 * s + 6], p[8 * s + 7]);
        pf[s] = __builtin_bit_cast(bf16x8, a); }
}

template <bool SAMPLE>
__device__ __forceinline__ void sb_unit(lptr ring, volatile LAS int* flags, const bf16* Qb, const bf16* Kb, const bf16* Vb, const bf16* CK, const bf16* CV, bf16* Ob,
                                        int b, int h, int qb, int wid, int lane) {
    KVStage<128, 128, 64> st; st.init(wid, lane);
    constexpr int BUF = KVStage<128, 128, 64>::BUF, KBYTES = KVStage<128, 128, 64>::KBYTES;
    const int r32 = lane & 31, hi = lane >> 5;
    const int qbase = SAMPLE ? PAST : 256 * qb + 32 * wid;
    const int qpos = qbase + r32;
    const size_t qrow = SAMPLE ? (size_t)(MP + 16 * b + r32) : (size_t)b * SEQ + qpos;
    const bool live = SAMPLE ? (wid == 0) : true;
    const bool rvalid = SAMPLE ? (wid == 0 && r32 < 16) : true;
    const int jt_hi = SAMPLE ? 32 : 4 * qb + 3;
    const int coff = h * 128;
    bf16x8 qr[8];
#pragma unroll
    for (int ks = 0; ks < 8; ++ks) qr[ks] = *(const bf16x8*)(Qb + qrow * D + coff + ks * 16 + hi * 8);
    f32x16 o[4];
#pragma unroll
    for (int i = 0; i < 4; ++i) o[i] = f32x16{};
    float C = 0.f;
#define SB_TILE_PTRS(jt_, kp_, vp_) do { size_t off_; \
        if (!SAMPLE) { off_ = ((size_t)b * SEQ + 64 * (size_t)(jt_)) * D + coff; kp_ = Kb + off_; vp_ = Vb + off_; } \
        else if ((jt_) == 32) { off_ = (size_t)(MP + 16 * b) * D + coff; kp_ = Kb + off_; vp_ = Vb + off_; } \
        else { off_ = ((size_t)b * PAST + 64 * (size_t)(jt_)) * D + coff; kp_ = CK + off_; vp_ = CV + off_; } } while (0)
    int jt = jt_hi, it = 0;
    { const bf16 *kp, *vp; SB_TILE_PTRS(jt, kp, vp); st.issue(ring, kp, vp, wid); }
    VM_WAIT(); __syncthreads();
    bool wdone = !live;
    for (;;) {
        const lptr cur = ring + (it & 1) * BUF, nxt = ring + ((it & 1) ^ 1) * BUF;
        const bool has_next = jt > 0;
        if (has_next) { const bf16 *kp, *vp; SB_TILE_PTRS(jt - 1, kp, vp); st.issue(nxt, kp, vp, wid); }
        const int kmin = 64 * jt;
        if (!wdone && kmin < qbase + 31) {
            f32x16 p0 = f32x16{}, p1 = f32x16{};
            qkt1<256>(p0, cur, 0, qr, r32, hi); qkt1<256>(p1, cur + 32 * 256, 0, qr, r32, hi);
            f32x16 L0, L1;
#pragma unroll
            for (int r = 0; r < 16; ++r) {
                const float z0 = p0[r], z1 = p1[r];
                L0[r] = -(fmaxf(z0, 0.f) + __builtin_amdgcn_logf(1.0f + __builtin_amdgcn_exp2f(-fabsf(z0))));
                L1[r] = -(fmaxf(z1, 0.f) + __builtin_amdgcn_logf(1.0f + __builtin_amdgcn_exp2f(-fabsf(z1)))); }
            const bool need_mask = (kmin + 63 >= qbase);
            if (need_mask) {
                const float df = (float)(qpos - kmin - 4 * hi);
#pragma unroll
                for (int r = 0; r < 16; ++r) { const float c = (float)((r & 3) + 8 * (r >> 2));
                    const float f0 = __builtin_amdgcn_fmed3f(df - c, 0.f, 1.f), f1 = __builtin_amdgcn_fmed3f(df - (c + 32.f), 0.f, 1.f);
                    L0[r] *= f0; p0[r] += f0 * 1e30f - 1e30f; L1[r] *= f1; p1[r] += f1 * 1e30f - 1e30f; } }
            float T[8];
#pragma unroll
            for (int g = 0; g < 4; ++g) {
                L0[4 * g + 2] += L0[4 * g + 3]; L0[4 * g + 1] += L0[4 * g + 2]; L0[4 * g] += L0[4 * g + 1]; T[g] = L0[4 * g];
                L1[4 * g + 2] += L1[4 * g + 3]; L1[4 * g + 1] += L1[4 * g + 2]; L1[4 * g] += L1[4 * g + 1]; T[4 + g] = L1[4 * g]; }
            float off[8]; float run = 0.f;
#pragma unroll
            for (int g = 7; g >= 0; --g) { float t1; const float t0 = swap_lo(T[g], t1); off[g] = C + run + (hi == 0 ? t1 : 0.f); run += t0 + t1; }
#pragma unroll
            for (int g = 0; g < 4; ++g)
#pragma unroll
                for (int i = 0; i < 4; ++i) { const int r = 4 * g + i;
                    p0[r] = __builtin_amdgcn_exp2f(p0[r] + L0[r] + off[g]);
                    p1[r] = __builtin_amdgcn_exp2f(p1[r] + L1[r] + off[4 + g]); }
            C += run;
            bf16x8 pf[4]; pack_p(pf, p0); pack_p(pf + 2, p1);
            pv<4, 4, 4096>(o, cur + KBYTES, lane, pf);
            wdone = __all((!rvalid) || (C < SB_DONE));
        }
        if (lane == 0) flags[(it & 1) * 8 + wid] = wdone ? 1 : 0;
        VM_WAIT(); LDS_WAIT(); __syncthreads();
        if (!has_next) break;
        int all = 1;
#pragma unroll
        for (int w = 0; w < 8; ++w) all &= flags[(it & 1) * 8 + w];
        if (all) break;
        --jt; ++it;
    }
#undef SB_TILE_PTRS
    if (rvalid) {
#pragma unroll
        for (int db = 0; db < 4; ++db)
#pragma unroll
            for (int gq = 0; gq < 4; ++gq) { v2u w; w.x = pk2(o[db][4 * gq], o[db][4 * gq + 1]); w.y = pk2(o[db][4 * gq + 2], o[db][4 * gq + 3]);
                *(v2u*)(Ob + qrow * D + coff + 32 * db + 8 * gq + 4 * hi) = w; }
    }
}

template <bool SAMPLE>
__device__ __forceinline__ void diff_unit(lptr ring, const LAS float* gtab, volatile LAS float* qn, const float* kn, const bf16* Qb, const bf16* Kb, const bf16* Vb, const bf16* CK, const bf16* CV, bf16* Ob,
                                          int b, int h8, int qb, float lam, int wid, int lane) {
    asm volatile("" : "+v"(lane));
    KVStage<256, 256, 32> st; st.init(wid, lane);
    constexpr int BUF = KVStage<256, 256, 32>::BUF, KBYTES = KVStage<256, 256, 32>::KBYTES, VDB = KVStage<256, 256, 32>::VDB;
    const int r32 = lane & 31, hi = lane >> 5, mp = wid >> 2, sb = wid & 3;
    const int qbase = SAMPLE ? PAST : 128 * qb + 32 * sb;
    const int qpos = qbase + r32;
    const size_t qrow = SAMPLE ? (size_t)(MP + 16 * b + r32) : (size_t)b * SEQ + qpos;
    const bool live = SAMPLE ? (sb == 0) : true;
    const bool rvalid = SAMPLE ? (sb == 0 && r32 < 16) : true;
    const int wchunk = SAMPLE ? 32 : (qbase >> 6);
    const int jt_hi = SAMPLE ? 64 : 4 * qb + 3;
    const int coff = h8 * 256;
    const float slope2 = __builtin_amdgcn_exp2f(-(float)(h8 + 1)) * LOG2E;
    const int xk = (r32 & 15) << 4;
    const lptr qs = ring + 65536 + wid * 8192 + lane * 16;
    float q2 = 0.f;
#pragma unroll
    for (int ks = 0; ks < 8; ++ks) { const bf16x8 qf = *(const bf16x8*)(Qb + qrow * D + coff + mp * 128 + ks * 16 + hi * 8); *(LAS bf16x8*)(qs + ks * 1024) = qf;
        if (!SAMPLE) {
#pragma unroll
            for (int e = 0; e < 8; ++e) { const float x = __uint_as_float((unsigned)(unsigned short)qf[e] << 16); q2 = fmaf(x, x, q2); } } }
    if (!SAMPLE) {
        { float t1; const float t0 = swap_lo(q2, t1); q2 = t0 + t1; }
        q2 = fmaxf(q2, __shfl_xor(q2, 1)); q2 = fmaxf(q2, __shfl_xor(q2, 2)); q2 = fmaxf(q2, __shfl_xor(q2, 4)); q2 = fmaxf(q2, __shfl_xor(q2, 8)); q2 = fmaxf(q2, __shfl_xor(q2, 16));
        if (lane == 0) qn[wid] = q2; }
    f32x16 o[8];
#pragma unroll
    for (int i = 0; i < 8; ++i) o[i] = f32x16{};
    float m = -INFINITY, l = 0.f;
#define DF_TILE_PTRS(jt_, kp_, vp_) do { size_t off_; \
        if (!SAMPLE) { off_ = ((size_t)b * SEQ + 32 * (size_t)(jt_)) * D + coff; kp_ = Kb + off_; vp_ = Vb + off_; } \
        else if ((jt_) == 64) { off_ = (size_t)(MP + 16 * b) * D + coff; kp_ = Kb + off_; vp_ = Vb + off_; } \
        else { off_ = ((size_t)b * PAST + 32 * (size_t)(jt_)) * D + coff; kp_ = CK + off_; vp_ = CV + off_; } } while (0)
    { const bf16 *kp, *vp; DF_TILE_PTRS(jt_hi, kp, vp); st.issue(ring, kp, vp, wid); }
    VM_WAIT(); LDS_WAIT(); __syncthreads();
    int jt_lo = 0;
    if (!SAMPLE) {
        const float* knb = kn + (b * 16 + 2 * h8) * 4;
        const float k0s = (knb[0] + knb[1]) + (knb[2] + knb[3]), k1s = (knb[4] + knb[5]) + (knb[6] + knb[7]);
        const float q0m = fmaxf(fmaxf(qn[0], qn[1]), fmaxf(qn[2], qn[3])), q1m = fmaxf(fmaxf(qn[4], qn[5]), fmaxf(qn[6], qn[7]));
        const float Z = 1.02f * sqrtf(fmaxf(q0m * k0s, q1m * k1s));
        const float nneed = (154.f + 2.f * Z) / slope2;
        const float lo = floorf(((float)(128 * qb) - nneed) * (1.0f / 32.0f));
        jt_lo = lo > 0.f ? (int)lo : 0;
        jt_lo = __builtin_amdgcn_readfirstlane(jt_lo);
    }
    int it = 0;
    for (int jt = jt_hi; jt >= jt_lo; --jt, ++it) {
        const lptr cur = ring + (it & 1) * BUF, nxt = ring + ((it & 1) ^ 1) * BUF;
        if (jt > jt_lo) { const bf16 *kp, *vp; DF_TILE_PTRS(jt - 1, kp, vp); st.issue(nxt, kp, vp, wid); }
        if (live && (jt >> 1) <= wchunk) {
            f32x16 p = f32x16{};
            { const LAS unsigned char* k0 = cur + r32 * 512 + mp * 256;
#pragma unroll
              for (int ks = 0; ks < 8; ++ks) { const int cb = (ks * 32 + hi * 16) ^ xk;
                  p = __builtin_amdgcn_mfma_f32_32x32x16_bf16(*(const LAS bf16x8*)(k0 + cb), *(const LAS bf16x8*)(qs + ks * 1024), p, 0, 0, 0);
                  if ((ks & 1) == 1) __builtin_amdgcn_sched_barrier(0); } }
            const float dqf = (float)(qpos - 32 * jt - 4 * hi);
#pragma unroll
            for (int r = 0; r < 16; ++r) { const float c = (float)((r & 3) + 8 * (r >> 2)); p[r] = fmaf(-slope2, fabsf(dqf - c), p[r]); }
            if (SAMPLE && jt == 64) {
#pragma unroll
                for (int r = 8; r < 16; ++r) p[r] = -INFINITY; }
            float tm = p[0];
#pragma unroll
            for (int r = 1; r < 16; ++r) tm = fmaxf(tm, p[r]);
            { float t1; const float t0 = swap_lo(tm, t1); tm = fmaxf(t0, t1); }
            if (__any(tm > m)) { const float mn = fmaxf(m, tm); const float alpha = __builtin_amdgcn_exp2f(m - mn); m = mn; l *= alpha;
#pragma unroll
                for (int db = 0; db < 8; ++db)
#pragma unroll
                    for (int r = 0; r < 16; ++r) o[db][r] *= alpha; }
            float ps = 0.f;
#pragma unroll
            for (int r = 0; r < 16; ++r) { p[r] = __builtin_amdgcn_exp2f(p[r] - m); ps += p[r]; }
            l += ps;
            bf16x8 pf[2]; pack_p(pf, p);
            pv<8, 2, VDB>(o, cur + KBYTES, lane, pf);
        }
        VM_WAIT(); LDS_WAIT(); __syncthreads();
    }
#undef DF_TILE_PTRS
    { float t1; const float t0 = swap_lo(l, t1); l = t0 + t1; }
    const float inv = live ? 1.0f / l : 0.f;
    const lptr xb = ring + sb * 32768 + lane * 16;
    if (mp == 1) { const float sc = lam * inv;
#pragma unroll
        for (int v = 0; v < 32; ++v) { const int db = v >> 2, gq = v & 3; f32x4 x = {o[db][4 * gq] * sc, o[db][4 * gq + 1] * sc, o[db][4 * gq + 2] * sc, o[db][4 * gq + 3] * sc};
            *(LAS f32x4*)(xb + v * 1024) = x; } }
    LDS_WAIT(); __syncthreads();
    if (mp == 0) { float ss = 0.f;
#pragma unroll
        for (int v = 0; v < 32; ++v) { const int db = v >> 2, gq = v & 3; const f32x4 x = *(const LAS f32x4*)(xb + v * 1024);
#pragma unroll
            for (int e = 0; e < 4; ++e) { const float y = o[db][4 * gq + e] * inv - x[e]; o[db][4 * gq + e] = y; ss += y * y; }
            if ((v & 3) == 3) asm volatile("" ::: "memory"); }
        { float t1; const float t0 = swap_lo(ss, t1); ss = t0 + t1; }
        const float rs = 1.0f / sqrtf(ss * (1.0f / 256.0f) + 1e-5f);
        if (rvalid) {
#pragma unroll
            for (int v = 0; v < 32; ++v) { const int db = v >> 2, gq = v & 3; const int d0 = 32 * db + 8 * gq + 4 * hi; const f32x4 g4 = *(const LAS f32x4*)(gtab + d0);
                v2u w; w.x = pk2(o[db][4 * gq] * rs * g4[0], o[db][4 * gq + 1] * rs * g4[1]); w.y = pk2(o[db][4 * gq + 2] * rs * g4[2], o[db][4 * gq + 3] * rs * g4[3]);
                *(v2u*)(Ob + qrow * D + coff + d0) = w;
                if ((v & 3) == 3) asm volatile("" ::: "memory"); } }
    }
    LDS_WAIT(); __syncthreads();
}
}
__device__ __forceinline__ int lane_id_fresh() { int l; asm volatile("v_mbcnt_lo_u32_b32 %0, -1, 0\n\tv_mbcnt_hi_u32_b32 %0, -1, %0" : "=v"(l)); return l; }
__device__ __forceinline__ void transpose_item(const float* W, int K, int N, bf16* WT, LAS float* scr, int item, int lane) {
    const int nblk = N / 32, kb = item / nblk, nb = item % nblk, k0 = 64 * kb, n0 = 32 * nb;
#pragma unroll 8
    for (int i = 0; i < 32; ++i) { const int kk = 2 * i + (lane >> 5); scr[kk * 33 + (lane & 31)] = W[(size_t)(k0 + kk) * N + n0 + (lane & 31)]; }
    LDS_WAIT(); asm volatile("" ::: "memory");
    const int c = lane & 7;
#pragma unroll
    for (int j = 0; j < 4; ++j) { const int n = (lane >> 3) + 8 * j; const LAS float* s = scr + (8 * c) * 33 + n;
        v4u o; o.x = pk2(s[0 * 33], s[1 * 33]); o.y = pk2(s[2 * 33], s[3 * 33]); o.z = pk2(s[4 * 33], s[5 * 33]); o.w = pk2(s[6 * 33], s[7 * 33]);
        *(v4u*)(WT + (size_t)(n0 + n) * K + k0 + 8 * c) = o; }
    LDS_WAIT(); asm volatile("" ::: "memory");
}
__device__ __forceinline__ void xn_rows(const float* srcp, const float* srcs, const float* g, bf16* XN, int gw, int NGW, int lane) {
    for (int m = gw; m < M; m += NGW) {
        v2u* o8 = (v2u*)(XN + (size_t)m * D) + lane;
        if (m < MV) {
            const f32x4* xr = (const f32x4*)(m < MP ? srcp + (size_t)m * D : srcs + (size_t)(m - MP) * D) + lane;
            f32x4 v[8]; float ss = 0.f;
#pragma unroll
            for (int j = 0; j < 8; ++j) { v[j] = xr[64 * j]; ss += (v[j].x * v[j].x + v[j].y * v[j].y) + (v[j].z * v[j].z + v[j].w * v[j].w); }
            const float rs = 1.0f / sqrtf(wave_sum(ss) * (1.0f / D) + 1e-6f);
#pragma unroll
            for (int j = 0; j < 8; ++j) { const f32x4 gv = ((const f32x4*)g)[lane + 64 * j]; v2u w; w.x = pk2(v[j].x * rs * gv.x, v[j].y * rs * gv.y); w.y = pk2(v[j].z * rs * gv.z, v[j].w * rs * gv.w); o8[64 * j] = w; }
        } else {
#pragma unroll
            for (int j = 0; j < 8; ++j) o8[64 * j] = (v2u){0u, 0u};
        }
    }
}
__device__ __forceinline__ void final_rows(float* X, const float* g, int gw, int NGW, int lane) {
    for (int m = gw; m < MV; m += NGW) {
        f32x4* xr = (f32x4*)(X + (size_t)m * D) + lane;
        f32x4 v[8]; float ss = 0.f;
#pragma unroll
        for (int j = 0; j < 8; ++j) { v[j] = xr[64 * j]; ss += (v[j].x * v[j].x + v[j].y * v[j].y) + (v[j].z * v[j].z + v[j].w * v[j].w); }
        const float rs = 1.0f / sqrtf(wave_sum(ss) * (1.0f / D) + 1e-6f);
#pragma unroll
        for (int j = 0; j < 8; ++j) { const f32x4 gv = ((const f32x4*)g)[lane + 64 * j]; xr[64 * j] = (v[j] * rs) * gv; }
    }
}
__device__ __forceinline__ void cache_convert(const float* ck, const float* cv, bf16* CK, bf16* CV, size_t gt, size_t NT) {
    constexpr size_t NCH = (size_t)DEC_B * PAST * D / 8;
    for (size_t i = gt; i < 2 * NCH; i += NT) { const bool t = i >= NCH; const size_t c = t ? i - NCH : i;
        const f32x4* s = (const f32x4*)((t ? cv : ck) + c * 8); const f32x4 a = s[0], b2 = s[1];
        v4u o; o.x = pk2(a.x, a.y); o.y = pk2(a.z, a.w); o.z = pk2(b2.x, b2.y); o.w = pk2(b2.z, b2.w);
        *(v4u*)((t ? CV : CK) + c * 8) = o; }
}

struct Args { const float* in[16]; float* out; unsigned char* ws; int ph_lo, ph_hi; };
struct SkQKV { unsigned char* ws; float* out; int L; float qscale;
    __device__ __forceinline__ void operator()(int row, int col, float v) const { const int t = col >> 11, c = col & 2047;
        bf16* ob = (bf16*)(ws + QKV_WS_Q + (size_t)t * QKV_WS_STRIDE) + (size_t)row * D + c;
        const float sv = t == 0 ? v * qscale : v; *ob = (bf16)(pk2(sv, 0.f) & 0xffffu);
        if (t != 0) { float* fs = out + (t == 1 ? QKV_OUT_KS : QKV_OUT_VS) + (size_t)L * MS * D; fs[(size_t)(row - MP) * D + c] = v; } } };
struct SkResid { const float* rs; float* out;
    __device__ __forceinline__ void operator()(int row, int col, float v) const { const size_t i = (size_t)(row - MP) * D + col; out[i] = rs[i] + v; } };
struct SkRelu2 { bf16* O; int ldc;
    __device__ __forceinline__ void operator()(int row, int col, float v) const { const float a = fmaxf(v, 0.f); O[(size_t)row * ldc + col] = (bf16)(pk2(a * a, 0.f) & 0xffffu); } };
template <class Epi>
__device__ __forceinline__ void skinny_phase(LAS unsigned char* ring, const bf16* A, const bf16* Bt, int N, int K, const Epi& E, int vcu, int G, int wave, int lane) {
    typedef short bf16x8 __attribute__((ext_vector_type(8))); typedef float f32x16 __attribute__((ext_vector_type(16)));
    const int ntile = 4 * (N / 32), r32 = lane & 31, hi = lane >> 5, kw = K / 8;
    LAS float* red = (LAS float*)ring;
    for (int t = vcu; t < ntile; t += G) {
        const int mb = t & 3, nb = t >> 2;
        const bf16* ap = A + (size_t)(MP + 32 * mb + r32) * K + wave * kw + hi * 8;
        const bf16* bp = Bt + (size_t)(32 * nb + r32) * K + wave * kw + hi * 8;
        f32x16 acc = f32x16{};
        for (int k0 = 0; k0 < kw; k0 += 256) {
            bf16x8 a[16], b[16];
#pragma unroll
            for (int j = 0; j < 16; ++j) { a[j] = *(const bf16x8*)(ap + k0 + 16 * j); b[j] = *(const bf16x8*)(bp + k0 + 16 * j); }
#pragma unroll
            for (int j = 0; j < 16; ++j) acc = __builtin_amdgcn_mfma_f32_32x32x16_bf16(a[j], b[j], acc, 0, 0, 0);
        }
#pragma unroll
        for (int r = 0; r < 16; ++r) red[(wave * 16 + r) * 64 + lane] = acc[r];
        LDS_WAIT(); __syncthreads();
        float v0 = 0.f, v1 = 0.f;
#pragma unroll
        for (int w = 0; w < 8; ++w) { v0 += red[(w * 16 + 2 * wave) * 64 + lane]; v1 += red[(w * 16 + 2 * wave + 1) * 64 + lane]; }
        const int r0 = 2 * wave, row0 = MP + 32 * mb + (r0 & 3) + 8 * (r0 >> 2) + 4 * hi, col = 32 * nb + r32;
        E(row0, col, v0); E(row0 + 1, col, v1);
        LDS_WAIT(); __syncthreads();
    }
}

#ifndef PROBE_DUP
#define PROBE_DUP 0
#endif
template <int L>
__device__ __forceinline__ void layer_phases(const Args& args, LAS unsigned char* lds, volatile LAS int* flags, LAS float* gtab, const XcdBarrier& bar, int lo, int hi, int G, int vcu, int wave) {
#define PHASE_LOCALS const int lane = lane_id_fresh(); const int tid = wave * 64 + lane;
#define IN(k) (lo <= (k) && (k) < hi)
#define SEAM(k) do { if (ONE_LAUNCH && IN(k) && IN((k) + 1)) xcd_barrier(bar); } while (0)
    unsigned char* ws = args.ws;
    const float* x_prompt = args.in[0]; const float* x_sample = args.in[1];
    float* X = args.out + OUT_Y;
    bf16* XN = (bf16*)(ws + WS_XN); bf16* CK = (bf16*)(ws + WS_CK); bf16* CV = (bf16*)(ws + WS_CV);
    bf16* Qb = (bf16*)(ws + WS_Q); bf16* Kb = (bf16*)(ws + WS_K); bf16* Vb = (bf16*)(ws + WS_V); bf16* Hb = (bf16*)(ws + WS_H);
    const int gw = vcu * NWAVES + wave, NGW = G * NWAVES;

        const int pb = 1 + 7 * L;
        unsigned char* wl = ws + WS_W + (size_t)L * W_LAYER;
        const bf16* Wqkv_t = (const bf16*)(wl + W_QKV); const bf16* Wo_t = (const bf16*)(wl + W_O); const bf16* Wup_t = (const bf16*)(wl + W_UP); const bf16* Wdn_t = (const bf16*)(wl + W_DN);
        constexpr bool DUPG = (L == 0) && (PROBE_DUP & 2), DUPA = (L == 0 ? (PROBE_DUP & 8) : (PROBE_DUP & 4)) != 0, DUPT = (L == 0) && (PROBE_DUP & 16);
        bf16* const DUMMY_O = (bf16*)(ws + WS_V + (size_t)M * D * 2);
        float* const DUMMY_X = (float*)(ws + WS_XN);
        if (IN(pb)) { PHASE_LOCALS
#pragma unroll
            for (int rep = 0; rep < (DUPG ? 2 : 1); ++rep) {
            pg8::Gemm g{XN, Wqkv_t, MP, 3 * D, D}; pg8::StaticOrder S; S.init(MP, 3 * D, G, (int)blockIdx.x);
            pg8::EpiQKV E{ws, args.out, L, att::QSCALE, (unsigned*)(ws + WS_CTL) + CW_KN};
            pg8::gemm_phase<pg8::EpiQKV, pg8::StaticOrder, PG8_ALIGN, PG8_SP2>(lds + RING_OFF, g, S, E, wave, lane);
            skinny_phase(lds + RING_OFF, XN, Wqkv_t, 3 * D, D, SkQKV{ws, args.out, L, att::QSCALE}, vcu, G, wave, lane);
            }
        }
        SEAM(pb);
        if (IN(pb + 1)) { PHASE_LOCALS
            if (L == 0) {
#pragma unroll
                for (int rep = 0; rep < (DUPA ? 2 : 1); ++rep) { bf16* const Ob = (DUPA && rep == 0) ? DUMMY_O : Qb;
                for (int u = vcu; u < 2048; u += G) att::sb_unit<false>(lds + RING_OFF, flags, Qb, Kb, Vb, CK, CV, Ob, u >> 9, (u >> 5) & 15, u & 31, wave, lane);
                for (int u = vcu; u < 128; u += G) att::sb_unit<true>(lds + RING_OFF, flags, Qb, Kb, Vb, CK, CV, Ob, u >> 4, u & 15, 0, wave, lane);
                }
            } else {
                constexpr float LAMBDA_INIT = 0.35550906759096926f;
                float s1 = args.in[7][lane] * args.in[8][lane] + args.in[7][lane + 64] * args.in[8][lane + 64];
                float s2 = args.in[9][lane] * args.in[10][lane] + args.in[9][lane + 64] * args.in[10][lane + 64];
                s1 = wave_sum(s1); s2 = wave_sum(s2);
                const float lam = expf(s1) - expf(s2) + LAMBDA_INIT;
                if (tid < 256) gtab[tid] = args.in[11][tid] * (1.0f - LAMBDA_INIT);
                LDS_WAIT(); __syncthreads();
#pragma unroll
                for (int rep = 0; rep < (DUPA ? 2 : 1); ++rep) { bf16* const Ob = (DUPA && rep == 0) ? DUMMY_O : Qb;
                volatile LAS float* qn = (volatile LAS float*)(lds + LDSCTL_OFF + 192);
                volatile LAS int* qslot = (volatile LAS int*)(lds + LDSCTL_OFF + 224);
                const float* kn = (const float*)(ws + WS_CTL) + CW_KN;
                const unsigned q0 = xb_xcc_id() & 7u;
                for (unsigned qk = 0; qk < 8; ++qk) { const unsigned q = (q0 + qk) & 7u; unsigned* head = (unsigned*)(ws + WS_CTL) + CW_QH + 64 * q + 16 * (DUPA ? rep : 0);
                    for (;;) {
                        if (tid == 0) *qslot = (int)atomicAdd(head, 1u);
                        LDS_WAIT(); __syncthreads();
                        const int e = *qslot;
                        __syncthreads();
                        if (e >= 264) break;
                        if (e < 256) { const int qb = 63 - (e >> 2), g4 = e & 3; const int b = 2 * (q >> 2) + (g4 & 1), h8 = (g4 & 2) ? 7 - (q & 3) : (q & 3);
                            att::diff_unit<false>(lds + RING_OFF, gtab, qn, kn, Qb, Kb, Vb, CK, CV, Ob, b, h8, qb, lam, wave, lane); }
                        else att::diff_unit<true>(lds + RING_OFF, gtab, qn, kn, Qb, Kb, Vb, CK, CV, Ob, e - 256, q, 0, lam, wave, lane);
                    }
                }
                }
            }
        }
        SEAM(pb + 1);
        if (IN(pb + 2)) { PHASE_LOCALS
#pragma unroll
            for (int rep = 0; rep < (DUPG ? 2 : 1); ++rep) {
            pg8::Gemm g{Qb, Wo_t, MP, D, D}; pg8::StaticOrder S; S.init(MP, D, G, (int)blockIdx.x);
            pg8::EpiResid E{L == 0 ? x_prompt : X, L == 0 ? x_sample : X + (size_t)MP * D, X};
            pg8::gemm_phase<pg8::EpiResid, pg8::StaticOrder, PG8_ALIGN, PG8_SP2>(lds + RING_OFF, g, S, E, wave, lane);
            skinny_phase(lds + RING_OFF, Qb, Wo_t, D, D, SkResid{L == 0 ? x_sample : X + (size_t)MP * D, X + (size_t)MP * D}, vcu, G, wave, lane);
            }
        }
        SEAM(pb + 2);
        if (IN(pb + 3)) { PHASE_LOCALS xn_rows(X, X + (size_t)MP * D, args.in[12] + (size_t)L * D, XN, gw, NGW, lane); if (DUPT) xn_rows(X, X + (size_t)MP * D, args.in[12] + (size_t)L * D, XN, gw, NGW, lane); }
        SEAM(pb + 3);
        if (IN(pb + 4)) { PHASE_LOCALS
#pragma unroll
            for (int rep = 0; rep < (DUPG ? 2 : 1); ++rep) {
            pg8::Gemm g{XN, Wup_t, MP, FF, D}; pg8::StaticOrder S; S.init(MP, FF, G, (int)blockIdx.x);
            pg8::EpiRelu2 E{Hb, FF};
            pg8::gemm_phase<pg8::EpiRelu2, pg8::StaticOrder, PG8_ALIGN, PG8_SP2>(lds + RING_OFF, g, S, E, wave, lane);
            skinny_phase(lds + RING_OFF, XN, Wup_t, FF, D, SkRelu2{Hb, FF}, vcu, G, wave, lane);
            }
        }
        SEAM(pb + 4);
        if (IN(pb + 5)) { PHASE_LOCALS
#pragma unroll
            for (int rep = 0; rep < (DUPG ? 2 : 1); ++rep) {
            pg8::Gemm g{Hb, Wdn_t, MP, D, FF}; pg8::StaticOrder S; S.init(MP, D, G, (int)blockIdx.x);
            pg8::EpiResid E{X, X + (size_t)MP * D, (DUPG && rep == 0) ? DUMMY_X : X};
            pg8::gemm_phase<pg8::EpiResid, pg8::StaticOrder, PG8_ALIGN, PG8_SP2>(lds + RING_OFF, g, S, E, wave, lane);
            skinny_phase(lds + RING_OFF, Hb, Wdn_t, D, FF, SkResid{X + (size_t)MP * D, ((DUPG && rep == 0) ? DUMMY_X : X) + (size_t)MP * D}, vcu, G, wave, lane);
            }
        }
        SEAM(pb + 5);
        if (IN(pb + 6)) { PHASE_LOCALS
            if (L == 0) {
#pragma unroll
                for (int rep = 0; rep < (DUPT ? 2 : 1); ++rep) {
                cache_convert(args.in[2] + (size_t)DEC_B * PAST * D, args.in[3] + (size_t)DEC_B * PAST * D, CK, CV, (size_t)vcu * (NWAVES * 64) + tid, (size_t)G * (NWAVES * 64));
                xn_rows(X, X + (size_t)MP * D, args.in[4] + D, XN, gw, NGW, lane); } }
            else final_rows(X, args.in[15], gw, NGW, lane);
        }
        if (L == 0) SEAM(pb + 6);

#undef PHASE_LOCALS
#undef IN
#undef SEAM
}

__global__ void __launch_bounds__(NWAVES * 64, 2) fwd_kernel(Args args) {
    extern __shared__ __attribute__((aligned(16))) unsigned char lds_raw[];
    LAS unsigned char* lds = (LAS unsigned char*)lds_raw;
    volatile LAS unsigned* MISC = (volatile LAS unsigned*)(lds + LDSCTL_OFF);
    volatile LAS int* flags = (volatile LAS int*)(lds + LDSCTL_OFF + 128);
    LAS float* gtab = (LAS float*)(lds + GTAB_OFF);
    const int wave = __builtin_amdgcn_readfirstlane((int)threadIdx.x >> 6);
    const int lane = lane_id_fresh(); const int tid = wave * 64 + lane;
    const int G = gridDim.x; const int bx = blockIdx.x; const int vcu = (G % 8 == 0) ? (bx % 8) * (G / 8) + bx / 8 : bx;
    for (int u = tid; u < 128; u += NWAVES * 64) ((LAS unsigned*)(lds + LDSCTL_OFF))[u] = 0u;
    __syncthreads();
    unsigned char* ws = args.ws;
    gu32* ctl = (gu32*)(ws + WS_CTL);
    XcdBarrier bar; bar.bar = (unsigned*)ctl + CW_BAR; bar.x = 0; bar.st = nullptr; bar.wave = wave;
    if (ONE_LAUNCH) bar = xcd_barrier_post((unsigned*)ctl + CW_BAR, MISC + 8, wave);
    const int lo = args.ph_lo, hi = args.ph_hi;
#define IN(k) (lo <= (k) && (k) < hi)
#define SEAM(k) do { if (ONE_LAUNCH && IN(k) && IN((k) + 1)) xcd_barrier(bar); } while (0)
    const float* x_prompt = args.in[0]; const float* x_sample = args.in[1];
    float* X = args.out + OUT_Y;
    bf16* XN = (bf16*)(ws + WS_XN); bf16* CK = (bf16*)(ws + WS_CK); bf16* CV = (bf16*)(ws + WS_CV);
    bf16* Qb = (bf16*)(ws + WS_Q); bf16* Kb = (bf16*)(ws + WS_K); bf16* Vb = (bf16*)(ws + WS_V); bf16* Hb = (bf16*)(ws + WS_H);
    const int gw = vcu * NWAVES + wave, NGW = G * NWAVES;

    if (IN(0)) {
#pragma unroll
        for (int rep = 0; rep < ((PROBE_DUP & 1) ? 2 : 1); ++rep) {
        LAS float* scr = (LAS float*)(lds + RING_OFF + wave * 16384);
        constexpr int I_QKV = (D / 64) * (3 * D / 32), I_O = (D / 64) * (D / 32), I_UP = (D / 64) * (FF / 32), I_DN = (FF / 64) * (D / 32), I_L = I_QKV + I_O + I_UP + I_DN;
        for (int it = gw; it < 2 * I_L; it += NGW) {
            const int L = it / I_L; int r = it % I_L; unsigned char* wl = ws + WS_W + (size_t)L * W_LAYER;
            if (r < I_QKV) { transpose_item(args.in[5] + (size_t)L * D * 3 * D, D, 3 * D, (bf16*)(wl + W_QKV), scr, r, lane); continue; } r -= I_QKV;
            if (r < I_O) { transpose_item(args.in[6] + (size_t)L * D * D, D, D, (bf16*)(wl + W_O), scr, r, lane); continue; } r -= I_O;
            if (r < I_UP) { transpose_item(args.in[13] + (size_t)L * D * FF, D, FF, (bf16*)(wl + W_UP), scr, r, lane); continue; } r -= I_UP;
            transpose_item(args.in[14] + (size_t)L * FF * D, FF, D, (bf16*)(wl + W_DN), scr, r, lane);
        }
        cache_convert(args.in[2], args.in[3], CK, CV, (size_t)vcu * (NWAVES * 64) + tid, (size_t)G * (NWAVES * 64));
        xn_rows(x_prompt, x_sample, args.in[4], XN, gw, NGW, lane);
        for (int i = vcu * (NWAVES * 64) + tid; i < 3 * (M - MV) * D / 8; i += G * (NWAVES * 64)) { const int t = i / ((M - MV) * D / 8), c = i % ((M - MV) * D / 8);
            *(v4u*)(ws + WS_Q + (size_t)t * (WS_K - WS_Q) + ((size_t)MV * D + (size_t)c * 8) * 2) = (v4u){0u, 0u, 0u, 0u}; }
        }
    }
    SEAM(0);

    layer_phases<0>(args, lds, flags, gtab, bar, lo, hi, G, vcu, wave);
    layer_phases<1>(args, lds, flags, gtab, bar, lo, hi, G, vcu, wave);
#undef IN
#undef SEAM
}

extern "C" void kernel_launch(void* const* d_in, const int* in_sizes, int n_in, void* d_out, int out_size, void* d_ws, size_t ws_size, hipStream_t stream) {
    static int grid = 0;
    if (grid == 0) {
        if (n_in != 16 || (size_t)out_size != OUT_END || ws_size < WS_END) { fprintf(stderr, "kernel_launch: unexpected shapes (n_in %d out %d ws %zu)\n", n_in, out_size, ws_size); grid = -1; return; }
        int dev = 0, cus = 0;
        if (hipGetDevice(&dev) != hipSuccess || hipDeviceGetAttribute(&cus, hipDeviceAttributeMultiprocessorCount, dev) != hipSuccess) { grid = -1; return; }
        if (hipFuncSetAttribute((const void*)fwd_kernel, hipFuncAttributeMaxDynamicSharedMemorySize, LDS_BYTES) != hipSuccess) { fprintf(stderr, "kernel_launch: hipFuncSetAttribute failed\n"); grid = -1; return; }
        int per_cu = 0;
        if (hipOccupancyMaxActiveBlocksPerMultiprocessor(&per_cu, (const void*)fwd_kernel, NWAVES * 64, LDS_BYTES) != hipSuccess || per_cu < 1) fprintf(stderr, "kernel_launch: occupancy query says %d\n", per_cu);
        (void)hipGetLastError();
        grid = cus;
    }
    if (grid < 0) return;
    (void)hipMemsetAsync((char*)d_ws + WS_CTL, 0, CTL_ZERO_BYTES, stream);
    Args a{};
    for (int i = 0; i < 16; ++i) a.in[i] = (const float*)d_in[i];
    a.out = (float*)d_out; a.ws = (unsigned char*)d_ws;
    if (ONE_LAUNCH) { a.ph_lo = 0; a.ph_hi = N_PHASES; hipLaunchKernelGGL(fwd_kernel, dim3(grid), dim3(NWAVES * 64), LDS_BYTES, stream, a); }
    else for (int p = 0; p < N_PHASES; ++p) { a.ph_lo = p; a.ph_hi = p + 1; hipLaunchKernelGGL(fwd_kernel, dim3(grid), dim3(NWAVES * 64), LDS_BYTES, stream, a); }
}
```

```cpp
#include <hip/hip_runtime.h>
#include <cstdio>
#include <cstdint>
constexpr int D = 2048, BATCH = 4, SEQ = 8192, DEC_B = 8, DEC_T = 16, PAST = 2048, FF = 8192;
constexpr int MP = BATCH * SEQ;
constexpr int MS = DEC_B * DEC_T;
constexpr int MV = MP + MS;
constexpr int M = 33024;
constexpr size_t QKV_WS_Q = (size_t)451 << 20, QKV_WS_STRIDE = (size_t)129 << 20;
constexpr size_t QKV_OUT_KP = (size_t)MV * D, QKV_OUT_VP = QKV_OUT_KP + 2 * (size_t)MP * D, QKV_OUT_KS = QKV_OUT_VP + 2 * (size_t)MP * D, QKV_OUT_VS = QKV_OUT_KS + 2 * (size_t)MS * D;
#ifndef EXPAND_L1
#define EXPAND_L1 0
#endif
#ifndef KV_STORE_POLICY
#define KV_STORE_POLICY 3
#define KV_STORE_BITS "sc0 sc1 nt"
#endif
namespace pg8 {
#define PG8_LAS __attribute__((address_space(3)))
#ifndef PG8_NREMAP
#define PG8_NREMAP 0
#endif
constexpr int PG8_WCS = PG8_NREMAP ? 64 : 32, PG8_BJS = PG8_NREMAP ? 32 : 128;
typedef unsigned short bf16_t;
typedef short bf16x8 __attribute__((ext_vector_type(8)));
typedef float f32x4 __attribute__((ext_vector_type(4)));
typedef unsigned u32x4 __attribute__((ext_vector_type(4)));
constexpr int BM = 256, BK = 64, HALF = 128, HTB = HALF * BK * 2  , STAGE_BYTES = 8 * HTB, NXCD = 8, WGM = 8;

__host__ __device__ __forceinline__ int lds_byte(int r, int c) { const int st = (r >> 4) * 2 + (c >> 5), rr = r & 15, cc = c & 31, ob = rr * 64 + cc * 2; return st * 1024 + (ob ^ (((ob >> 9) & 1) << 5)); }
__host__ __device__ __forceinline__ void stage_rc(int b, int& R, int& C) { const int st = b / 1024, sb = b % 1024, swz = sb ^ (((sb >> 9) & 1) << 5); R = (st >> 1) * 16 + swz / 64; C = (st & 1) * 32 + (swz % 64) / 2; }
__host__ __device__ __forceinline__ int perm32(int rho) { const int n = rho >> 4, i = rho & 15; return 8 * (i >> 2) + 4 * n + (i & 3); }

struct Unit { int pm, pn; };
struct Gemm { const bf16_t* A; const bf16_t* Bt; int M, N, K; };

struct StaticOrder {
    int nM, nN, nwg, G, c, wgm;
    __host__ __device__ void init(int M, int N, int G_, int c_, int wgm_ = WGM) { nM = M / BM; nN = N / BM; nwg = nM * nN; G = G_; c = c_; wgm = wgm_; }
    __host__ __device__ bool next(int i, Unit& u) const {
        const long L = (long)i * G + c; if (L >= nwg) return false;
        int wgid = (int)L; { const int q = nwg / NXCD, r = nwg % NXCD, xcd = wgid % NXCD, off = wgid / NXCD; wgid = (xcd < r ? xcd * (q + 1) : r * (q + 1) + (xcd - r) * q) + off; }
        const int nig = wgm * nN, gid = wgid / nig, fm = gid * wgm, gsz = (nM - fm) < wgm ? (nM - fm) : wgm;
        u.pm = fm + ((wgid % nig) % gsz); u.pn = (wgid % nig) / gsz; return true;
    }
    __device__ __forceinline__ void a_ready(const Unit&) const {}
    __device__ __forceinline__ void done(const Unit&) const {}
};

__device__ __forceinline__ unsigned cvt_pk_bf16(float lo, float hi) { unsigned r; asm volatile("v_cvt_pk_bf16_f32 %0, %1, %2" : "=v"(r) : "v"(lo), "v"(hi)); return r; }
typedef float f32x2 __attribute__((ext_vector_type(2)));
typedef unsigned u32x2 __attribute__((ext_vector_type(2)));
struct EpiQKV {
    static constexpr bool PERM = true, AFTER_DRAIN = false;
    unsigned char* ws; float* out; int L; float qscale; unsigned* kn; const float* rowss;
    __device__ __forceinline__ void operator()(const f32x4 (&acc)[2][2][4][2], const Unit& u, int wr, int wc, int fr, int fq) const {
        const int row0 = u.pm * BM + wr * 64 + fr; const int t = u.pn >> 3; const int col0 = (u.pn & 7) * BM + wc * PG8_WCS + 8 * fq;
        bf16_t* ob = (bf16_t*)(ws + QKV_WS_Q + (size_t)t * QKV_WS_STRIDE);
        float* fp = out + (t == 1 ? QKV_OUT_KP : QKV_OUT_VP) + (size_t)L * MP * D; float* fs = out + (t == 1 ? QKV_OUT_KS : QKV_OUT_VS) + (size_t)L * MS * D;
        const float sc = t == 0 ? qscale : 1.f;
#pragma unroll
        for (int ai = 0; ai < 2; ++ai)
#pragma unroll
            for (int m = 0; m < 4; ++m) { const int row = row0 + ai * HALF + m * 16;
                float* frow = nullptr; if (t != 0) { if (row < MP) { if (!(EXPAND_L1 && L == 1)) frow = fp + (size_t)row * D; } else if (row < MV) frow = fs + (size_t)(row - MP) * D; }
                bf16_t* rowp = ob + (size_t)row * D + col0;
                const float rsc = rowss ? 1.0f / sqrtf(rowss[row] * (1.0f / D) + 1e-6f) : 1.0f;
#pragma unroll
                for (int bj = 0; bj < 2; ++bj) { const f32x4 v0 = acc[ai][bj][m][0] * rsc, v1 = acc[ai][bj][m][1] * rsc;
                    u32x4 w; w.x = cvt_pk_bf16(v0[0] * sc, v0[1] * sc); w.y = cvt_pk_bf16(v0[2] * sc, v0[3] * sc); w.z = cvt_pk_bf16(v1[0] * sc, v1[1] * sc); w.w = cvt_pk_bf16(v1[2] * sc, v1[3] * sc);
                    *(u32x4*)(rowp + bj * PG8_BJS) = w;
                    if (frow) {
#if KV_STORE_POLICY == 0
                        __builtin_nontemporal_store(v0, (f32x4*)(frow + col0 + bj * PG8_BJS)); __builtin_nontemporal_store(v1, (f32x4*)(frow + col0 + bj * PG8_BJS + 4));
#elif KV_STORE_POLICY == 2
                        f32x4 a4 = v0, b4 = v1;
#pragma unroll
                        for (int e = 0; e < 4; ++e) { auto r = __builtin_amdgcn_permlane16_swap(__float_as_uint(a4[e]), __float_as_uint(b4[e]), false, false);
                            r = __builtin_amdgcn_permlane32_swap(r[0], r[1], false, false); a4[e] = __uint_as_float(r[0]); b4[e] = __uint_as_float(r[1]); }
                        __builtin_nontemporal_store(a4, (f32x4*)(frow + col0 - 4 * fq + bj * PG8_BJS)); __builtin_nontemporal_store(b4, (f32x4*)(frow + col0 - 4 * fq + 16 + bj * PG8_BJS));
#elif KV_STORE_POLICY == 3
                        f32x4 a4 = v0, b4 = v1;
#pragma unroll
                        for (int e = 0; e < 4; ++e) { auto r = __builtin_amdgcn_permlane16_swap(__float_as_uint(a4[e]), __float_as_uint(b4[e]), false, false);
                            r = __builtin_amdgcn_permlane32_swap(r[0], r[1], false, false); a4[e] = __uint_as_float(r[0]); b4[e] = __uint_as_float(r[1]); }
                        const bool odd = fr & 1; f32x4 s1, s2;
#pragma unroll
                        for (int e = 0; e < 4; ++e) { const float na = __int_as_float(__builtin_amdgcn_update_dpp(0, __float_as_int(a4[e]), 0xB1, 0xF, 0xF, true)), nb = __int_as_float(__builtin_amdgcn_update_dpp(0, __float_as_int(b4[e]), 0xB1, 0xF, 0xF, true));
                            s1[e] = odd ? nb : a4[e]; s2[e] = odd ? b4[e] : na; }
                        float* const cb = frow + col0 - 4 * fq + (odd ? 16 : 0) + bj * PG8_BJS;
                        __builtin_nontemporal_store(s1, (f32x4*)(cb - (odd ? D : 0))); __builtin_nontemporal_store(s2, (f32x4*)(cb + (odd ? 0 : D)));
#else
                        float* fa = frow + col0 + bj * PG8_BJS;
                        asm volatile("global_store_dwordx4 %0, %1, off " KV_STORE_BITS "\n\tglobal_store_dwordx4 %0, %2, off offset:16 " KV_STORE_BITS "\n\ts_nop 1" :: "v"(fa), "v"(v0), "v"(v1) : "memory");
#endif
                    } } }
        if (L == 1 && t == 1 && u.pm * BM < MP) {
#pragma unroll
            for (int bj = 0; bj < 2; ++bj) { float mx = 0.f;
#pragma unroll
                for (int ai = 0; ai < 2; ++ai)
#pragma unroll
                    for (int m = 0; m < 4; ++m) { const f32x4 v0 = acc[ai][bj][m][0], v1 = acc[ai][bj][m][1];
                        const float rq = rowss ? 1.0f / (rowss[row0 + ai * HALF + m * 16] * (1.0f / D) + 1e-6f) : 1.0f;
                        float sq = rq * ((v0[0] * v0[0] + v0[1] * v0[1]) + (v0[2] * v0[2] + v0[3] * v0[3]) + (v1[0] * v1[0] + v1[1] * v1[1]) + (v1[2] * v1[2] + v1[3] * v1[3]));
                        sq += __shfl_xor(sq, 16); sq += __shfl_xor(sq, 32); mx = fmaxf(mx, sq); }
                mx = fmaxf(mx, __shfl_xor(mx, 1)); mx = fmaxf(mx, __shfl_xor(mx, 2)); mx = fmaxf(mx, __shfl_xor(mx, 4)); mx = fmaxf(mx, __shfl_xor(mx, 8));
                const int c32 = (wc * PG8_WCS + bj * PG8_BJS) >> 5;
                if (fr == 0 && fq == 0) atomicMax(kn + (((u.pm * BM) / SEQ) * 16 + (u.pn & 7) * 2 + (c32 >> 2)) * 4 + (c32 & 3), __float_as_uint(mx)); }
        }
    }
};
struct EpiResid {
    static constexpr bool PERM = false, AFTER_DRAIN = false;
    const float* rp; const float* rs; float* out;
    __device__ __forceinline__ void operator()(const f32x4 (&acc)[2][2][4][2], const Unit& u, int wr, int wc, int fr, int fq) const {
        const int col0 = u.pn * BM + wc * PG8_WCS + 4 * fq;
#pragma unroll
        for (int ai = 0; ai < 2; ++ai)
#pragma unroll
            for (int m = 0; m < 4; ++m) { const int row = u.pm * BM + ai * HALF + wr * 64 + m * 16 + fr;
                if (row < MV) { const float* r = row < MP ? rp + (size_t)row * D : rs + (size_t)(row - MP) * D; float* o = out + (size_t)row * D;
#pragma unroll
                    for (int bj = 0; bj < 2; ++bj)
#pragma unroll
                        for (int n = 0; n < 2; ++n) { const int c = col0 + bj * PG8_BJS + n * 16; *(f32x4*)(o + c) = *(const f32x4*)(r + c) + acc[ai][bj][m][n]; } } }
    }
};
struct EpiResidB {
    static constexpr bool PERM = true, AFTER_DRAIN = false;
    bf16_t* X; float* rowss;
    __device__ __forceinline__ void operator()(const f32x4 (&acc)[2][2][4][2], const Unit& u, int wr, int wc, int fr, int fq) const {
        const int row0 = u.pm * BM + wr * 64 + fr, col0 = u.pn * BM + wc * PG8_WCS + 8 * fq;
#pragma unroll
        for (int ai = 0; ai < 2; ++ai)
#pragma unroll
            for (int m = 0; m < 4; ++m) { const int row = row0 + ai * HALF + m * 16; bf16_t* xr = X + (size_t)row * D + col0; float sq = 0.f;
#pragma unroll
                for (int bj = 0; bj < 2; ++bj) { const u32x4 r = *(const u32x4*)(xr + bj * PG8_BJS); f32x4 x0 = acc[ai][bj][m][0], x1 = acc[ai][bj][m][1];
                    x0[0] += __uint_as_float(r.x << 16); x0[1] += __uint_as_float(r.x & 0xffff0000u); x0[2] += __uint_as_float(r.y << 16); x0[3] += __uint_as_float(r.y & 0xffff0000u);
                    x1[0] += __uint_as_float(r.z << 16); x1[1] += __uint_as_float(r.z & 0xffff0000u); x1[2] += __uint_as_float(r.w << 16); x1[3] += __uint_as_float(r.w & 0xffff0000u);
                    sq += (x0[0] * x0[0] + x0[1] * x0[1]) + (x0[2] * x0[2] + x0[3] * x0[3]) + (x1[0] * x1[0] + x1[1] * x1[1]) + (x1[2] * x1[2] + x1[3] * x1[3]);
                    u32x4 w; w.x = cvt_pk_bf16(x0[0], x0[1]); w.y = cvt_pk_bf16(x0[2], x0[3]); w.z = cvt_pk_bf16(x1[0], x1[1]); w.w = cvt_pk_bf16(x1[2], x1[3]);
                    *(u32x4*)(xr + bj * PG8_BJS) = w; }
                sq += __shfl_xor(sq, 16); sq += __shfl_xor(sq, 32);
                if (fq == 0) atomicAdd(rowss + row, sq); }
    }
};
struct EpiRelu2 {
    static constexpr bool PERM = true, AFTER_DRAIN = false;
    bf16_t* O; int ldc; bool nostore; const float* rowss;
    __device__ __forceinline__ void operator()(const f32x4 (&acc)[2][2][4][2], const Unit& u, int wr, int wc, int fr, int fq) const {
        const int row0 = u.pm * BM + wr * 64 + fr, col0 = u.pn * BM + wc * PG8_WCS + 8 * fq;
#pragma unroll
        for (int ai = 0; ai < 2; ++ai)
#pragma unroll
            for (int m = 0; m < 4; ++m) { bf16_t* rowp = O + (size_t)(row0 + ai * HALF + m * 16) * ldc + col0;
                const float rsc = rowss ? 1.0f / sqrtf(rowss[row0 + ai * HALF + m * 16] * (1.0f / D) + 1e-6f) : 1.0f;
                u32x4 w[2];
#pragma unroll
                for (int bj = 0; bj < 2; ++bj) { f32x4 v0 = acc[ai][bj][m][0], v1 = acc[ai][bj][m][1];
#pragma unroll
                    for (int e = 0; e < 4; ++e) { const float a = fmaxf(v0[e] * rsc, 0.f), b = fmaxf(v1[e] * rsc, 0.f); v0[e] = a * a; v1[e] = b * b; }
                    w[bj].x = cvt_pk_bf16(v0[0], v0[1]); w[bj].y = cvt_pk_bf16(v0[2], v0[3]); w[bj].z = cvt_pk_bf16(v1[0], v1[1]); w[bj].w = cvt_pk_bf16(v1[2], v1[3]); }
                const bool odd = fr & 1; u32x4 s1, s2;
#pragma unroll
                for (int e = 0; e < 4; ++e) { const unsigned n0 = (unsigned)__builtin_amdgcn_update_dpp(0, (int)w[0][e], 0xB1, 0xF, 0xF, true), n1 = (unsigned)__builtin_amdgcn_update_dpp(0, (int)w[1][e], 0xB1, 0xF, 0xF, true);
                    s1[e] = odd ? n1 : w[0][e]; s2[e] = odd ? w[1][e] : n0; }
                if (!nostore) { bf16_t* const pb = rowp + (odd ? PG8_BJS : 0);
                    __builtin_nontemporal_store(s1, (u32x4*)(pb - (odd ? ldc : 0))); __builtin_nontemporal_store(s2, (u32x4*)(pb + (odd ? 0 : ldc))); } }
    }
};
template <class Epi, class Sched, bool ALIGN_EPI = false, bool SP2 = false>
__device__ __forceinline__ void gemm_phase(PG8_LAS unsigned char* lds, const Gemm g, const Sched& S, const Epi& E, int wid_in, int lane_in) {
    const int wid = wid_in, lane = lane_in, tid = wid_in * 64 + lane_in,     wr = wid >> 2, wc = wid & 3, fr = lane & 15, fq = lane >> 4;
    const int K = g.K, nt = K / BK;
    unsigned voffA[2], voffB[2];
#pragma unroll
    for (int i = 0; i < 2; ++i) { int R, C; stage_rc(tid * 16 + i * 8192, R, C); const int Rb = Epi::PERM ? ((R & ~31) + perm32(R & 31)) : R;
        voffA[i] = (unsigned)(R * K + C) * 2u; const int Rn = PG8_NREMAP ? 64 * (R >> 5) + (Rb & 31) : Rb;
        voffB[i] = (unsigned)(Rn * K + C) * 2u; }
    const size_t kstep = (size_t)(BK * 2);
    const size_t hstep = (size_t)HALF * K * 2;
    const size_t tstep = 2 * hstep;
    const size_t hstepB = PG8_NREMAP ? (size_t)32 * K * 2 : hstep;
    const unsigned ldsw = (unsigned)wid * 1024u;
    const int aoff = lds_byte(wr * 64 + fr, fq * 8), boff = lds_byte(wc * 32 + fr, fq * 8);
#define PG8_SA(b, h) (((b) * 2 + (h)) * HTB)
#define PG8_SB(b, h) ((4 + (b) * 2 + (h)) * HTB)
#define PG8_STAGE(bufoff, gbase, voff) do { _Pragma("unroll") for (int _i = 0; _i < 2; ++_i) \
        __builtin_amdgcn_global_load_lds((const unsigned*)((const char*)(gbase) + (voff)[_i]), (PG8_LAS unsigned*)(lds + (bufoff) + ldsw + _i * 8192), 16, 0, 0); } while (0)
#define PG8_LDA(dst, b, h) do { _Pragma("unroll") for (int m = 0; m < 4; ++m) _Pragma("unroll") for (int k = 0; k < 2; ++k) dst[m][k] = *(const PG8_LAS bf16x8*)(lds + PG8_SA(b, h) + aoff + m * 2048 + k * 1024); } while (0)
#define PG8_LDB(dst, b, h) do { _Pragma("unroll") for (int n = 0; n < 2; ++n) _Pragma("unroll") for (int k = 0; k < 2; ++k) dst[n][k] = *(const PG8_LAS bf16x8*)(lds + PG8_SB(b, h) + boff + n * 2048 + k * 1024); } while (0)
#define PG8_MMA(ai, bj, At, Bt) do { __builtin_amdgcn_s_setprio(1); _Pragma("unroll") for (int m = 0; m < 4; ++m) _Pragma("unroll") for (int n = 0; n < 2; ++n) _Pragma("unroll") for (int k = 0; k < 2; ++k) \
        acc[ai][bj][m][n] = __builtin_amdgcn_mfma_f32_16x16x32_bf16(Bt[n][k], At[m][k], acc[ai][bj][m][n], 0, 0, 0); __builtin_amdgcn_s_setprio(0); } while (0)
#define PG8_WAIT_V(n) asm volatile("s_waitcnt vmcnt(" #n ")" ::: "memory")
#define PG8_WAIT_L(n) asm volatile("s_waitcnt lgkmcnt(" #n ")" ::: "memory")
#define PG8_BAR __builtin_amdgcn_s_barrier()
#define PG8_SCHED __builtin_amdgcn_sched_barrier(0)
    Unit cur, nxt; int ui = 0;
    if (!S.next(0, cur)) return;
    f32x4 acc[2][2][4][2];
#pragma unroll
    for (int a = 0; a < 2; ++a)
#pragma unroll
        for (int b = 0; b < 2; ++b)
#pragma unroll
            for (int m = 0; m < 4; ++m)
#pragma unroll
                for (int n = 0; n < 2; ++n) acc[a][b][m][n] = (f32x4){0.f, 0.f, 0.f, 0.f};
    bf16x8 At[4][2], B0[2][2], B1[2][2];
    const char* cA = (const char*)g.A + (size_t)cur.pm * tstep; const char* cB = (const char*)g.Bt + (size_t)cur.pn * tstep;
    S.a_ready(cur);
    if constexpr (SP2) {
        PG8_STAGE(PG8_SB(0, 0), cB, voffB); PG8_STAGE(PG8_SB(0, 1), cB + hstepB, voffB); PG8_STAGE(PG8_SA(0, 0), cA, voffA); PG8_STAGE(PG8_SA(0, 1), cA + hstep, voffA);
        if (wr == 1) PG8_BAR;
        PG8_WAIT_V(2); PG8_BAR;
        PG8_STAGE(PG8_SB(1, 0), cB + kstep, voffB); PG8_STAGE(PG8_SA(1, 0), cA + kstep, voffA); PG8_STAGE(PG8_SB(1, 1), cB + hstepB + kstep, voffB);
        PG8_WAIT_V(6); PG8_BAR;
    } else {
        PG8_STAGE(PG8_SB(0, 0), cB, voffB); PG8_STAGE(PG8_SA(0, 0), cA, voffA); PG8_STAGE(PG8_SB(0, 1), cB + hstepB, voffB); PG8_STAGE(PG8_SA(0, 1), cA + hstep, voffA);
        if (wr == 1) PG8_BAR;
        PG8_WAIT_V(4); PG8_BAR;
        PG8_STAGE(PG8_SB(1, 0), cB + kstep, voffB); PG8_STAGE(PG8_SA(1, 0), cA + kstep, voffA); PG8_STAGE(PG8_SB(1, 1), cB + hstepB + kstep, voffB);
        PG8_WAIT_V(6); PG8_BAR;
    }
    for (;;) {
        const bool has_next = S.next(ui + 1, nxt);
        const char* nA = has_next ? (const char*)g.A + (size_t)nxt.pm * tstep : cA; const char* nB = has_next ? (const char*)g.Bt + (size_t)nxt.pn * tstep : cB;
        for (int t = 0; t < nt; t += 2) {
            const bool last = (t == nt - 2);
            const char* a1 = cA + (size_t)(t + 1) * kstep;
            const char* a2 = last ? nA : cA + (size_t)(t + 2) * kstep; const char* b2 = last ? nB : cB + (size_t)(t + 2) * kstep;
            const char* a3 = a2 + kstep; const char* b3 = b2 + kstep;
            if (last && has_next) S.a_ready(nxt);
            if constexpr (SP2) {
            PG8_LDB(B0, 0, 0); PG8_LDB(B1, 0, 1); PG8_SCHED; PG8_LDA(At, 0, 0); PG8_STAGE(PG8_SA(1, 1), a1 + hstep, voffA);
            PG8_WAIT_V(8); PG8_WAIT_L(0); PG8_BAR; PG8_MMA(0, 0, At, B0); PG8_MMA(0, 1, At, B1); PG8_BAR; PG8_SCHED;
            PG8_LDA(At, 0, 1); PG8_STAGE(PG8_SB(0, 0), b2, voffB); PG8_STAGE(PG8_SB(0, 1), b2 + hstepB, voffB); PG8_STAGE(PG8_SA(0, 0), a2, voffA);
            PG8_WAIT_V(8); PG8_WAIT_L(0); PG8_BAR; PG8_MMA(1, 0, At, B0); PG8_MMA(1, 1, At, B1); PG8_BAR; PG8_SCHED;
            PG8_LDB(B0, 1, 0); PG8_LDB(B1, 1, 1); PG8_SCHED; PG8_LDA(At, 1, 0); PG8_STAGE(PG8_SA(0, 1), a2 + hstep, voffA);
            PG8_WAIT_V(8); PG8_WAIT_L(0); PG8_BAR; PG8_MMA(0, 0, At, B0); PG8_MMA(0, 1, At, B1); PG8_BAR; PG8_SCHED;
            PG8_LDA(At, 1, 1); PG8_STAGE(PG8_SB(1, 0), b3, voffB); PG8_STAGE(PG8_SB(1, 1), b3 + hstepB, voffB); PG8_STAGE(PG8_SA(1, 0), a3, voffA);
            PG8_WAIT_V(8); PG8_WAIT_L(0); PG8_BAR; PG8_MMA(1, 0, At, B0); PG8_MMA(1, 1, At, B1); PG8_BAR; PG8_SCHED;
            } else {
            PG8_LDB(B0, 0, 0); PG8_SCHED; PG8_LDA(At, 0, 0); PG8_STAGE(PG8_SA(1, 1), a1 + hstep, voffA);
            PG8_WAIT_L(8); PG8_BAR; PG8_WAIT_L(0); PG8_MMA(0, 0, At, B0); PG8_BAR; PG8_SCHED;
            PG8_LDB(B1, 0, 1); PG8_STAGE(PG8_SB(0, 0), b2, voffB);
            PG8_BAR; PG8_WAIT_L(0); PG8_MMA(0, 1, At, B1); PG8_BAR;
            PG8_LDA(At, 0, 1); PG8_STAGE(PG8_SA(0, 0), a2, voffA);
            PG8_BAR; PG8_WAIT_L(0); PG8_MMA(1, 0, At, B0); PG8_BAR; PG8_SCHED;
            PG8_STAGE(PG8_SB(0, 1), b2 + hstepB, voffB);
            PG8_WAIT_V(6); PG8_BAR; PG8_MMA(1, 1, At, B1); PG8_BAR;
            PG8_LDB(B0, 1, 0); PG8_SCHED; PG8_LDA(At, 1, 0); PG8_STAGE(PG8_SA(0, 1), a2 + hstep, voffA);
            PG8_WAIT_L(8); PG8_BAR; PG8_WAIT_L(0); PG8_MMA(0, 0, At, B0); PG8_BAR; PG8_SCHED;
            PG8_LDB(B1, 1, 1); PG8_STAGE(PG8_SB(1, 0), b3, voffB);
            PG8_BAR; PG8_WAIT_L(0); PG8_MMA(0, 1, At, B1); PG8_BAR;
            PG8_LDA(At, 1, 1); PG8_STAGE(PG8_SA(1, 0), a3, voffA);
            PG8_BAR; PG8_WAIT_L(0); PG8_MMA(1, 0, At, B0); PG8_BAR; PG8_SCHED;
            PG8_STAGE(PG8_SB(1, 1), b3 + hstepB, voffB);
            PG8_WAIT_V(6); PG8_BAR; PG8_MMA(1, 1, At, B1); PG8_BAR;
            }
        }
        if constexpr (ALIGN_EPI) { if (wr == 0) PG8_BAR; }
        if constexpr (!Epi::AFTER_DRAIN) { E(acc, cur, wr, wc, fr, fq); S.done(cur); }
        if (!has_next) break;
#pragma unroll
        for (int a = 0; a < 2; ++a)
#pragma unroll
            for (int b = 0; b < 2; ++b)
#pragma unroll
                for (int m = 0; m < 4; ++m)
#pragma unroll
                    for (int n = 0; n < 2; ++n) acc[a][b][m][n] = (f32x4){0.f, 0.f, 0.f, 0.f};
        cur = nxt; cA = nA; cB = nB; ++ui;
        if constexpr (ALIGN_EPI) { if (wr == 1) PG8_BAR; }
    }
    PG8_WAIT_V(0);
    if constexpr (!ALIGN_EPI) { if (wr == 0) PG8_BAR; }
    PG8_BAR;
    if constexpr (Epi::AFTER_DRAIN) { E.fused(acc, cur, wr, wc, fr, fq, lds, wid, lane); S.done(cur); }
#undef PG8_SA
#undef PG8_SB
#undef PG8_STAGE
#undef PG8_LDA
#undef PG8_LDB
#undef PG8_MMA
#undef PG8_WAIT_V
#undef PG8_WAIT_L
#undef PG8_BAR
#undef PG8_SCHED
}
}
#ifndef PG8_SP2
#define PG8_SP2 true
#endif
#ifndef PG8_ALIGN
#define PG8_ALIGN true
#endif
constexpr int NWAVES = 8;
#ifndef MK_N_LAUNCHES
#define MK_N_LAUNCHES 1
#endif
constexpr int N_PHASES = 15;
constexpr bool ONE_LAUNCH = (MK_N_LAUNCHES == 1);

constexpr size_t MiB = 1u << 20;
constexpr size_t WS_CTL = 0, CTL_ZERO_BYTES = 1 * MiB;
constexpr size_t WS_W = 2 * MiB;
constexpr size_t W_LAYER = 96 * MiB, W_QKV = 0, W_O = 24 * MiB, W_UP = 32 * MiB, W_DN = 64 * MiB;
constexpr size_t WS_XN = 194 * MiB;
constexpr size_t WS_CK = 323 * MiB, WS_CV = 387 * MiB;
constexpr size_t WS_Q = 451 * MiB, WS_K = 580 * MiB, WS_V = 709 * MiB;
constexpr size_t WS_H = WS_Q;
constexpr size_t WS_CK1 = 967 * MiB, WS_CV1 = 1031 * MiB;
constexpr size_t WS_END = 1095 * MiB;
static_assert(WS_H + (size_t)M * FF * 2 <= WS_CK1 && WS_V + (size_t)M * D * 2 <= WS_END && WS_XN + (size_t)M * D * 2 <= WS_CK && WS_W + 2 * W_LAYER <= WS_XN, "d_ws map");
static_assert(QKV_WS_Q == WS_Q && WS_K == WS_Q + QKV_WS_STRIDE && WS_V == WS_Q + 2 * QKV_WS_STRIDE, "QKV epilogue map");
constexpr int CW_TMO = 0;
constexpr int CW_KN = 1024;
constexpr int CW_QH = 2048;
constexpr int CW_RSS = 65536;
constexpr int CW_BAR = 4096;
static_assert((size_t)(CW_RSS + 5 * MV) * 4 <= CTL_ZERO_BYTES, "CTL map");

constexpr size_t OUT_Y = 0, OUT_KP = (size_t)MV * D, OUT_VP = OUT_KP + 2 * (size_t)MP * D, OUT_KS = OUT_VP + 2 * (size_t)MP * D, OUT_VS = OUT_KS + 2 * (size_t)MS * D, OUT_END = OUT_VS + 2 * (size_t)MS * D;
static_assert(OUT_KP == QKV_OUT_KP && OUT_VP == QKV_OUT_VP && OUT_KS == QKV_OUT_KS && OUT_VS == QKV_OUT_VS, "QKV epilogue map");

constexpr int RING_OFF = 0, RING_BYTES = 131072;
constexpr int LDS_BYTES = 163840;
constexpr int LDSCTL_OFF = LDS_BYTES - 512;
static_assert(RING_BYTES <= LDSCTL_OFF, "LDS map");

#define GAS __attribute__((address_space(1)))
#define LAS __attribute__((address_space(3)))
typedef unsigned short bf16;
typedef unsigned v4u __attribute__((ext_vector_type(4)));
typedef unsigned v2u __attribute__((ext_vector_type(2)));
typedef float f32x4 __attribute__((ext_vector_type(4)));
typedef GAS unsigned gu32;
#define RLX_AGENT __ATOMIC_RELAXED, __HIP_MEMORY_SCOPE_AGENT
#define LDS_WAIT() asm volatile("s_waitcnt lgkmcnt(0)" ::: "memory")
#define VM_WAIT() asm volatile("s_waitcnt vmcnt(0)" ::: "memory")
typedef float f32x2_t __attribute__((ext_vector_type(2))); typedef __bf16 bf16x2_t __attribute__((ext_vector_type(2)));
__device__ __forceinline__ unsigned pk2(float lo, float hi) { f32x2_t v = {lo, hi}; bf16x2_t b = __builtin_convertvector(v, bf16x2_t); return __builtin_bit_cast(unsigned, b); }
__device__ __forceinline__ float wave_sum(float v) {
#pragma unroll
    for (int o = 1; o < 64; o <<= 1) v += __shfl_xor(v, o);
    return v;
}
#define XB_TMO      128
#define XB_XCNT(j)  (256  + 64 * (j))
#define XB_XSUB(j)  (1280 + 64 * (j))
#define XB_XGEN(j)  (2304 + 64 * (j))
#define XB_TOP      3328
#define XB_TOPGEN   3392
#define XCD_BAR_WORDS 3456
#define XB_SPIN_CAP (1u << 18)

__device__ __forceinline__ unsigned xb_ld(unsigned* p)              { return __hip_atomic_load(p, __ATOMIC_RELAXED, __HIP_MEMORY_SCOPE_AGENT); }
__device__ __forceinline__ unsigned xb_add(unsigned* p, unsigned v) { return __hip_atomic_fetch_add(p, v, __ATOMIC_RELAXED, __HIP_MEMORY_SCOPE_AGENT); }
__device__ __forceinline__ unsigned xb_xcc_id() { return (unsigned)__builtin_amdgcn_s_getreg((3 << 11) | 20) & 0xFu; }
#define XB_SPIN(cond, bar) do { unsigned _sp = 0; while (cond) { __builtin_amdgcn_s_sleep(1); \
    if ((++_sp & 255u) == 0u) { if (xb_ld(&(bar)[XB_TMO])) break; if (_sp > XB_SPIN_CAP) { atomicAdd(&(bar)[XB_TMO], 1u); break; } } } } while (0)

struct XcdBarrier {
    unsigned* bar; unsigned x; int wave;
    volatile LAS unsigned* st;
};

__device__ __forceinline__ bool xb_thread0(int wave) { return wave == 0 && __builtin_amdgcn_mbcnt_hi(~0u, __builtin_amdgcn_mbcnt_lo(~0u, 0u)) == 0u; }
__device__ __forceinline__ XcdBarrier xcd_barrier_post(unsigned* bar, volatile LAS unsigned* st, int wave) {
    XcdBarrier b; b.bar = bar; b.x = xb_xcc_id(); b.st = st; b.wave = wave;
    if (xb_thread0(wave)) (void)xb_add(&bar[XB_XCNT(b.x)], 1u);
    return b;
}
__device__ __forceinline__ void xcd_barrier_complete(unsigned* bar, unsigned x, unsigned& nloc, unsigned& nx) {
    const unsigned G = gridDim.x * gridDim.y * gridDim.z;
    unsigned sum, cnt, mine, sp = 0u;
    for (;;) {
        sum = 0u; cnt = 0u; mine = 0u;
#pragma unroll
        for (unsigned j = 0; j < 16; ++j) { const unsigned c = xb_ld(&bar[XB_XCNT(j)]); sum += c; cnt += (c > 0u) ? 1u : 0u; mine = (j == x) ? c : mine; }
        if (sum == G) break;
        __builtin_amdgcn_s_sleep(1);
        if ((++sp & 255u) == 0u) { if (xb_ld(&bar[XB_TMO])) break; if (sp > XB_SPIN_CAP) { atomicAdd(&bar[XB_TMO], 1u); break; } }
    }
    nloc = mine > 0u ? mine : 1u; nx = cnt > 0u ? cnt : 1u;
}

__device__ __forceinline__ void xcd_barrier(const XcdBarrier& b) {
    asm volatile("s_waitcnt vmcnt(0)" ::: "memory");
    __syncthreads();
    if (xb_thread0(b.wave)) {
        unsigned* bar = b.bar;
        __builtin_amdgcn_s_waitcnt(0);
        unsigned nloc = b.st[0], nx = b.st[1];
        if (nloc == 0u) { xcd_barrier_complete(bar, b.x, nloc, nx); b.st[0] = nloc; b.st[1] = nx; }
        const unsigned old = xb_add(&bar[XB_XSUB(b.x)], 1u);
        const unsigned gen = old / nloc;
        if (old + 1u == (gen + 1u) * nloc) {
            __builtin_amdgcn_fence(__ATOMIC_RELEASE, "agent");
            asm volatile("s_waitcnt vmcnt(0)" ::: "memory");
            const unsigned og = xb_add(&bar[XB_TOP], 1u);
            const unsigned tg = og / nx;
            if (og + 1u == (tg + 1u) * nx) xb_add(&bar[XB_TOPGEN], 1u);
            else XB_SPIN(xb_ld(&bar[XB_TOPGEN]) == tg, bar);
            __builtin_amdgcn_fence(__ATOMIC_ACQUIRE, "agent");
            xb_add(&bar[XB_XGEN(b.x)], 1u);
            asm volatile("s_waitcnt vmcnt(0)" ::: "memory");
        } else {
            XB_SPIN(xb_ld(&bar[XB_XGEN(b.x)]) == gen, bar);
            __builtin_amdgcn_fence(__ATOMIC_ACQUIRE, "agent");
            asm volatile("s_waitcnt vmcnt(0)" ::: "memory");
        }
    }
    __syncthreads();
}
namespace att {
typedef short bf16x8 __attribute__((ext_vector_type(8)));
typedef short s16x4 __attribute__((ext_vector_type(4)));
typedef short v4i16_t __attribute__((ext_vector_type(4)));
typedef float f32x16 __attribute__((ext_vector_type(16)));
typedef LAS unsigned char* lptr;
constexpr float LOG2E = 1.4426950408889634f;
constexpr float QSCALE = 0.08838834764831845f * 1.4426950408889634f;
constexpr float GSCALE = 1.0f - 0.35550906759096926f;
constexpr float DF_THR = 0.0f;
#ifndef SB_EAGER_TILES
#define SB_EAGER_TILES 8
#endif
constexpr int SB_EAGER_LO = 32 - SB_EAGER_TILES;
constexpr float SB_DONE = -150.0f;

__device__ __forceinline__ s16x4 vtr(const LAS unsigned char* p) { return __builtin_bit_cast(s16x4, __builtin_amdgcn_ds_read_tr16_b64_v4i16((LAS v4i16_t*)p)); }
__device__ __forceinline__ float swap_lo(float x, float& other_hi) { auto rr = __builtin_amdgcn_permlane32_swap(__float_as_uint(x), __float_as_uint(x), false, false); other_hi = __uint_as_float(rr[1]); return __uint_as_float(rr[0]); }

template <int KW, int VW, int TK> struct KVStage {
    static constexpr int KBYTES = TK * KW * 2, VBYTES = TK * VW * 2, BUF = KBYTES + VBYTES, NK = KBYTES / 8192, NV = VBYTES / 8192, VDB = TK * 64  ;
    unsigned voffK[NK], voffV[NV];
    __device__ __forceinline__ void init(int wid, int lane) {
#pragma unroll
        for (int j = 0; j < NK; ++j) { const int pos = (wid * NK + j) * 64 + lane; int row, c16;
            if (KW == 128) { row = pos >> 4; c16 = (pos & 15) ^ (row & 15); } else { row = pos >> 5; c16 = ((pos >> 4) & 1) * 16 + ((pos & 15) ^ (row & 15)); }
            voffK[j] = (unsigned)(row * D + c16 * 8) * 2u; }
#pragma unroll
        for (int j = 0; j < NV; ++j) { const int pos = (wid * NV + j) * 64 + lane; const int dblk = pos / (TK * 4), row = (pos >> 2) % TK, sub = pos & 3;
            voffV[j] = (unsigned)(row * D + (dblk * 4 + sub) * 8) * 2u; }
    }
    __device__ static __forceinline__ void glds16(const void* gsrc, unsigned lds_dst) { unsigned keep;
        asm volatile("s_mov_b32 %0, m0\n\ts_mov_b32 m0, %2\n\ts_nop 0\n\tglobal_load_lds_dwordx4 %1, off\n\ts_mov_b32 m0, %0" : "=&s"(keep) : "v"(gsrc), "s"(lds_dst) : "memory"); }
    __device__ __forceinline__ void issue2(lptr kbuf, lptr vbuf, const bf16* kp, const bf16* vp, int wid) const {
        const unsigned kd = (unsigned)(uintptr_t)kbuf, vd = (unsigned)(uintptr_t)vbuf;
#pragma unroll
        for (int j = 0; j < NK; ++j) glds16((const char*)kp + voffK[j], (unsigned)__builtin_amdgcn_readfirstlane((int)(kd + (wid * NK + j) * 1024)));
#pragma unroll
        for (int j = 0; j < NV; ++j) glds16((const char*)vp + voffV[j], (unsigned)__builtin_amdgcn_readfirstlane((int)(vd + (wid * NV + j) * 1024)));
    }
    __device__ __forceinline__ void issue(lptr buf, const bf16* kp, const bf16* vp, int wid) const { issue2(buf, buf + KBYTES, kp, vp, wid); }
};

template <int KPITCH> __device__ __forceinline__ void qkt1(f32x16& p, const LAS unsigned char* Kb, int mp, const bf16x8* qr, int r32, int hi) {
    const int xk = (r32 & 15) << 4; const LAS unsigned char* k0 = Kb + r32 * KPITCH + mp * 256;
#pragma unroll
    for (int ks = 0; ks < 8; ++ks) { const int cb = (ks * 32 + hi * 16) ^ xk;
        const bf16x8 a0 = *(const LAS bf16x8*)(k0 + cb);
        p = __builtin_amdgcn_mfma_f32_32x32x16_bf16(a0, qr[ks], p, 0, 0, 0); }
}
template <int NDB, int NS, int VDB> __device__ __forceinline__ void pv(f32x16* o, const LAS unsigned char* Vb, int lane, const bf16x8* pf) {
    const LAS unsigned char* vb = Vb + (4 * (lane >> 5) + ((lane & 15) >> 2)) * 64 + ((lane >> 4) & 1) * 32 + (lane & 3) * 8;
    constexpr int N = NDB * NS, AH = 2;
    s16x4 lo[AH + 1], hi4[AH + 1];
#pragma unroll
    for (int k = 0; k < AH && k < N; ++k) { lo[k] = vtr(vb + (k / NS) * VDB + (k % NS) * 1024); hi4[k] = vtr(vb + (k / NS) * VDB + (k % NS) * 1024 + 512); }
    __builtin_amdgcn_s_setprio(1);
#pragma unroll
    for (int k = 0; k < N; ++k) { const int db = k / NS, s = k % NS;
        if (k + AH < N) { const int db1 = (k + AH) / NS, s1 = (k + AH) % NS; lo[(k + AH) % (AH + 1)] = vtr(vb + db1 * VDB + s1 * 1024); hi4[(k + AH) % (AH + 1)] = vtr(vb + db1 * VDB + s1 * 1024 + 512); }
        const s16x4 l_ = lo[k % (AH + 1)], h_ = hi4[k % (AH + 1)];
        const bf16x8 vf = (bf16x8){l_[0], l_[1], l_[2], l_[3], h_[0], h_[1], h_[2], h_[3]};
        o[db] = __builtin_amdgcn_mfma_f32_32x32x16_bf16(vf, pf[s], o[db], 0, 0, 0); }
    __builtin_amdgcn_s_setprio(0);
    __builtin_amdgcn_sched_group_barrier(0x100, 2 * AH, 0);
#pragma unroll
    for (int k = 0; k < N; ++k) { if (k + AH < N) __builtin_amdgcn_sched_group_barrier(0x100, 2, 0); __builtin_amdgcn_sched_group_barrier(0x8, 1, 0); }
}
__device__ __forceinline__ void pack_p(bf16x8* pf, const f32x16& p) {
#pragma unroll
    for (int s = 0; s < 2; ++s) { v4u a;
        a.x = pk2(p[8 * s + 0], p[8 * s + 1]); a.y = pk2(p[8 * s + 2], p[8 * s + 3]); a.z = pk2(p[8 * s + 4], p[8 * s + 5]); a.w = pk2(p[8 * s + 6], p[8 * s + 7]);
        pf[s] = __builtin_bit_cast(bf16x8, a); }
}

template <bool SAMPLE>
__device__ __forceinline__ void sb_unit(lptr ring, volatile LAS int* flags, const bf16* Qb, const bf16* Kb, const bf16* Vb, bf16* CK, bf16* CV, const float* ck32, const float* cv32, bf16* Ob,
                                        int b, int h, int qb, int wid, int lane) {
    KVStage<128, 128, 64> st; st.init(wid, lane);
    constexpr int BUF = KVStage<128, 128, 64>::BUF, KBYTES = KVStage<128, 128, 64>::KBYTES;
    const int r32 = lane & 31, hi = lane >> 5;
    const int qbase = SAMPLE ? PAST : 256 * qb + 32 * wid;
    const int qpos = qbase + r32;
    const size_t qrow = SAMPLE ? (size_t)(MP + 16 * b + r32) : (size_t)b * SEQ + qpos;
    const bool live = SAMPLE ? (wid == 0) : true;
    const bool rvalid = SAMPLE ? (wid == 0 && r32 < 16) : true;
    const int jt_hi = SAMPLE ? 32 : 4 * qb + 3;
    const int coff = h * 128;
    bf16x8 qr[8];
#pragma unroll
    for (int ks = 0; ks < 8; ++ks) qr[ks] = *(const bf16x8*)(Qb + qrow * D + coff + ks * 16 + hi * 8);
    f32x16 o[4];
#pragma unroll
    for (int i = 0; i < 4; ++i) o[i] = f32x16{};
    float C = 0.f;
#define SB_TILE_PTRS(jt_, kp_, vp_) do { size_t off_; \
        if (!SAMPLE) { off_ = ((size_t)b * SEQ + 64 * (size_t)(jt_)) * D + coff; kp_ = Kb + off_; vp_ = Vb + off_; } \
        else if ((jt_) == 32) { off_ = (size_t)(MP + 16 * b) * D + coff; kp_ = Kb + off_; vp_ = Vb + off_; } \
        else { off_ = ((size_t)b * PAST + 64 * (size_t)(jt_)) * D + coff; kp_ = CK + off_; vp_ = CV + off_; } } while (0)
    int jt = jt_hi, it = 0;
    { const bf16 *kp, *vp; SB_TILE_PTRS(jt, kp, vp); st.issue(ring, kp, vp, wid); }
    VM_WAIT(); __syncthreads();
    bool wdone = !live;
    for (;;) {
        const lptr cur = ring + (it & 1) * BUF, nxt = ring + ((it & 1) ^ 1) * BUF;
        const bool has_next = jt > 0;
        if (SAMPLE && has_next && jt - 1 < SB_EAGER_LO) {
            const int tid_ = wid * 64 + lane, row_ = tid_ >> 3, c0_ = (tid_ & 7) * 16; const size_t o_ = ((size_t)b * PAST + 64 * (size_t)(jt - 1) + row_) * D + coff + c0_;
#pragma unroll
            for (int t_ = 0; t_ < 2; ++t_) { const float* s_ = (t_ ? cv32 : ck32) + o_; bf16* d_ = (t_ ? CV : CK) + o_;
                const f32x4 x0 = ((const f32x4*)s_)[0], x1 = ((const f32x4*)s_)[1], x2 = ((const f32x4*)s_)[2], x3 = ((const f32x4*)s_)[3];
                v4u w0, w1; w0.x = pk2(x0.x, x0.y); w0.y = pk2(x0.z, x0.w); w0.z = pk2(x1.x, x1.y); w0.w = pk2(x1.z, x1.w); w1.x = pk2(x2.x, x2.y); w1.y = pk2(x2.z, x2.w); w1.z = pk2(x3.x, x3.y); w1.w = pk2(x3.z, x3.w);
                ((v4u*)d_)[0] = w0; ((v4u*)d_)[1] = w1; }
            VM_WAIT(); __syncthreads(); }
        if (has_next) { const bf16 *kp, *vp; SB_TILE_PTRS(jt - 1, kp, vp); st.issue(nxt, kp, vp, wid); }
        const int kmin = 64 * jt;
        if (!wdone && kmin < qbase + 31) {
            f32x16 p0 = f32x16{}, p1 = f32x16{};
            qkt1<256>(p0, cur, 0, qr, r32, hi); qkt1<256>(p1, cur + 32 * 256, 0, qr, r32, hi);
            f32x16 L0, L1;
#pragma unroll
            for (int r = 0; r < 16; ++r) {
                const float z0 = p0[r], z1 = p1[r];
                L0[r] = -(fmaxf(z0, 0.f) + __builtin_amdgcn_logf(1.0f + __builtin_amdgcn_exp2f(-fabsf(z0))));
                L1[r] = -(fmaxf(z1, 0.f) + __builtin_amdgcn_logf(1.0f + __builtin_amdgcn_exp2f(-fabsf(z1)))); }
            const bool need_mask = (kmin + 63 >= qbase);
            if (need_mask) {
                const float df = (float)(qpos - kmin - 4 * hi);
#pragma unroll
                for (int r = 0; r < 16; ++r) { const float c = (float)((r & 3) + 8 * (r >> 2));
                    const float f0 = __builtin_amdgcn_fmed3f(df - c, 0.f, 1.f), f1 = __builtin_amdgcn_fmed3f(df - (c + 32.f), 0.f, 1.f);
                    L0[r] *= f0; p0[r] += f0 * 1e30f - 1e30f; L1[r] *= f1; p1[r] += f1 * 1e30f - 1e30f; } }
            float T[8];
#pragma unroll
            for (int g = 0; g < 4; ++g) {
                L0[4 * g + 2] += L0[4 * g + 3]; L0[4 * g + 1] += L0[4 * g + 2]; L0[4 * g] += L0[4 * g + 1]; T[g] = L0[4 * g];
                L1[4 * g + 2] += L1[4 * g + 3]; L1[4 * g + 1] += L1[4 * g + 2]; L1[4 * g] += L1[4 * g + 1]; T[4 + g] = L1[4 * g]; }
            float off[8]; float run = 0.f;
#pragma unroll
            for (int g = 7; g >= 0; --g) { float t1; const float t0 = swap_lo(T[g], t1); off[g] = C + run + (hi == 0 ? t1 : 0.f); run += t0 + t1; }
#pragma unroll
            for (int g = 0; g < 4; ++g)
#pragma unroll
                for (int i = 0; i < 4; ++i) { const int r = 4 * g + i;
                    p0[r] = __builtin_amdgcn_exp2f(p0[r] + L0[r] + off[g]);
                    p1[r] = __builtin_amdgcn_exp2f(p1[r] + L1[r] + off[4 + g]); }
            C += run;
            bf16x8 pf[4]; pack_p(pf, p0); pack_p(pf + 2, p1);
            pv<4, 4, 4096>(o, cur + KBYTES, lane, pf);
            wdone = __all((!rvalid) || (C < SB_DONE));
        }
        if (lane == 0) flags[(it & 1) * 8 + wid] = wdone ? 1 : 0;
        VM_WAIT(); LDS_WAIT(); __syncthreads();
        if (!has_next) break;
        int all = 1;
#pragma unroll
        for (int w = 0; w < 8; ++w) all &= flags[(it & 1) * 8 + w];
        if (all) break;
        --jt; ++it;
    }
#undef SB_TILE_PTRS
    if (rvalid) {
#pragma unroll
        for (int db = 0; db < 4; ++db)
#pragma unroll
            for (int gq = 0; gq < 4; ++gq) { v2u w; w.x = pk2(o[db][4 * gq], o[db][4 * gq + 1]); w.y = pk2(o[db][4 * gq + 2], o[db][4 * gq + 3]);
                *(v2u*)(Ob + qrow * D + coff + 32 * db + 8 * gq + 4 * hi) = w; }
    }
}

constexpr int XSTEPS = 16;
__device__ __forceinline__ size_t xstep_off(int s, int wid, int lane) { return (size_t)(16 * wid + 2 * (s >> 1)) * D + lane * 4; }
__device__ __forceinline__ void xstep_store(float* dst, const v4u w) {
    __builtin_nontemporal_store((f32x4){__uint_as_float(w.x << 16), __uint_as_float(w.x & 0xffff0000u), __uint_as_float(w.y << 16), __uint_as_float(w.y & 0xffff0000u)}, (f32x4*)dst);
    __builtin_nontemporal_store((f32x4){__uint_as_float(w.z << 16), __uint_as_float(w.z & 0xffff0000u), __uint_as_float(w.w << 16), __uint_as_float(w.w & 0xffff0000u)}, (f32x4*)(dst + D));
}
__device__ __forceinline__ v4u xstep_load(const bf16* src) { const v2u a = *(const v2u*)src, b = *(const v2u*)(src + D); return (v4u){a.x, a.y, b.x, b.y}; }

template <bool SAMPLE, int VAR = 0>
__device__ __forceinline__ void diff_unit(lptr ring, const float* gtab  , volatile LAS float* qn, const float* kn, const bf16* Qb, const bf16* Kb, const bf16* Vb, const bf16* CK, const bf16* CV, bf16* Ob,
                                          float* kout, float* vout  , int b, int h8, int qb, float lam, int wid, int lane) {
    asm volatile("" : "+v"(lane));
    KVStage<256, 256, 32> st; st.init(wid, lane);
    constexpr int VDB = KVStage<256, 256, 32>::VDB;
    const int r32 = lane & 31, hi = lane >> 5, mp = wid >> 2, sb = wid & 3;
    const int qbase = SAMPLE ? PAST : 128 * qb + 32 * sb;
    const int qpos = qbase + r32;
    const size_t qrow = SAMPLE ? (size_t)(MP + 16 * b + r32) : (size_t)b * SEQ + qpos;
    const bool live = SAMPLE ? (sb == 0) : true;
    const bool rvalid = SAMPLE ? (sb == 0 && r32 < 16) : true;
    const int wchunk = SAMPLE ? 32 : (qbase >> 6);
    const int jt_hi = SAMPLE ? 64 : 4 * qb + 3;
    const int coff = h8 * 256;
    constexpr bool XP = EXPAND_L1 && !SAMPLE;
    const float slope2 = __builtin_amdgcn_exp2f(-(float)(h8 + 1)) * LOG2E;
    const int xk = (r32 & 15) << 4;
    const lptr qs = ring + 98304 + wid * 8192 + lane * 16;
    float q2 = 0.f;
#pragma unroll
    for (int ks = 0; ks < 8; ++ks) { const bf16x8 qf = *(const bf16x8*)(Qb + qrow * D + coff + mp * 128 + ks * 16 + hi * 8); *(LAS bf16x8*)(qs + ks * 1024) = qf;
        if (!SAMPLE) {
#pragma unroll
            for (int e = 0; e < 8; ++e) { const float x = __uint_as_float((unsigned)(unsigned short)qf[e] << 16); q2 = fmaf(x, x, q2); } } }
    if (!SAMPLE) {
        { float t1; const float t0 = swap_lo(q2, t1); q2 = t0 + t1; }
        q2 = fmaxf(q2, __shfl_xor(q2, 1)); q2 = fmaxf(q2, __shfl_xor(q2, 2)); q2 = fmaxf(q2, __shfl_xor(q2, 4)); q2 = fmaxf(q2, __shfl_xor(q2, 8)); q2 = fmaxf(q2, __shfl_xor(q2, 16));
        if (lane == 0) qn[wid] = q2; }
    f32x16 o[8];
#pragma unroll
    for (int i = 0; i < 8; ++i) o[i] = f32x16{};
    float m = 0.f, l = 0.f;
#define DF_TILE_PTRS(jt_, kp_, vp_) do { size_t off_; \
        if (!SAMPLE) { off_ = ((size_t)b * SEQ + 32 * (size_t)(jt_)) * D + coff; kp_ = Kb + off_; vp_ = Vb + off_; } \
        else if ((jt_) == 64) { off_ = (size_t)(MP + 16 * b) * D + coff; kp_ = Kb + off_; vp_ = Vb + off_; } \
        else { off_ = ((size_t)b * PAST + 32 * (size_t)(jt_)) * D + coff; kp_ = CK + off_; vp_ = CV + off_; } } while (0)
    { const bf16 *kp, *vp; DF_TILE_PTRS(jt_hi, kp, vp); st.issue(ring, kp, vp, wid); }
    VM_WAIT(); LDS_WAIT(); __syncthreads();
    int jt_lo = 0;
    if (!SAMPLE) {
        const float* knb = kn + (b * 16 + 2 * h8) * 4;
        const float k0s = (knb[0] + knb[1]) + (knb[2] + knb[3]), k1s = (knb[4] + knb[5]) + (knb[6] + knb[7]);
        const float q0m = fmaxf(fmaxf(qn[0], qn[1]), fmaxf(qn[2], qn[3])), q1m = fmaxf(fmaxf(qn[4], qn[5]), fmaxf(qn[6], qn[7]));
        const float Z = 1.02f * sqrtf(fmaxf(q0m * k0s, q1m * k1s));
        const float nneed = (154.f + 2.f * Z) / slope2;
        const float lo = floorf(((float)(128 * qb) - nneed) * (1.0f / 32.0f));
        jt_lo = lo > 0.f ? (int)lo : 0;
        jt_lo = __builtin_amdgcn_readfirstlane(jt_lo);
    }
#define DF_ISSUE(i_, bf_) do { const bf16 *kp_, *vp_; DF_TILE_PTRS(jt_hi - (i_), kp_, vp_); st.issue(ring + (bf_) * 32768, kp_, vp_, wid); } while (0)
    unsigned a0s[16];
#pragma unroll
    for (int r = 0; r < 16; ++r) { const int c = (r & 3) + 8 * (r >> 2); const float kc = (float)c * LOG2E;
        a0s[r] = c == 0 ? 0u : (unsigned)__builtin_amdgcn_readfirstlane((int)(__float_as_uint(kc) - ((unsigned)(h8 + 1) << 23))); }
    const int n = jt_hi - jt_lo + 1;
    const size_t xbase = ((size_t)b * SEQ + 128 * (size_t)qb) * D + coff;
    v4u xq = {0u, 0u, 0u, 0u};
#define XP_LOAD(ptr_) asm volatile("global_load_dwordx2 v[252:253], %0, off\n\tglobal_load_dwordx2 v[254:255], %1, off" :: "v"(ptr_), "v"((ptr_) + D) : "memory", "v252", "v253", "v254", "v255")
#define XP_READ(x_) asm volatile("v_mov_b32 %0, v252\n\tv_mov_b32 %1, v253\n\tv_mov_b32 %2, v254\n\tv_mov_b32 %3, v255" : "=v"(x_.x), "=v"(x_.y), "=v"(x_.z), "=v"(x_.w) :: "memory")
    if (XP) XP_LOAD(Kb + xbase + xstep_off(0, wid, lane));
    if (n > 1) DF_ISSUE(1, 1);
#define DF_QK(i_, bf_, P, MREF) do { const int jt_ = jt_hi - (i_); \
        if (live && (jt_ >> 1) <= wchunk) { \
            if ((jt_ >> 1) == wchunk) { P = f32x16{}; MREF = 0.f; } \
            else { const float e_ = slope2 * (float)(32 * jt_ + 4 * hi - qpos) - m; MREF = m; \
                _Pragma("unroll") for (int r = 0; r < 16; ++r) P[r] = e_ + __uint_as_float(a0s[r]); } \
            const LAS unsigned char* k0_ = ring + (bf_) * 32768 + r32 * 512 + mp * 256; \
            bf16x8 kf_[2], qf_[2]; kf_[0] = *(const LAS bf16x8*)(k0_ + ((hi * 16) ^ xk)); qf_[0] = *(const LAS bf16x8*)(qs); \
            _Pragma("unroll") for (int ks = 0; ks < 8; ++ks) { \
                if (ks < 7) { kf_[(ks + 1) & 1] = *(const LAS bf16x8*)(k0_ + (((ks + 1) * 32 + hi * 16) ^ xk)); qf_[(ks + 1) & 1] = *(const LAS bf16x8*)(qs + (ks + 1) * 1024); } \
                P = __builtin_amdgcn_mfma_f32_32x32x16_bf16(kf_[ks & 1], qf_[ks & 1], P, 0, 0, 0); } \
            __builtin_amdgcn_sched_group_barrier(0x100, 2, 0); \
            _Pragma("unroll") for (int ks = 0; ks < 8; ++ks) { if (ks < 7) __builtin_amdgcn_sched_group_barrier(0x100, 2, 0); __builtin_amdgcn_sched_group_barrier(0x8, 1, 0); } } } while (0)
    m = 0.f;
    f32x16 pN = f32x16{}; float mrefN = 0.f;
    DF_QK(0, 0, pN, mrefN);
    int bf = 0;
    for (int i = 0; i < n; ++i) {
        const int jt = jt_hi - i;
        const int bf1 = bf == 2 ? 0 : bf + 1, bf2 = bf1 == 2 ? 0 : bf1 + 1;
        if (XP && i >= 1 && i <= XSTEPS) asm volatile("s_waitcnt vmcnt(2)" ::: "memory"); else asm volatile("s_waitcnt vmcnt(0)" ::: "memory");
        asm volatile("s_waitcnt lgkmcnt(0)" ::: "memory"); __builtin_amdgcn_s_barrier(); asm volatile("" ::: "memory");
        if (XP && i < XSTEPS) XP_READ(xq);
        if (XP && i + 1 < XSTEPS) XP_LOAD((((i + 1) & 1) ? Vb : Kb) + xbase + xstep_off(i + 1, wid, lane));
        if (i + 2 < n && VAR != 2) DF_ISSUE(i + 2, bf2);
        if (XP && i < XSTEPS) xstep_store(((i & 1) ? vout : kout) + xbase + xstep_off(i, wid, lane), xq);
        f32x16 p = pN; float mref = mrefN;
        if (i + 1 < n) DF_QK(i + 1, bf1, pN, mrefN);
        if (live && (jt >> 1) <= wchunk && VAR != 3) {
            const lptr cur = ring + bf * 32768;
            if ((jt >> 1) == wchunk) {
                const float dqf = (float)(qpos - 32 * jt - 4 * hi);
#pragma unroll
                for (int r = 0; r < 16; ++r) { const float c = (float)((r & 3) + 8 * (r >> 2)); p[r] = fmaf(-slope2, fabsf(dqf - c), p[r]); }
                if (SAMPLE && jt == 64) {
#pragma unroll
                    for (int r = 8; r < 16; ++r) p[r] = -INFINITY; } }
            float tm = fmaxf(fmaxf(p[0], p[1]), p[2]);
#pragma unroll
            for (int r = 3; r < 15; r += 2) tm = fmaxf(fmaxf(tm, p[r]), p[r + 1]);
            tm = fmaxf(tm, p[15]);
            { float t1; const float t0 = swap_lo(tm, t1); tm = fmaxf(t0, t1); }
            float d = mref - m;
            if (__any(tm + d > DF_THR)) { const float mn = fmaxf(m, mref + tm); const float alpha = __builtin_amdgcn_exp2f(m - mn); m = mn; l *= alpha; d = mref - m;
#pragma unroll
                for (int db = 0; db < 8; ++db)
#pragma unroll
                    for (int r = 0; r < 16; ++r) o[db][r] *= alpha; }
            if (__any(d != 0.f)) {
#pragma unroll
                for (int r = 0; r < 16; ++r) p[r] += d; }
            float ps = 0.f;
#pragma unroll
            for (int r = 0; r < 16; ++r) { p[r] = __builtin_amdgcn_exp2f(p[r]); ps += p[r]; }
            l += ps;
            bf16x8 pf[2]; pack_p(pf, p);
            if (VAR != 1) pv<8, 2, VDB>(o, cur + 16384, lane, pf); else asm volatile("" :: "v"(pf[0]), "v"(pf[1]));
        }
        bf = bf1;
    }
    if (XP && n < XSTEPS) { asm volatile("s_waitcnt vmcnt(0)" ::: "memory"); XP_READ(xq);
        for (int s = n; s < XSTEPS; ++s) { xstep_store(((s & 1) ? vout : kout) + xbase + xstep_off(s, wid, lane), xq);
            if (s + 1 < XSTEPS) xq = xstep_load((((s + 1) & 1) ? Vb : Kb) + xbase + xstep_off(s + 1, wid, lane)); } }
    asm volatile("s_waitcnt lgkmcnt(0)" ::: "memory"); __builtin_amdgcn_s_barrier(); asm volatile("" ::: "memory");
#undef DF_QK
#undef XP_LOAD
#undef XP_READ
#undef DF_ISSUE
#undef DF_TILE_PTRS
    { float t1; const float t0 = swap_lo(l, t1); l = t0 + t1; }
    const float inv = live ? 1.0f / l : 0.f;
    const lptr xb = ring + sb * 32768 + lane * 16;
    if (mp == 1) { const float sc = lam * inv;
#pragma unroll
        for (int v = 0; v < 32; ++v) { const int db = v >> 2, gq = v & 3; f32x4 x = {o[db][4 * gq] * sc, o[db][4 * gq + 1] * sc, o[db][4 * gq + 2] * sc, o[db][4 * gq + 3] * sc};
            *(LAS f32x4*)(xb + v * 1024) = x; } }
    LDS_WAIT(); __syncthreads();
    if (mp == 0) { float ss = 0.f;
#pragma unroll
        for (int v = 0; v < 32; ++v) { const int db = v >> 2, gq = v & 3; const f32x4 x = *(const LAS f32x4*)(xb + v * 1024);
#pragma unroll
            for (int e = 0; e < 4; ++e) { const float y = o[db][4 * gq + e] * inv - x[e]; o[db][4 * gq + e] = y; ss += y * y; }
            if ((v & 3) == 3) asm volatile("" : "+v"(ss) :: "memory"); }
        { float t1; const float t0 = swap_lo(ss, t1); ss = t0 + t1; }
        const float rs = 1.0f / sqrtf(ss * (1.0f / 256.0f) + 1e-5f);
#pragma unroll
        for (int v = 0; v < 32; v += 2) { const int db = v >> 2, gq = v & 3; const int d0 = 32 * db + 8 * gq + 4 * hi; const f32x4 ga = *(const f32x4*)(gtab + d0) * GSCALE, gb = *(const f32x4*)(gtab + d0 + 8) * GSCALE;
            v2u wa, wb; wa.x = pk2(o[db][4 * gq] * rs * ga[0], o[db][4 * gq + 1] * rs * ga[1]); wa.y = pk2(o[db][4 * gq + 2] * rs * ga[2], o[db][4 * gq + 3] * rs * ga[3]);
            wb.x = pk2(o[db][4 * gq + 4] * rs * gb[0], o[db][4 * gq + 5] * rs * gb[1]); wb.y = pk2(o[db][4 * gq + 6] * rs * gb[2], o[db][4 * gq + 7] * rs * gb[3]);
            auto r = __builtin_amdgcn_permlane32_swap(wa.x, wb.x, false, false); wa.x = r[0]; wb.x = r[1];
            r = __builtin_amdgcn_permlane32_swap(wa.y, wb.y, false, false); wa.y = r[0]; wb.y = r[1];
            if (rvalid) *(v4u*)(Ob + qrow * D + coff + 32 * db + 8 * gq + 8 * hi) = (v4u){wa.x, wa.y, wb.x, wb.y};
            if ((v & 3) == 2) asm volatile("" ::: "memory"); }
    }
    LDS_WAIT(); __syncthreads();
}
}
#ifndef SKEW_TICKS
#define SKEW_TICKS 0
#endif
#ifndef SKEW2_QKV
#define SKEW2_QKV 0
#define SKEW2_WO 0
#define SKEW2_UP 0
#define SKEW2_DN 0
#endif
__device__ __forceinline__ void phase_skew(int ticks2) {
    if (SKEW_TICKS > 0 || ticks2 > 0) { const unsigned long long t0 = __builtin_amdgcn_s_memrealtime();
        const unsigned long long w = (unsigned long long)((blockIdx.x >> 3) & 31u) * SKEW_TICKS + (unsigned long long)((blockIdx.x >> 3) & 1u) * ticks2;
        while (__builtin_amdgcn_s_memrealtime() - t0 < w) __builtin_amdgcn_s_sleep(8); }
}
__device__ __forceinline__ int lane_id_fresh() { int l; asm volatile("v_mbcnt_lo_u32_b32 %0, -1, 0\n\tv_mbcnt_hi_u32_b32 %0, -1, %0" : "=v"(l)); return l; }
__device__ __forceinline__ void transpose_item(const float* W, int K, int N, bf16* WT, const float* gk  , LAS float* scr, int item, int lane) {
    const int nblk = N / 32, kb = item / nblk, nb = item % nblk, k0 = 64 * kb, n0 = 32 * nb;
    f32x4 v[8];
#pragma unroll
    for (int i = 0; i < 8; ++i) { v[i] = *(const f32x4*)(W + (size_t)(k0 + 8 * i + (lane >> 3)) * N + n0 + 4 * (lane & 7)); if (gk) v[i] = v[i] * gk[k0 + 8 * i + (lane >> 3)]; }
#pragma unroll
    for (int i = 0; i < 8; ++i) { LAS float* d = scr + (8 * i + (lane >> 3)) * 33 + 4 * (lane & 7); d[0] = v[i].x; d[1] = v[i].y; d[2] = v[i].z; d[3] = v[i].w; }
    LDS_WAIT(); asm volatile("" ::: "memory");
    const int c = lane & 7;
#pragma unroll
    for (int j = 0; j < 4; ++j) { const int n = (lane >> 3) + 8 * j; const LAS float* s = scr + (8 * c) * 33 + n;
        v4u o; o.x = pk2(s[0 * 33], s[1 * 33]); o.y = pk2(s[2 * 33], s[3 * 33]); o.z = pk2(s[4 * 33], s[5 * 33]); o.w = pk2(s[6 * 33], s[7 * 33]);
        *(v4u*)(WT + (size_t)(n0 + n) * K + k0 + 8 * c) = o; }
    LDS_WAIT(); asm volatile("" ::: "memory");
}
__device__ __forceinline__ void x0_rows(const float* srcp, const float* srcs, bf16* Xb, float* rowss, int gw, int NGW, int lane) {
    for (int m = gw; m < M; m += NGW) {
        v2u* o8 = (v2u*)(Xb + (size_t)m * D) + lane;
        if (m < MV) {
            const f32x4* xr = (const f32x4*)(m < MP ? srcp + (size_t)m * D : srcs + (size_t)(m - MP) * D) + lane;
            f32x4 v[8]; float ss = 0.f;
#pragma unroll
            for (int j = 0; j < 8; ++j) { v[j] = xr[64 * j]; ss += (v[j].x * v[j].x + v[j].y * v[j].y) + (v[j].z * v[j].z + v[j].w * v[j].w); }
            ss = wave_sum(ss); if (lane == 0) rowss[m] = ss;
#pragma unroll
            for (int j = 0; j < 8; ++j) { v2u w; w.x = pk2(v[j].x, v[j].y); w.y = pk2(v[j].z, v[j].w); o8[64 * j] = w; }
        } else {
#pragma unroll
            for (int j = 0; j < 8; ++j) o8[64 * j] = (v2u){0u, 0u};
        }
    }
}
__device__ __forceinline__ void final_rows(const bf16* Xb, const float* rowss, const float* g, float* Y, int gw, int NGW, int lane) {
    for (int m = gw; m < MV; m += NGW) {
        const v2u* xr = (const v2u*)(Xb + (size_t)m * D) + lane; f32x4* yr = (f32x4*)(Y + (size_t)m * D) + lane;
        const float rs = 1.0f / sqrtf(rowss[m] * (1.0f / D) + 1e-6f);
#pragma unroll
        for (int j = 0; j < 8; ++j) { const v2u w = xr[64 * j]; const f32x4 gv = ((const f32x4*)g)[lane + 64 * j];
            f32x4 x = {__uint_as_float(w.x << 16), __uint_as_float(w.x & 0xffff0000u), __uint_as_float(w.y << 16), __uint_as_float(w.y & 0xffff0000u)};
            yr[64 * j] = (x * rs) * gv; }
    }
}
__device__ __forceinline__ void cache_convert(const float* ck, const float* cv, bf16* CK, bf16* CV, int k_lo  , size_t gt, size_t NT) {
    const size_t per = (size_t)(PAST - k_lo) * D / 8, NCH = (size_t)DEC_B * per;
    for (size_t i = gt; i < 2 * NCH; i += NT) { const bool t = i >= NCH; const size_t j = t ? i - NCH : i; const size_t s_ = j / per, r_ = j % per;
        const size_t c = (s_ * PAST + k_lo) * (size_t)(D / 8) + r_;
        const f32x4* s = (const f32x4*)((t ? cv : ck) + c * 8); const f32x4 a = s[0], b2 = s[1];
        v4u o; o.x = pk2(a.x, a.y); o.y = pk2(a.z, a.w); o.z = pk2(b2.x, b2.y); o.w = pk2(b2.z, b2.w);
        *(v4u*)((t ? CV : CK) + c * 8) = o; }
}

struct Args { const float* in[16]; float* out; unsigned char* ws; int ph_lo, ph_hi; };
struct SkQKV { static constexpr bool SS = false; unsigned char* ws; float* out; int L; float qscale; const float* rowss;
    __device__ __forceinline__ float operator()(int row, int col, float v) const { const int t = col >> 11, c = col & 2047;
        if (rowss) v *= 1.0f / sqrtf(rowss[row] * (1.0f / D) + 1e-6f);
        bf16* ob = (bf16*)(ws + QKV_WS_Q + (size_t)t * QKV_WS_STRIDE) + (size_t)row * D + c;
        const float sv = t == 0 ? v * qscale : v; *ob = (bf16)(pk2(sv, 0.f) & 0xffffu);
        if (t != 0) { float* fs = out + (t == 1 ? QKV_OUT_KS : QKV_OUT_VS) + (size_t)L * MS * D; fs[(size_t)(row - MP) * D + c] = v; } return 0.f; } };
struct SkResidB { static constexpr bool SS = true; bf16* X; float* rowss;
    __device__ __forceinline__ float operator()(int row, int col, float v) const { bf16* p = X + (size_t)row * D + col; const float x = __uint_as_float((unsigned)*p << 16) + v;
        *p = (bf16)(pk2(x, 0.f) & 0xffffu); return x; } };
struct SkRelu2 { static constexpr bool SS = false; bf16* O; int ldc; const float* rowss;
    __device__ __forceinline__ float operator()(int row, int col, float v) const { if (rowss) v *= 1.0f / sqrtf(rowss[row] * (1.0f / D) + 1e-6f);
        const float a = fmaxf(v, 0.f); O[(size_t)row * ldc + col] = (bf16)(pk2(a * a, 0.f) & 0xffffu); return 0.f; } };
template <class Epi>
__device__ __forceinline__ void skinny_phase(LAS unsigned char* ring, const bf16* A, const bf16* Bt, int N, int K, const Epi& E, int vcu, int G, int wave, int lane) {
    typedef short bf16x8 __attribute__((ext_vector_type(8))); typedef float f32x16 __attribute__((ext_vector_type(16)));
    const int ntile = 4 * (N / 32), r32 = lane & 31, hi = lane >> 5, kw = K / 8;
    LAS float* red = (LAS float*)ring;
    LAS unsigned char* stg = ring + wave * 16384;
    const int srow = lane >> 4, sch = lane & 15, xk = (r32 & 15);
    for (int t = vcu; t < ntile; t += G) {
        const int mb = t & 3, nb = t >> 2;
        const bf16* ap = A + (size_t)(MP + 32 * mb + srow) * K + wave * kw + sch * 8;
        const bf16* bp = Bt + (size_t)(32 * nb + srow) * K + wave * kw + sch * 8;
        f32x16 acc = f32x16{};
#pragma unroll 1
        for (int k0 = 0; k0 < kw; k0 += 128) {
            bf16x8 ga[8], gb[8];
#pragma unroll
            for (int i = 0; i < 8; ++i) { ga[i] = *(const bf16x8*)(ap + (size_t)(4 * i) * K + k0); gb[i] = *(const bf16x8*)(bp + (size_t)(4 * i) * K + k0); }
#pragma unroll
            for (int i = 0; i < 8; ++i) { const int row = 4 * i + srow; const int off = row * 256 + ((sch ^ (row & 15)) << 4);
                *(LAS bf16x8*)(stg + off) = ga[i]; *(LAS bf16x8*)(stg + 8192 + off) = gb[i]; }
            LDS_WAIT();
#pragma unroll
            for (int ks = 0; ks < 8; ++ks) { const int off = r32 * 256 + (((2 * ks + hi) ^ xk) << 4);
                acc = __builtin_amdgcn_mfma_f32_32x32x16_bf16(*(const LAS bf16x8*)(stg + off), *(const LAS bf16x8*)(stg + 8192 + off), acc, 0, 0, 0); }
            LDS_WAIT();
        }
        __syncthreads();
#pragma unroll
        for (int r = 0; r < 16; ++r) red[(wave * 16 + r) * 64 + lane] = acc[r];
        LDS_WAIT(); __syncthreads();
        float v0 = 0.f, v1 = 0.f;
#pragma unroll
        for (int w = 0; w < 8; ++w) { v0 += red[(w * 16 + 2 * wave) * 64 + lane]; v1 += red[(w * 16 + 2 * wave + 1) * 64 + lane]; }
        const int r0 = 2 * wave, row0 = MP + 32 * mb + (r0 & 3) + 8 * (r0 >> 2) + 4 * hi, col = 32 * nb + r32;
        float x0 = E(row0, col, v0), x1 = E(row0 + 1, col, v1);
        if constexpr (Epi::SS) { x0 *= x0; x1 *= x1;
#pragma unroll
            for (int o = 1; o < 32; o <<= 1) { x0 += __shfl_xor(x0, o); x1 += __shfl_xor(x1, o); }
            if (r32 == 0) { atomicAdd(E.rowss + row0, x0); atomicAdd(E.rowss + row0 + 1, x1); } }
        LDS_WAIT(); __syncthreads();
    }
}

#ifndef WGM_QKV
#define WGM_QKV 4
#endif
#ifndef WGM_WO
#define WGM_WO 2
#endif
#ifndef WGM_UP
#define WGM_UP 4
#endif
#ifndef WGM_DN
#define WGM_DN 4
#endif
#ifndef FFN_CHUNKS
#define FFN_CHUNKS 1
#endif
#ifndef PROBE_VAR
#define PROBE_VAR 0
#endif
#ifndef PROBE_DUP
#define PROBE_DUP 0
#endif
template <int L>
__device__ __forceinline__ void layer_phases(const Args& args, LAS unsigned char* lds, volatile LAS int* flags, const XcdBarrier& bar, int lo, int hi, int G, int vcu, int wave) {
#define PHASE_LOCALS const int lane = lane_id_fresh(); const int tid = wave * 64 + lane;
#define IN(k) (lo <= (k) && (k) < hi)
#define SEAM(k) do { if (ONE_LAUNCH && IN(k) && IN((k) + 1)) xcd_barrier(bar); } while (0)
    unsigned char* ws = args.ws;
    const float* x_prompt = args.in[0]; const float* x_sample = args.in[1];
    bf16* XN = (bf16*)(ws + WS_XN);
    bf16* CK = (bf16*)(ws + (L == 0 ? WS_CK : WS_CK1)); bf16* CV = (bf16*)(ws + (L == 0 ? WS_CV : WS_CV1));
    float* const RSS = (float*)(ws + WS_CTL) + CW_RSS;
    const float* const rss_qkv = RSS + (size_t)(2 * L) * MV; float* const rss_wo = RSS + (size_t)(2 * L + 1) * MV; float* const rss_dn = RSS + (size_t)(2 * L + 2) * MV;
    bf16* Qb = (bf16*)(ws + WS_Q); bf16* Kb = (bf16*)(ws + WS_K); bf16* Vb = (bf16*)(ws + WS_V); bf16* Hb = (bf16*)(ws + WS_H);
    const int gw = vcu * NWAVES + wave, NGW = G * NWAVES;

        const int pb = 1 + 7 * L;
        unsigned char* wl = ws + WS_W + (size_t)L * W_LAYER;
        const bf16* Wqkv_t = (const bf16*)(wl + W_QKV); const bf16* Wo_t = (const bf16*)(wl + W_O); const bf16* Wup_t = (const bf16*)(wl + W_UP); const bf16* Wdn_t = (const bf16*)(wl + W_DN);
        constexpr bool DUPG = (L == 0) && (PROBE_DUP & 2), DUPA = (L == 0 ? (PROBE_DUP & 8) : (PROBE_DUP & 4)) != 0, DUPT = (L == 0) && (PROBE_DUP & 16), DUPU = (L == 0) && (PROBE_DUP & 32);
        bf16* const DUMMY_O = (bf16*)(ws + WS_V + (size_t)M * D * 2);
        float* const DUMMY_X = (float*)(ws + WS_XN);
        if (IN(pb)) { PHASE_LOCALS
#pragma unroll
            for (int rep = 0; rep < (DUPG ? 2 : 1); ++rep) {
            pg8::Gemm g{XN, Wqkv_t, MP, 3 * D, D}; pg8::StaticOrder S; S.init(MP, 3 * D, G, (int)blockIdx.x, WGM_QKV);
            pg8::EpiQKV E{ws, args.out, L, att::QSCALE, (unsigned*)(ws + WS_CTL) + CW_KN, rss_qkv};
            phase_skew(SKEW2_QKV);
            pg8::gemm_phase<pg8::EpiQKV, pg8::StaticOrder, PG8_ALIGN, PG8_SP2>(lds + RING_OFF, g, S, E, wave, lane);
            skinny_phase(lds + RING_OFF, XN, Wqkv_t, 3 * D, D, SkQKV{ws, args.out, L, att::QSCALE, rss_qkv}, vcu, G, wave, lane);
            }
        }
        SEAM(pb);
        if (IN(pb + 1)) { PHASE_LOCALS float* const KOUT = args.out + OUT_KP + (size_t)L * MP * D; float* const VOUT = args.out + OUT_VP + (size_t)L * MP * D;
            if (L == 0) {
#pragma unroll
                for (int rep = 0; rep < (DUPA ? 2 : 1); ++rep) { bf16* const Ob = (DUPA && rep == 0) ? DUMMY_O : Qb;
                for (int u = vcu; u < 2048; u += G) att::sb_unit<false>(lds + RING_OFF, flags, Qb, Kb, Vb, CK, CV, args.in[2], args.in[3], Ob, u >> 9, (u >> 5) & 15, u & 31, wave, lane);
                for (int u = vcu; u < 128; u += G) att::sb_unit<true>(lds + RING_OFF, flags, Qb, Kb, Vb, CK, CV, args.in[2], args.in[3], Ob, u >> 4, u & 15, 0, wave, lane);
                }
            } else {
                constexpr float LAMBDA_INIT = 0.35550906759096926f;
                float s1 = args.in[7][lane] * args.in[8][lane] + args.in[7][lane + 64] * args.in[8][lane + 64];
                float s2 = args.in[9][lane] * args.in[10][lane] + args.in[9][lane + 64] * args.in[10][lane + 64];
                s1 = wave_sum(s1); s2 = wave_sum(s2);
                const float lam = expf(s1) - expf(s2) + LAMBDA_INIT;
                const float* gtab = args.in[11];
                volatile LAS unsigned* MISCp = (volatile LAS unsigned*)(lds + LDSCTL_OFF);
                const unsigned st0 = MISCp[8], st1 = MISCp[9];
                LDS_WAIT(); __syncthreads();
#pragma unroll
                for (int rep = 0; rep < (DUPA ? 2 : 1); ++rep) { bf16* const Ob = (DUPA && rep == 0) ? DUMMY_O : Qb;
                volatile LAS float* qn = (volatile LAS float*)(lds + 65536);
                volatile LAS int* qslot = (volatile LAS int*)(lds + 65536 + 64);
                const float* kn = (const float*)(ws + WS_CTL) + CW_KN;
                const unsigned q0 = xb_xcc_id() & 7u;
                for (unsigned qk = 0; qk < 8; ++qk) { const unsigned q = (q0 + qk) & 7u; unsigned* head = (unsigned*)(ws + WS_CTL) + CW_QH + 64 * q + 16 * (DUPA ? rep : 0);
                    for (;;) {
                        if (tid == 0) *qslot = (int)atomicAdd(head, 1u);
                        LDS_WAIT(); __syncthreads();
                        const int e = *qslot;
                        __syncthreads();
                        if (e >= 264) break;
                        if (e >= 8) { const int ep = e - 8; const int qb = 63 - (ep >> 2), g4 = ep & 3; const int b = 2 * (q >> 2) + (g4 & 1), h8 = (g4 & 2) ? 7 - (q & 3) : (q & 3);
                            if (DUPA && rep == 0) att::diff_unit<false, PROBE_VAR>(lds + RING_OFF, gtab, qn, kn, Qb, Kb, Vb, CK, CV, Ob, KOUT, VOUT, b, h8, qb, lam, wave, lane);
                            else att::diff_unit<false>(lds + RING_OFF, gtab, qn, kn, Qb, Kb, Vb, CK, CV, Ob, KOUT, VOUT, b, h8, qb, lam, wave, lane); }
                        else att::diff_unit<true>(lds + RING_OFF, gtab, qn, kn, Qb, Kb, Vb, CK, CV, Ob, KOUT, VOUT, e, q, 0, lam, wave, lane);
                    }
                }
                if (DUPA ? rep == 1 : true) { LDS_WAIT(); __syncthreads(); if (tid == 0) { MISCp[8] = st0; MISCp[9] = st1; } LDS_WAIT(); __syncthreads(); }
                }
            }
        }
        SEAM(pb + 1);
        if (IN(pb + 2)) { PHASE_LOCALS
#pragma unroll
            for (int rep = 0; rep < (DUPG ? 2 : 1); ++rep) {
            pg8::Gemm g{Qb, Wo_t, MP, D, D}; pg8::StaticOrder S; S.init(MP, D, G, (int)blockIdx.x, WGM_WO);
            pg8::EpiResidB E{XN, rss_wo};
            phase_skew(SKEW2_WO);
            pg8::gemm_phase<pg8::EpiResidB, pg8::StaticOrder, PG8_ALIGN, PG8_SP2>(lds + RING_OFF, g, S, E, wave, lane);
            skinny_phase(lds + RING_OFF, Qb, Wo_t, D, D, SkResidB{XN, rss_wo}, vcu, G, wave, lane);
            }
        }
        SEAM(pb + 2);
        constexpr int NC = (ONE_LAUNCH && PROBE_DUP == 0) ? FFN_CHUNKS : 1, MC = MP / NC;
        static_assert(MP % NC == 0 && (MC / 256) * (FF / 256) % 256 == 0 && (MC / 256) * (D / 256) % 256 == 0, "chunk GEMMs must be whole rounds");
        bf16* const Hs = (bf16*)((unsigned char*)Hb + ((size_t)MC * FF - (size_t)MP * FF) * 2);
#pragma unroll 1
        for (int c = 0; c < NC; ++c) {
        if (IN(pb + 4)) { PHASE_LOCALS
#pragma unroll
            for (int rep = 0; rep < ((DUPG || DUPU) ? 2 : 1); ++rep) {
            pg8::Gemm g{XN + (size_t)c * MC * D, Wup_t, MC, FF, D}; pg8::StaticOrder S; S.init(MC, FF, G, (int)blockIdx.x, WGM_UP);
            pg8::EpiRelu2 E{Hb, FF, DUPU && rep == 0 && (PROBE_DUP & 64), rss_wo + (size_t)c * MC};
            phase_skew(SKEW2_UP);
            pg8::gemm_phase<pg8::EpiRelu2, pg8::StaticOrder, PG8_ALIGN, PG8_SP2>(lds + RING_OFF, g, S, E, wave, lane);
            if (c == 0) skinny_phase(lds + RING_OFF, XN, Wup_t, FF, D, SkRelu2{Hs, FF, rss_wo}, vcu, G, wave, lane);
            }
        }
        if (NC > 1) xcd_barrier(bar); else SEAM(pb + 4);
        if (IN(pb + 5)) { PHASE_LOCALS
#pragma unroll
            for (int rep = 0; rep < 1; ++rep) {
            pg8::Gemm g{Hb, Wdn_t, MC, D, FF}; pg8::StaticOrder S; S.init(MC, D, G, (int)blockIdx.x, WGM_DN);
            pg8::EpiResidB E{XN + (size_t)c * MC * D, rss_dn + (size_t)c * MC};
            phase_skew(SKEW2_DN);
            pg8::gemm_phase<pg8::EpiResidB, pg8::StaticOrder, PG8_ALIGN, PG8_SP2>(lds + RING_OFF, g, S, E, wave, lane);
            if (c == NC - 1) skinny_phase(lds + RING_OFF, Hs, Wdn_t, D, FF, SkResidB{XN, rss_dn}, vcu, G, wave, lane);
            }
        }
        if (NC > 1) xcd_barrier(bar); else SEAM(pb + 5);
        }
        if (L == 1 && IN(pb + 6)) { PHASE_LOCALS final_rows(XN, rss_dn, args.in[15], args.out + OUT_Y, gw, NGW, lane); }

#undef PHASE_LOCALS
#undef IN
#undef SEAM
}

__global__ void __launch_bounds__(NWAVES * 64, 2) fwd_kernel(Args args) {
    extern __shared__ __attribute__((aligned(16))) unsigned char lds_raw[];
    LAS unsigned char* lds = (LAS unsigned char*)lds_raw;
    volatile LAS unsigned* MISC = (volatile LAS unsigned*)(lds + LDSCTL_OFF);
    volatile LAS int* flags = (volatile LAS int*)(lds + LDSCTL_OFF + 128);
    const int wave = __builtin_amdgcn_readfirstlane((int)threadIdx.x >> 6);
    const int lane = lane_id_fresh(); const int tid = wave * 64 + lane;
    const int G = gridDim.x; const int bx = blockIdx.x; const int vcu = (G % 8 == 0) ? (bx % 8) * (G / 8) + bx / 8 : bx;
    for (int u = tid; u < 128; u += NWAVES * 64) ((LAS unsigned*)(lds + LDSCTL_OFF))[u] = 0u;
    __syncthreads();
    unsigned char* ws = args.ws;
    gu32* ctl = (gu32*)(ws + WS_CTL);
    XcdBarrier bar; bar.bar = (unsigned*)ctl + CW_BAR; bar.x = 0; bar.st = nullptr; bar.wave = wave;
    if (ONE_LAUNCH) bar = xcd_barrier_post((unsigned*)ctl + CW_BAR, MISC + 8, wave);
    const int lo = args.ph_lo, hi = args.ph_hi;
#define IN(k) (lo <= (k) && (k) < hi)
#define SEAM(k) do { if (ONE_LAUNCH && IN(k) && IN((k) + 1)) xcd_barrier(bar); } while (0)
    const float* x_prompt = args.in[0]; const float* x_sample = args.in[1];
    float* X = args.out + OUT_Y;
    bf16* XN = (bf16*)(ws + WS_XN); bf16* CK = (bf16*)(ws + WS_CK); bf16* CV = (bf16*)(ws + WS_CV);
    bf16* Qb = (bf16*)(ws + WS_Q); bf16* Kb = (bf16*)(ws + WS_K); bf16* Vb = (bf16*)(ws + WS_V); bf16* Hb = (bf16*)(ws + WS_H);
    const int gw = vcu * NWAVES + wave, NGW = G * NWAVES;

    if (IN(0)) {
#pragma unroll
        for (int rep = 0; rep < ((PROBE_DUP & 1) ? 2 : 1); ++rep) {
        LAS float* scr = (LAS float*)(lds + RING_OFF + wave * 16384);
        constexpr int I_QKV = (D / 64) * (3 * D / 32), I_O = (D / 64) * (D / 32), I_UP = (D / 64) * (FF / 32), I_DN = (FF / 64) * (D / 32), I_L = I_QKV + I_O + I_UP + I_DN;
        for (int it = gw; it < 2 * I_L; it += NGW) {
            const int L = it / I_L; int r = it % I_L; unsigned char* wl = ws + WS_W + (size_t)L * W_LAYER;
            if (r < I_QKV) { transpose_item(args.in[5] + (size_t)L * D * 3 * D, D, 3 * D, (bf16*)(wl + W_QKV), args.in[4] + (size_t)L * D, scr, r, lane); continue; } r -= I_QKV;
            if (r < I_O) { transpose_item(args.in[6] + (size_t)L * D * D, D, D, (bf16*)(wl + W_O), nullptr, scr, r, lane); continue; } r -= I_O;
            if (r < I_UP) { transpose_item(args.in[13] + (size_t)L * D * FF, D, FF, (bf16*)(wl + W_UP), args.in[12] + (size_t)L * D, scr, r, lane); continue; } r -= I_UP;
            transpose_item(args.in[14] + (size_t)L * FF * D, FF, D, (bf16*)(wl + W_DN), nullptr, scr, r, lane);
        }
        cache_convert(args.in[2], args.in[3], CK, CV, 64 * att::SB_EAGER_LO, (size_t)vcu * (NWAVES * 64) + tid, (size_t)G * (NWAVES * 64));
        cache_convert(args.in[2] + (size_t)DEC_B * PAST * D, args.in[3] + (size_t)DEC_B * PAST * D, (bf16*)(ws + WS_CK1), (bf16*)(ws + WS_CV1), 0, (size_t)vcu * (NWAVES * 64) + tid, (size_t)G * (NWAVES * 64));
        x0_rows(x_prompt, x_sample, XN, (float*)(ws + WS_CTL) + CW_RSS, gw, NGW, lane);
        for (int i = vcu * (NWAVES * 64) + tid; i < 3 * (M - MV) * D / 8; i += G * (NWAVES * 64)) { const int t = i / ((M - MV) * D / 8), c = i % ((M - MV) * D / 8);
            *(v4u*)(ws + WS_Q + (size_t)t * (WS_K - WS_Q) + ((size_t)MV * D + (size_t)c * 8) * 2) = (v4u){0u, 0u, 0u, 0u}; }
        }
    }
    SEAM(0);

    layer_phases<0>(args, lds, flags, bar, lo, hi, G, vcu, wave);
    layer_phases<1>(args, lds, flags, bar, lo, hi, G, vcu, wave);
#undef IN
#undef SEAM
}

extern "C" void kernel_launch(void* const* d_in, const int* in_sizes, int n_in, void* d_out, int out_size, void* d_ws, size_t ws_size, hipStream_t stream) {
    static int grid = 0;
    if (grid == 0) {
        if (n_in != 16 || (size_t)out_size != OUT_END || ws_size < WS_END) { fprintf(stderr, "kernel_launch: unexpected shapes (n_in %d out %d ws %zu)\n", n_in, out_size, ws_size); grid = -1; return; }
        int dev = 0, cus = 0;
        if (hipGetDevice(&dev) != hipSuccess || hipDeviceGetAttribute(&cus, hipDeviceAttributeMultiprocessorCount, dev) != hipSuccess) { grid = -1; return; }
        if (hipFuncSetAttribute((const void*)fwd_kernel, hipFuncAttributeMaxDynamicSharedMemorySize, LDS_BYTES) != hipSuccess) { fprintf(stderr, "kernel_launch: hipFuncSetAttribute failed\n"); grid = -1; return; }
        int per_cu = 0;
        if (hipOccupancyMaxActiveBlocksPerMultiprocessor(&per_cu, (const void*)fwd_kernel, NWAVES * 64, LDS_BYTES) != hipSuccess || per_cu < 1) fprintf(stderr, "kernel_launch: occupancy query says %d\n", per_cu);
        (void)hipGetLastError();
        grid = cus;
    }
    if (grid < 0) return;
    (void)hipMemsetAsync((char*)d_ws + WS_CTL, 0, CTL_ZERO_BYTES, stream);
    Args a{};
    for (int i = 0; i < 16; ++i) a.in[i] = (const float*)d_in[i];
    a.out = (float*)d_out; a.ws = (unsigned char*)d_ws;
    if (ONE_LAUNCH) { a.ph_lo = 0; a.ph_hi = N_PHASES; hipLaunchKernelGGL(fwd_kernel, dim3(grid), dim3(NWAVES * 64), LDS_BYTES, stream, a); }
    else for (int p = 0; p < N_PHASES; ++p) { a.ph_lo = p; a.ph_hi = p + 1; hipLaunchKernelGGL(fwd_kernel, dim3(grid), dim3(NWAVES * 64), LDS_BYTES, stream, a); }
}
```

```cpp
#include <hip/hip_runtime.h>
#include <cstdio>
#include <cstdint>
constexpr int D = 2048, BATCH = 4, SEQ = 8192, DEC_B = 8, DEC_T = 16, PAST = 2048, FF = 8192;
constexpr int MP = BATCH * SEQ;
constexpr int MS = DEC_B * DEC_T;
constexpr int MV = MP + MS;
constexpr int M = 33024;
constexpr size_t QKV_WS_Q = (size_t)451 << 20, QKV_WS_STRIDE = (size_t)129 << 20;
constexpr size_t QKV_OUT_KP = (size_t)MV * D, QKV_OUT_VP = QKV_OUT_KP + 2 * (size_t)MP * D, QKV_OUT_KS = QKV_OUT_VP + 2 * (size_t)MP * D, QKV_OUT_VS = QKV_OUT_KS + 2 * (size_t)MS * D;
#ifndef EXPAND_L1
#define EXPAND_L1 0
#endif
#ifndef KV_STORE_POLICY
#define KV_STORE_POLICY 3
#define KV_STORE_BITS "sc0 sc1 nt"
#endif
namespace pg8 {
#define PG8_LAS __attribute__((address_space(3)))
#ifndef PG8_NREMAP
#define PG8_NREMAP 0
#endif
constexpr int PG8_WCS = PG8_NREMAP ? 64 : 32, PG8_BJS = PG8_NREMAP ? 32 : 128;
typedef unsigned short bf16_t;
typedef short bf16x8 __attribute__((ext_vector_type(8)));
typedef float f32x4 __attribute__((ext_vector_type(4)));
typedef unsigned u32x4 __attribute__((ext_vector_type(4)));
constexpr int BM = 256, BK = 64, HALF = 128, HTB = HALF * BK * 2  , STAGE_BYTES = 8 * HTB, NXCD = 8, WGM = 8;

__host__ __device__ __forceinline__ int lds_byte(int r, int c) { const int st = (r >> 4) * 2 + (c >> 5), rr = r & 15, cc = c & 31, ob = rr * 64 + cc * 2; return st * 1024 + (ob ^ (((ob >> 9) & 1) << 5)); }
__host__ __device__ __forceinline__ void stage_rc(int b, int& R, int& C) { const int st = b / 1024, sb = b % 1024, swz = sb ^ (((sb >> 9) & 1) << 5); R = (st >> 1) * 16 + swz / 64; C = (st & 1) * 32 + (swz % 64) / 2; }
__host__ __device__ __forceinline__ int perm32(int rho) { const int n = rho >> 4, i = rho & 15; return 8 * (i >> 2) + 4 * n + (i & 3); }

struct Unit { int pm, pn; };
struct Gemm { const bf16_t* A; const bf16_t* Bt; int M, N, K; };

struct StaticOrder {
    int nM, nN, nwg, G, c, wgm;
    __host__ __device__ void init(int M, int N, int G_, int c_, int wgm_ = WGM) { nM = M / BM; nN = N / BM; nwg = nM * nN; G = G_; c = c_; wgm = wgm_; }
    __host__ __device__ bool next(int i, Unit& u) const {
        const long L = (long)i * G + c; if (L >= nwg) return false;
        int wgid = (int)L; { const int q = nwg / NXCD, r = nwg % NXCD, xcd = wgid % NXCD, off = wgid / NXCD; wgid = (xcd < r ? xcd * (q + 1) : r * (q + 1) + (xcd - r) * q) + off; }
        const int nig = wgm * nN, gid = wgid / nig, fm = gid * wgm, gsz = (nM - fm) < wgm ? (nM - fm) : wgm;
        u.pm = fm + ((wgid % nig) % gsz); u.pn = (wgid % nig) / gsz; return true;
    }
    __device__ __forceinline__ void a_ready(const Unit&) const {}
    __device__ __forceinline__ void done(const Unit&) const {}
};

__device__ __forceinline__ unsigned cvt_pk_bf16(float lo, float hi) { unsigned r; asm volatile("v_cvt_pk_bf16_f32 %0, %1, %2" : "=v"(r) : "v"(lo), "v"(hi)); return r; }
typedef float f32x2 __attribute__((ext_vector_type(2)));
typedef unsigned u32x2 __attribute__((ext_vector_type(2)));
struct EpiQKV {
    static constexpr bool PERM = true, AFTER_DRAIN = false;
    unsigned char* ws; float* out; int L; float qscale; unsigned* kn; const float* rowss;
    __device__ __forceinline__ void operator()(const f32x4 (&acc)[2][2][4][2], const Unit& u, int wr, int wc, int fr, int fq) const {
        const int row0 = u.pm * BM + wr * 64 + fr; const int t = u.pn >> 3; const int col0 = (u.pn & 7) * BM + wc * PG8_WCS + 8 * fq;
        bf16_t* ob = (bf16_t*)(ws + QKV_WS_Q + (size_t)t * QKV_WS_STRIDE);
        float* fp = out + (t == 1 ? QKV_OUT_KP : QKV_OUT_VP) + (size_t)L * MP * D; float* fs = out + (t == 1 ? QKV_OUT_KS : QKV_OUT_VS) + (size_t)L * MS * D;
        const float sc = t == 0 ? qscale : 1.f;
#pragma unroll
        for (int ai = 0; ai < 2; ++ai)
#pragma unroll
            for (int m = 0; m < 4; ++m) { const int row = row0 + ai * HALF + m * 16;
                float* frow = nullptr; if (t != 0) { if (row < MP) { if (!(EXPAND_L1 && L == 1)) frow = fp + (size_t)row * D; } else if (row < MV) frow = fs + (size_t)(row - MP) * D; }
                bf16_t* rowp = ob + (size_t)row * D + col0;
                const float rsc = rowss ? 1.0f / sqrtf(rowss[row] * (1.0f / D) + 1e-6f) : 1.0f;
#pragma unroll
                for (int bj = 0; bj < 2; ++bj) { const f32x4 v0 = acc[ai][bj][m][0] * rsc, v1 = acc[ai][bj][m][1] * rsc;
                    u32x4 w; w.x = cvt_pk_bf16(v0[0] * sc, v0[1] * sc); w.y = cvt_pk_bf16(v0[2] * sc, v0[3] * sc); w.z = cvt_pk_bf16(v1[0] * sc, v1[1] * sc); w.w = cvt_pk_bf16(v1[2] * sc, v1[3] * sc);
                    *(u32x4*)(rowp + bj * PG8_BJS) = w;
                    if (frow) {
#if KV_STORE_POLICY == 0
                        __builtin_nontemporal_store(v0, (f32x4*)(frow + col0 + bj * PG8_BJS)); __builtin_nontemporal_store(v1, (f32x4*)(frow + col0 + bj * PG8_BJS + 4));
#elif KV_STORE_POLICY == 2
                        f32x4 a4 = v0, b4 = v1;
#pragma unroll
                        for (int e = 0; e < 4; ++e) { auto r = __builtin_amdgcn_permlane16_swap(__float_as_uint(a4[e]), __float_as_uint(b4[e]), false, false);
                            r = __builtin_amdgcn_permlane32_swap(r[0], r[1], false, false); a4[e] = __uint_as_float(r[0]); b4[e] = __uint_as_float(r[1]); }
                        __builtin_nontemporal_store(a4, (f32x4*)(frow + col0 - 4 * fq + bj * PG8_BJS)); __builtin_nontemporal_store(b4, (f32x4*)(frow + col0 - 4 * fq + 16 + bj * PG8_BJS));
#elif KV_STORE_POLICY == 3
                        f32x4 a4 = v0, b4 = v1;
#pragma unroll
                        for (int e = 0; e < 4; ++e) { auto r = __builtin_amdgcn_permlane16_swap(__float_as_uint(a4[e]), __float_as_uint(b4[e]), false, false);
                            r = __builtin_amdgcn_permlane32_swap(r[0], r[1], false, false); a4[e] = __uint_as_float(r[0]); b4[e] = __uint_as_float(r[1]); }
                        const bool odd = fr & 1; f32x4 s1, s2;
#pragma unroll
                        for (int e = 0; e < 4; ++e) { const float na = __int_as_float(__builtin_amdgcn_update_dpp(0, __float_as_int(a4[e]), 0xB1, 0xF, 0xF, true)), nb = __int_as_float(__builtin_amdgcn_update_dpp(0, __float_as_int(b4[e]), 0xB1, 0xF, 0xF, true));
                            s1[e] = odd ? nb : a4[e]; s2[e] = odd ? b4[e] : na; }
                        float* const cb = frow + col0 - 4 * fq + (odd ? 16 : 0) + bj * PG8_BJS;
                        __builtin_nontemporal_store(s1, (f32x4*)(cb - (odd ? D : 0))); __builtin_nontemporal_store(s2, (f32x4*)(cb + (odd ? 0 : D)));
#else
                        float* fa = frow + col0 + bj * PG8_BJS;
                        asm volatile("global_store_dwordx4 %0, %1, off " KV_STORE_BITS "\n\tglobal_store_dwordx4 %0, %2, off offset:16 " KV_STORE_BITS "\n\ts_nop 1" :: "v"(fa), "v"(v0), "v"(v1) : "memory");
#endif
                    } } }
        if (L == 1 && t == 1 && u.pm * BM < MP) {
#pragma unroll
            for (int bj = 0; bj < 2; ++bj) { float mx = 0.f;
#pragma unroll
                for (int ai = 0; ai < 2; ++ai)
#pragma unroll
                    for (int m = 0; m < 4; ++m) { const f32x4 v0 = acc[ai][bj][m][0], v1 = acc[ai][bj][m][1];
                        const float rq = rowss ? 1.0f / (rowss[row0 + ai * HALF + m * 16] * (1.0f / D) + 1e-6f) : 1.0f;
                        float sq = rq * ((v0[0] * v0[0] + v0[1] * v0[1]) + (v0[2] * v0[2] + v0[3] * v0[3]) + (v1[0] * v1[0] + v1[1] * v1[1]) + (v1[2] * v1[2] + v1[3] * v1[3]));
                        sq += __shfl_xor(sq, 16); sq += __shfl_xor(sq, 32); mx = fmaxf(mx, sq); }
                mx = fmaxf(mx, __shfl_xor(mx, 1)); mx = fmaxf(mx, __shfl_xor(mx, 2)); mx = fmaxf(mx, __shfl_xor(mx, 4)); mx = fmaxf(mx, __shfl_xor(mx, 8));
                const int c32 = (wc * PG8_WCS + bj * PG8_BJS) >> 5;
                if (fr == 0 && fq == 0) atomicMax(kn + (((u.pm * BM) / SEQ) * 16 + (u.pn & 7) * 2 + (c32 >> 2)) * 4 + (c32 & 3), __float_as_uint(mx)); }
        }
    }
};
struct EpiResid {
    static constexpr bool PERM = false, AFTER_DRAIN = false;
    const float* rp; const float* rs; float* out;
    __device__ __forceinline__ void operator()(const f32x4 (&acc)[2][2][4][2], const Unit& u, int wr, int wc, int fr, int fq) const {
        const int col0 = u.pn * BM + wc * PG8_WCS + 4 * fq;
#pragma unroll
        for (int ai = 0; ai < 2; ++ai)
#pragma unroll
            for (int m = 0; m < 4; ++m) { const int row = u.pm * BM + ai * HALF + wr * 64 + m * 16 + fr;
                if (row < MV) { const float* r = row < MP ? rp + (size_t)row * D : rs + (size_t)(row - MP) * D; float* o = out + (size_t)row * D;
#pragma unroll
                    for (int bj = 0; bj < 2; ++bj)
#pragma unroll
                        for (int n = 0; n < 2; ++n) { const int c = col0 + bj * PG8_BJS + n * 16; *(f32x4*)(o + c) = *(const f32x4*)(r + c) + acc[ai][bj][m][n]; } } }
    }
};
struct EpiResidB {
    static constexpr bool PERM = true, AFTER_DRAIN = false;
    bf16_t* X; float* rowss;
    __device__ __forceinline__ void operator()(const f32x4 (&acc)[2][2][4][2], const Unit& u, int wr, int wc, int fr, int fq) const {
        const int row0 = u.pm * BM + wr * 64 + fr, col0 = u.pn * BM + wc * PG8_WCS + 8 * fq;
#pragma unroll
        for (int ai = 0; ai < 2; ++ai)
#pragma unroll
            for (int m = 0; m < 4; ++m) { const int row = row0 + ai * HALF + m * 16; bf16_t* xr = X + (size_t)row * D + col0; float sq = 0.f;
#pragma unroll
                for (int bj = 0; bj < 2; ++bj) { const u32x4 r = *(const u32x4*)(xr + bj * PG8_BJS); f32x4 x0 = acc[ai][bj][m][0], x1 = acc[ai][bj][m][1];
                    x0[0] += __uint_as_float(r.x << 16); x0[1] += __uint_as_float(r.x & 0xffff0000u); x0[2] += __uint_as_float(r.y << 16); x0[3] += __uint_as_float(r.y & 0xffff0000u);
                    x1[0] += __uint_as_float(r.z << 16); x1[1] += __uint_as_float(r.z & 0xffff0000u); x1[2] += __uint_as_float(r.w << 16); x1[3] += __uint_as_float(r.w & 0xffff0000u);
                    sq += (x0[0] * x0[0] + x0[1] * x0[1]) + (x0[2] * x0[2] + x0[3] * x0[3]) + (x1[0] * x1[0] + x1[1] * x1[1]) + (x1[2] * x1[2] + x1[3] * x1[3]);
                    u32x4 w; w.x = cvt_pk_bf16(x0[0], x0[1]); w.y = cvt_pk_bf16(x0[2], x0[3]); w.z = cvt_pk_bf16(x1[0], x1[1]); w.w = cvt_pk_bf16(x1[2], x1[3]);
                    *(u32x4*)(xr + bj * PG8_BJS) = w; }
                sq += __shfl_xor(sq, 16); sq += __shfl_xor(sq, 32);
                if (fq == 0) atomicAdd(rowss + row, sq); }
    }
};
struct EpiRelu2 {
    static constexpr bool PERM = true, AFTER_DRAIN = false;
    bf16_t* O; int ldc; bool nostore; const float* rowss;
    __device__ __forceinline__ void operator()(const f32x4 (&acc)[2][2][4][2], const Unit& u, int wr, int wc, int fr, int fq) const {
        const int row0 = u.pm * BM + wr * 64 + fr, col0 = u.pn * BM + wc * PG8_WCS + 8 * fq;
#pragma unroll
        for (int ai = 0; ai < 2; ++ai)
#pragma unroll
            for (int m = 0; m < 4; ++m) { bf16_t* rowp = O + (size_t)(row0 + ai * HALF + m * 16) * ldc + col0;
                const float rsc = rowss ? 1.0f / sqrtf(rowss[row0 + ai * HALF + m * 16] * (1.0f / D) + 1e-6f) : 1.0f;
#pragma unroll
                for (int bj = 0; bj < 2; ++bj) { f32x4 v0 = acc[ai][bj][m][0], v1 = acc[ai][bj][m][1];
#pragma unroll
                    for (int e = 0; e < 4; ++e) { const float a = fmaxf(v0[e] * rsc, 0.f), b = fmaxf(v1[e] * rsc, 0.f); v0[e] = a * a; v1[e] = b * b; }
                    u32x4 w; w.x = cvt_pk_bf16(v0[0], v0[1]); w.y = cvt_pk_bf16(v0[2], v0[3]); w.z = cvt_pk_bf16(v1[0], v1[1]); w.w = cvt_pk_bf16(v1[2], v1[3]);
                    if (!nostore) __builtin_nontemporal_store(w, (u32x4*)(rowp + bj * PG8_BJS));
                    else {
                        const int lane_ = fq * 16 + fr, wv_ = wr * 4 + wc, i_ = (ai * 4 + m) * 2 + bj;
                        *(u32x4*)(O + ((size_t)(u.pm * 8 + (u.pn & 7)) * 8 + wv_) * 8192 + i_ * 512 + lane_ * 8) = w; } } }
    }
};
template <class Epi, class Sched, bool ALIGN_EPI = false, bool SP2 = false>
__device__ __forceinline__ void gemm_phase(PG8_LAS unsigned char* lds, const Gemm g, const Sched& S, const Epi& E, int wid_in, int lane_in) {
    const int wid = wid_in, lane = lane_in, tid = wid_in * 64 + lane_in,     wr = wid >> 2, wc = wid & 3, fr = lane & 15, fq = lane >> 4;
    const int K = g.K, nt = K / BK;
    unsigned voffA[2], voffB[2];
#pragma unroll
    for (int i = 0; i < 2; ++i) { int R, C; stage_rc(tid * 16 + i * 8192, R, C); const int Rb = Epi::PERM ? ((R & ~31) + perm32(R & 31)) : R;
        voffA[i] = (unsigned)(R * K + C) * 2u; const int Rn = PG8_NREMAP ? 64 * (R >> 5) + (Rb & 31) : Rb;
        voffB[i] = (unsigned)(Rn * K + C) * 2u; }
    const size_t kstep = (size_t)(BK * 2);
    const size_t hstep = (size_t)HALF * K * 2;
    const size_t tstep = 2 * hstep;
    const size_t hstepB = PG8_NREMAP ? (size_t)32 * K * 2 : hstep;
    const unsigned ldsw = (unsigned)wid * 1024u;
    const int aoff = lds_byte(wr * 64 + fr, fq * 8), boff = lds_byte(wc * 32 + fr, fq * 8);
#define PG8_SA(b, h) (((b) * 2 + (h)) * HTB)
#define PG8_SB(b, h) ((4 + (b) * 2 + (h)) * HTB)
#define PG8_STAGE(bufoff, gbase, voff) do { _Pragma("unroll") for (int _i = 0; _i < 2; ++_i) \
        __builtin_amdgcn_global_load_lds((const unsigned*)((const char*)(gbase) + (voff)[_i]), (PG8_LAS unsigned*)(lds + (bufoff) + ldsw + _i * 8192), 16, 0, 0); } while (0)
#define PG8_LDA(dst, b, h) do { _Pragma("unroll") for (int m = 0; m < 4; ++m) _Pragma("unroll") for (int k = 0; k < 2; ++k) dst[m][k] = *(const PG8_LAS bf16x8*)(lds + PG8_SA(b, h) + aoff + m * 2048 + k * 1024); } while (0)
#define PG8_LDB(dst, b, h) do { _Pragma("unroll") for (int n = 0; n < 2; ++n) _Pragma("unroll") for (int k = 0; k < 2; ++k) dst[n][k] = *(const PG8_LAS bf16x8*)(lds + PG8_SB(b, h) + boff + n * 2048 + k * 1024); } while (0)
#define PG8_MMA(ai, bj, At, Bt) do { __builtin_amdgcn_s_setprio(1); _Pragma("unroll") for (int m = 0; m < 4; ++m) _Pragma("unroll") for (int n = 0; n < 2; ++n) _Pragma("unroll") for (int k = 0; k < 2; ++k) \
        acc[ai][bj][m][n] = __builtin_amdgcn_mfma_f32_16x16x32_bf16(Bt[n][k], At[m][k], acc[ai][bj][m][n], 0, 0, 0); __builtin_amdgcn_s_setprio(0); } while (0)
#define PG8_WAIT_V(n) asm volatile("s_waitcnt vmcnt(" #n ")" ::: "memory")
#define PG8_WAIT_L(n) asm volatile("s_waitcnt lgkmcnt(" #n ")" ::: "memory")
#define PG8_BAR __builtin_amdgcn_s_barrier()
#define PG8_SCHED __builtin_amdgcn_sched_barrier(0)
    Unit cur, nxt; int ui = 0;
    if (!S.next(0, cur)) return;
    f32x4 acc[2][2][4][2];
#pragma unroll
    for (int a = 0; a < 2; ++a)
#pragma unroll
        for (int b = 0; b < 2; ++b)
#pragma unroll
            for (int m = 0; m < 4; ++m)
#pragma unroll
                for (int n = 0; n < 2; ++n) acc[a][b][m][n] = (f32x4){0.f, 0.f, 0.f, 0.f};
    bf16x8 At[4][2], B0[2][2], B1[2][2];
    const char* cA = (const char*)g.A + (size_t)cur.pm * tstep; const char* cB = (const char*)g.Bt + (size_t)cur.pn * tstep;
    S.a_ready(cur);
    if constexpr (SP2) {
        PG8_STAGE(PG8_SB(0, 0), cB, voffB); PG8_STAGE(PG8_SB(0, 1), cB + hstepB, voffB); PG8_STAGE(PG8_SA(0, 0), cA, voffA); PG8_STAGE(PG8_SA(0, 1), cA + hstep, voffA);
        if (wr == 1) PG8_BAR;
        PG8_WAIT_V(2); PG8_BAR;
        PG8_STAGE(PG8_SB(1, 0), cB + kstep, voffB); PG8_STAGE(PG8_SA(1, 0), cA + kstep, voffA); PG8_STAGE(PG8_SB(1, 1), cB + hstepB + kstep, voffB);
        PG8_WAIT_V(6); PG8_BAR;
    } else {
        PG8_STAGE(PG8_SB(0, 0), cB, voffB); PG8_STAGE(PG8_SA(0, 0), cA, voffA); PG8_STAGE(PG8_SB(0, 1), cB + hstepB, voffB); PG8_STAGE(PG8_SA(0, 1), cA + hstep, voffA);
        if (wr == 1) PG8_BAR;
        PG8_WAIT_V(4); PG8_BAR;
        PG8_STAGE(PG8_SB(1, 0), cB + kstep, voffB); PG8_STAGE(PG8_SA(1, 0), cA + kstep, voffA); PG8_STAGE(PG8_SB(1, 1), cB + hstepB + kstep, voffB);
        PG8_WAIT_V(6); PG8_BAR;
    }
    for (;;) {
        const bool has_next = S.next(ui + 1, nxt);
        const char* nA = has_next ? (const char*)g.A + (size_t)nxt.pm * tstep : cA; const char* nB = has_next ? (const char*)g.Bt + (size_t)nxt.pn * tstep : cB;
        for (int t = 0; t < nt; t += 2) {
            const bool last = (t == nt - 2);
            const char* a1 = cA + (size_t)(t + 1) * kstep;
            const char* a2 = last ? nA : cA + (size_t)(t + 2) * kstep; const char* b2 = last ? nB : cB + (size_t)(t + 2) * kstep;
            const char* a3 = a2 + kstep; const char* b3 = b2 + kstep;
            if (last && has_next) S.a_ready(nxt);
            if constexpr (SP2) {
            PG8_LDB(B0, 0, 0); PG8_LDB(B1, 0, 1); PG8_SCHED; PG8_LDA(At, 0, 0); PG8_STAGE(PG8_SA(1, 1), a1 + hstep, voffA);
            PG8_WAIT_V(8); PG8_WAIT_L(0); PG8_BAR; PG8_MMA(0, 0, At, B0); PG8_MMA(0, 1, At, B1); PG8_BAR; PG8_SCHED;
            PG8_LDA(At, 0, 1); PG8_STAGE(PG8_SB(0, 0), b2, voffB); PG8_STAGE(PG8_SB(0, 1), b2 + hstepB, voffB); PG8_STAGE(PG8_SA(0, 0), a2, voffA);
            PG8_WAIT_V(8); PG8_WAIT_L(0); PG8_BAR; PG8_MMA(1, 0, At, B0); PG8_MMA(1, 1, At, B1); PG8_BAR; PG8_SCHED;
            PG8_LDB(B0, 1, 0); PG8_LDB(B1, 1, 1); PG8_SCHED; PG8_LDA(At, 1, 0); PG8_STAGE(PG8_SA(0, 1), a2 + hstep, voffA);
            PG8_WAIT_V(8); PG8_WAIT_L(0); PG8_BAR; PG8_MMA(0, 0, At, B0); PG8_MMA(0, 1, At, B1); PG8_BAR; PG8_SCHED;
            PG8_LDA(At, 1, 1); PG8_STAGE(PG8_SB(1, 0), b3, voffB); PG8_STAGE(PG8_SB(1, 1), b3 + hstepB, voffB); PG8_STAGE(PG8_SA(1, 0), a3, voffA);
            PG8_WAIT_V(8); PG8_WAIT_L(0); PG8_BAR; PG8_MMA(1, 0, At, B0); PG8_MMA(1, 1, At, B1); PG8_BAR; PG8_SCHED;
            } else {
            PG8_LDB(B0, 0, 0); PG8_SCHED; PG8_LDA(At, 0, 0); PG8_STAGE(PG8_SA(1, 1), a1 + hstep, voffA);
            PG8_WAIT_L(8); PG8_BAR; PG8_WAIT_L(0); PG8_MMA(0, 0, At, B0); PG8_BAR; PG8_SCHED;
            PG8_LDB(B1, 0, 1); PG8_STAGE(PG8_SB(0, 0), b2, voffB);
            PG8_BAR; PG8_WAIT_L(0); PG8_MMA(0, 1, At, B1); PG8_BAR;
            PG8_LDA(At, 0, 1); PG8_STAGE(PG8_SA(0, 0), a2, voffA);
            PG8_BAR; PG8_WAIT_L(0); PG8_MMA(1, 0, At, B0); PG8_BAR; PG8_SCHED;
            PG8_STAGE(PG8_SB(0, 1), b2 + hstepB, voffB);
            PG8_WAIT_V(6); PG8_BAR; PG8_MMA(1, 1, At, B1); PG8_BAR;
            PG8_LDB(B0, 1, 0); PG8_SCHED; PG8_LDA(At, 1, 0); PG8_STAGE(PG8_SA(0, 1), a2 + hstep, voffA);
            PG8_WAIT_L(8); PG8_BAR; PG8_WAIT_L(0); PG8_MMA(0, 0, At, B0); PG8_BAR; PG8_SCHED;
            PG8_LDB(B1, 1, 1); PG8_STAGE(PG8_SB(1, 0), b3, voffB);
            PG8_BAR; PG8_WAIT_L(0); PG8_MMA(0, 1, At, B1); PG8_BAR;
            PG8_LDA(At, 1, 1); PG8_STAGE(PG8_SA(1, 0), a3, voffA);
            PG8_BAR; PG8_WAIT_L(0); PG8_MMA(1, 0, At, B0); PG8_BAR; PG8_SCHED;
            PG8_STAGE(PG8_SB(1, 1), b3 + hstepB, voffB);
            PG8_WAIT_V(6); PG8_BAR; PG8_MMA(1, 1, At, B1); PG8_BAR;
            }
        }
        if constexpr (ALIGN_EPI) { if (wr == 0) PG8_BAR; }
        if constexpr (!Epi::AFTER_DRAIN) { E(acc, cur, wr, wc, fr, fq); S.done(cur); }
        if (!has_next) break;
#pragma unroll
        for (int a = 0; a < 2; ++a)
#pragma unroll
            for (int b = 0; b < 2; ++b)
#pragma unroll
                for (int m = 0; m < 4; ++m)
#pragma unroll
                    for (int n = 0; n < 2; ++n) acc[a][b][m][n] = (f32x4){0.f, 0.f, 0.f, 0.f};
        cur = nxt; cA = nA; cB = nB; ++ui;
        if constexpr (ALIGN_EPI) { if (wr == 1) PG8_BAR; }
    }
    PG8_WAIT_V(0);
    if constexpr (!ALIGN_EPI) { if (wr == 0) PG8_BAR; }
    PG8_BAR;
    if constexpr (Epi::AFTER_DRAIN) { E.fused(acc, cur, wr, wc, fr, fq, lds, wid, lane); S.done(cur); }
#undef PG8_SA
#undef PG8_SB
#undef PG8_STAGE
#undef PG8_LDA
#undef PG8_LDB
#undef PG8_MMA
#undef PG8_WAIT_V
#undef PG8_WAIT_L
#undef PG8_BAR
#undef PG8_SCHED
}
}
#ifndef PG8_SP2
#define PG8_SP2 true
#endif
#ifndef PG8_ALIGN
#define PG8_ALIGN true
#endif
constexpr int NWAVES = 8;
#ifndef MK_N_LAUNCHES
#define MK_N_LAUNCHES 1
#endif
constexpr int N_PHASES = 15;
constexpr bool ONE_LAUNCH = (MK_N_LAUNCHES == 1);

constexpr size_t MiB = 1u << 20;
constexpr size_t WS_CTL = 0, CTL_ZERO_BYTES = 1 * MiB;
constexpr size_t WS_W = 2 * MiB;
constexpr size_t W_LAYER = 96 * MiB, W_QKV = 0, W_O = 24 * MiB, W_UP = 32 * MiB, W_DN = 64 * MiB;
constexpr size_t WS_XN = 194 * MiB;
constexpr size_t WS_CK = 323 * MiB, WS_CV = 387 * MiB;
constexpr size_t WS_Q = 451 * MiB, WS_K = 580 * MiB, WS_V = 709 * MiB;
constexpr size_t WS_H = WS_Q;
constexpr size_t WS_CK1 = 967 * MiB, WS_CV1 = 1031 * MiB;
constexpr size_t WS_END = 1095 * MiB;
static_assert(WS_H + (size_t)M * FF * 2 <= WS_CK1 && WS_V + (size_t)M * D * 2 <= WS_END && WS_XN + (size_t)M * D * 2 <= WS_CK && WS_W + 2 * W_LAYER <= WS_XN, "d_ws map");
static_assert(QKV_WS_Q == WS_Q && WS_K == WS_Q + QKV_WS_STRIDE && WS_V == WS_Q + 2 * QKV_WS_STRIDE, "QKV epilogue map");
constexpr int CW_TMO = 0;
constexpr int CW_KN = 1024;
constexpr int CW_QH = 2048;
constexpr int CW_RSS = 65536;
constexpr int CW_BAR = 4096;
static_assert((size_t)(CW_RSS + 5 * MV) * 4 <= CTL_ZERO_BYTES, "CTL map");

constexpr size_t OUT_Y = 0, OUT_KP = (size_t)MV * D, OUT_VP = OUT_KP + 2 * (size_t)MP * D, OUT_KS = OUT_VP + 2 * (size_t)MP * D, OUT_VS = OUT_KS + 2 * (size_t)MS * D, OUT_END = OUT_VS + 2 * (size_t)MS * D;
static_assert(OUT_KP == QKV_OUT_KP && OUT_VP == QKV_OUT_VP && OUT_KS == QKV_OUT_KS && OUT_VS == QKV_OUT_VS, "QKV epilogue map");

constexpr int RING_OFF = 0, RING_BYTES = 131072;
constexpr int LDS_BYTES = 163840;
constexpr int LDSCTL_OFF = LDS_BYTES - 512;
static_assert(RING_BYTES <= LDSCTL_OFF, "LDS map");

#define GAS __attribute__((address_space(1)))
#define LAS __attribute__((address_space(3)))
typedef unsigned short bf16;
typedef unsigned v4u __attribute__((ext_vector_type(4)));
typedef unsigned v2u __attribute__((ext_vector_type(2)));
typedef float f32x4 __attribute__((ext_vector_type(4)));
typedef GAS unsigned gu32;
#define RLX_AGENT __ATOMIC_RELAXED, __HIP_MEMORY_SCOPE_AGENT
#define LDS_WAIT() asm volatile("s_waitcnt lgkmcnt(0)" ::: "memory")
#define VM_WAIT() asm volatile("s_waitcnt vmcnt(0)" ::: "memory")
typedef float f32x2_t __attribute__((ext_vector_type(2))); typedef __bf16 bf16x2_t __attribute__((ext_vector_type(2)));
__device__ __forceinline__ unsigned pk2(float lo, float hi) { f32x2_t v = {lo, hi}; bf16x2_t b = __builtin_convertvector(v, bf16x2_t); return __builtin_bit_cast(unsigned, b); }
__device__ __forceinline__ float wave_sum(float v) {
#pragma unroll
    for (int o = 1; o < 64; o <<= 1) v += __shfl_xor(v, o);
    return v;
}
#define XB_TMO      128
#define XB_XCNT(j)  (256  + 64 * (j))
#define XB_XSUB(j)  (1280 + 64 * (j))
#define XB_XGEN(j)  (2304 + 64 * (j))
#define XB_TOP      3328
#define XB_TOPGEN   3392
#define XCD_BAR_WORDS 3456
#define XB_SPIN_CAP (1u << 18)

__device__ __forceinline__ unsigned xb_ld(unsigned* p)              { return __hip_atomic_load(p, __ATOMIC_RELAXED, __HIP_MEMORY_SCOPE_AGENT); }
__device__ __forceinline__ unsigned xb_add(unsigned* p, unsigned v) { return __hip_atomic_fetch_add(p, v, __ATOMIC_RELAXED, __HIP_MEMORY_SCOPE_AGENT); }
__device__ __forceinline__ unsigned xb_xcc_id() { return (unsigned)__builtin_amdgcn_s_getreg((3 << 11) | 20) & 0xFu; }
#define XB_SPIN(cond, bar) do { unsigned _sp = 0; while (cond) { __builtin_amdgcn_s_sleep(1); \
    if ((++_sp & 255u) == 0u) { if (xb_ld(&(bar)[XB_TMO])) break; if (_sp > XB_SPIN_CAP) { atomicAdd(&(bar)[XB_TMO], 1u); break; } } } } while (0)

struct XcdBarrier {
    unsigned* bar; unsigned x; int wave;
    volatile LAS unsigned* st;
};

__device__ __forceinline__ bool xb_thread0(int wave) { return wave == 0 && __builtin_amdgcn_mbcnt_hi(~0u, __builtin_amdgcn_mbcnt_lo(~0u, 0u)) == 0u; }
__device__ __forceinline__ XcdBarrier xcd_barrier_post(unsigned* bar, volatile LAS unsigned* st, int wave) {
    XcdBarrier b; b.bar = bar; b.x = xb_xcc_id(); b.st = st; b.wave = wave;
    if (xb_thread0(wave)) (void)xb_add(&bar[XB_XCNT(b.x)], 1u);
    return b;
}
__device__ __forceinline__ void xcd_barrier_complete(unsigned* bar, unsigned x, unsigned& nloc, unsigned& nx) {
    const unsigned G = gridDim.x * gridDim.y * gridDim.z;
    unsigned sum, cnt, mine, sp = 0u;
    for (;;) {
        sum = 0u; cnt = 0u; mine = 0u;
#pragma unroll
        for (unsigned j = 0; j < 16; ++j) { const unsigned c = xb_ld(&bar[XB_XCNT(j)]); sum += c; cnt += (c > 0u) ? 1u : 0u; mine = (j == x) ? c : mine; }
        if (sum == G) break;
        __builtin_amdgcn_s_sleep(1);
        if ((++sp & 255u) == 0u) { if (xb_ld(&bar[XB_TMO])) break; if (sp > XB_SPIN_CAP) { atomicAdd(&bar[XB_TMO], 1u); break; } }
    }
    nloc = mine > 0u ? mine : 1u; nx = cnt > 0u ? cnt : 1u;
}

__device__ __forceinline__ void xcd_barrier(const XcdBarrier& b) {
    asm volatile("s_waitcnt vmcnt(0)" ::: "memory");
    __syncthreads();
    if (xb_thread0(b.wave)) {
        unsigned* bar = b.bar;
        __builtin_amdgcn_s_waitcnt(0);
        unsigned nloc = b.st[0], nx = b.st[1];
        if (nloc == 0u) { xcd_barrier_complete(bar, b.x, nloc, nx); b.st[0] = nloc; b.st[1] = nx; }
        const unsigned old = xb_add(&bar[XB_XSUB(b.x)], 1u);
        const unsigned gen = old / nloc;
        if (old + 1u == (gen + 1u) * nloc) {
            __builtin_amdgcn_fence(__ATOMIC_RELEASE, "agent");
            asm volatile("s_waitcnt vmcnt(0)" ::: "memory");
            const unsigned og = xb_add(&bar[XB_TOP], 1u);
            const unsigned tg = og / nx;
            if (og + 1u == (tg + 1u) * nx) xb_add(&bar[XB_TOPGEN], 1u);
            else XB_SPIN(xb_ld(&bar[XB_TOPGEN]) == tg, bar);
            __builtin_amdgcn_fence(__ATOMIC_ACQUIRE, "agent");
            xb_add(&bar[XB_XGEN(b.x)], 1u);
            asm volatile("s_waitcnt vmcnt(0)" ::: "memory");
        } else {
            XB_SPIN(xb_ld(&bar[XB_XGEN(b.x)]) == gen, bar);
            __builtin_amdgcn_fence(__ATOMIC_ACQUIRE, "agent");
            asm volatile("s_waitcnt vmcnt(0)" ::: "memory");
        }
    }
    __syncthreads();
}
namespace att {
typedef short bf16x8 __attribute__((ext_vector_type(8)));
typedef short s16x4 __attribute__((ext_vector_type(4)));
typedef short v4i16_t __attribute__((ext_vector_type(4)));
typedef float f32x16 __attribute__((ext_vector_type(16)));
typedef LAS unsigned char* lptr;
constexpr float LOG2E = 1.4426950408889634f;
constexpr float QSCALE = 0.08838834764831845f * 1.4426950408889634f;
constexpr float GSCALE = 1.0f - 0.35550906759096926f;
constexpr float DF_THR = 0.0f;
#ifndef SB_EAGER_TILES
#define SB_EAGER_TILES 8
#endif
constexpr int SB_EAGER_LO = 32 - SB_EAGER_TILES;
constexpr float SB_DONE = -150.0f;

__device__ __forceinline__ s16x4 vtr(const LAS unsigned char* p) { return __builtin_bit_cast(s16x4, __builtin_amdgcn_ds_read_tr16_b64_v4i16((LAS v4i16_t*)p)); }
__device__ __forceinline__ float swap_lo(float x, float& other_hi) { auto rr = __builtin_amdgcn_permlane32_swap(__float_as_uint(x), __float_as_uint(x), false, false); other_hi = __uint_as_float(rr[1]); return __uint_as_float(rr[0]); }

template <int KW, int VW, int TK> struct KVStage {
    static constexpr int KBYTES = TK * KW * 2, VBYTES = TK * VW * 2, BUF = KBYTES + VBYTES, NK = KBYTES / 8192, NV = VBYTES / 8192, VDB = TK * 64  ;
    unsigned voffK[NK], voffV[NV];
    __device__ __forceinline__ void init(int wid, int lane) {
#pragma unroll
        for (int j = 0; j < NK; ++j) { const int pos = (wid * NK + j) * 64 + lane; int row, c16;
            if (KW == 128) { row = pos >> 4; c16 = (pos & 15) ^ (row & 15); } else { row = pos >> 5; c16 = ((pos >> 4) & 1) * 16 + ((pos & 15) ^ (row & 15)); }
            voffK[j] = (unsigned)(row * D + c16 * 8) * 2u; }
#pragma unroll
        for (int j = 0; j < NV; ++j) { const int pos = (wid * NV + j) * 64 + lane; const int dblk = pos / (TK * 4), row = (pos >> 2) % TK, sub = pos & 3;
            voffV[j] = (unsigned)(row * D + (dblk * 4 + sub) * 8) * 2u; }
    }
    __device__ static __forceinline__ void glds16(const void* gsrc, unsigned lds_dst) { unsigned keep;
        asm volatile("s_mov_b32 %0, m0\n\ts_mov_b32 m0, %2\n\ts_nop 0\n\tglobal_load_lds_dwordx4 %1, off\n\ts_mov_b32 m0, %0" : "=&s"(keep) : "v"(gsrc), "s"(lds_dst) : "memory"); }
    __device__ __forceinline__ void issue2(lptr kbuf, lptr vbuf, const bf16* kp, const bf16* vp, int wid) const {
        const unsigned kd = (unsigned)(uintptr_t)kbuf, vd = (unsigned)(uintptr_t)vbuf;
#pragma unroll
        for (int j = 0; j < NK; ++j) glds16((const char*)kp + voffK[j], (unsigned)__builtin_amdgcn_readfirstlane((int)(kd + (wid * NK + j) * 1024)));
#pragma unroll
        for (int j = 0; j < NV; ++j) glds16((const char*)vp + voffV[j], (unsigned)__builtin_amdgcn_readfirstlane((int)(vd + (wid * NV + j) * 1024)));
    }
    __device__ __forceinline__ void issue(lptr buf, const bf16* kp, const bf16* vp, int wid) const { issue2(buf, buf + KBYTES, kp, vp, wid); }
};

template <int KPITCH> __device__ __forceinline__ void qkt1(f32x16& p, const LAS unsigned char* Kb, int mp, const bf16x8* qr, int r32, int hi) {
    const int xk = (r32 & 15) << 4; const LAS unsigned char* k0 = Kb + r32 * KPITCH + mp * 256;
#pragma unroll
    for (int ks = 0; ks < 8; ++ks) { const int cb = (ks * 32 + hi * 16) ^ xk;
        const bf16x8 a0 = *(const LAS bf16x8*)(k0 + cb);
        p = __builtin_amdgcn_mfma_f32_32x32x16_bf16(a0, qr[ks], p, 0, 0, 0); }
}
template <int NDB, int NS, int VDB> __device__ __forceinline__ void pv(f32x16* o, const LAS unsigned char* Vb, int lane, const bf16x8* pf) {
    const LAS unsigned char* vb = Vb + (4 * (lane >> 5) + ((lane & 15) >> 2)) * 64 + ((lane >> 4) & 1) * 32 + (lane & 3) * 8;
    constexpr int N = NDB * NS, AH = 2;
    s16x4 lo[AH + 1], hi4[AH + 1];
#pragma unroll
    for (int k = 0; k < AH && k < N; ++k) { lo[k] = vtr(vb + (k / NS) * VDB + (k % NS) * 1024); hi4[k] = vtr(vb + (k / NS) * VDB + (k % NS) * 1024 + 512); }
    __builtin_amdgcn_s_setprio(1);
#pragma unroll
    for (int k = 0; k < N; ++k) { const int db = k / NS, s = k % NS;
        if (k + AH < N) { const int db1 = (k + AH) / NS, s1 = (k + AH) % NS; lo[(k + AH) % (AH + 1)] = vtr(vb + db1 * VDB + s1 * 1024); hi4[(k + AH) % (AH + 1)] = vtr(vb + db1 * VDB + s1 * 1024 + 512); }
        const s16x4 l_ = lo[k % (AH + 1)], h_ = hi4[k % (AH + 1)];
        const bf16x8 vf = (bf16x8){l_[0], l_[1], l_[2], l_[3], h_[0], h_[1], h_[2], h_[3]};
        o[db] = __builtin_amdgcn_mfma_f32_32x32x16_bf16(vf, pf[s], o[db], 0, 0, 0); }
    __builtin_amdgcn_s_setprio(0);
    __builtin_amdgcn_sched_group_barrier(0x100, 2 * AH, 0);
#pragma unroll
    for (int k = 0; k < N; ++k) { if (k + AH < N) __builtin_amdgcn_sched_group_barrier(0x100, 2, 0); __builtin_amdgcn_sched_group_barrier(0x8, 1, 0); }
}
__device__ __forceinline__ void pack_p(bf16x8* pf, const f32x16& p) {
#pragma unroll
    for (int s = 0; s < 2; ++s) { v4u a;
        a.x = pk2(p[8 * s + 0], p[8 * s + 1]); a.y = pk2(p[8 * s + 2], p[8 * s + 3]); a.z = pk2(p[8 * s + 4], p[8 * s + 5]); a.w = pk2(p[8 * s + 6], p[8 * s + 7]);
        pf[s] = __builtin_bit_cast(bf16x8, a); }
}

template <bool SAMPLE>
__device__ __forceinline__ void sb_unit(lptr ring, volatile LAS int* flags, const bf16* Qb, const bf16* Kb, const bf16* Vb, bf16* CK, bf16* CV, const float* ck32, const float* cv32, bf16* Ob,
                                        int b, int h, int qb, int wid, int lane) {
    KVStage<128, 128, 64> st; st.init(wid, lane);
    constexpr int BUF = KVStage<128, 128, 64>::BUF, KBYTES = KVStage<128, 128, 64>::KBYTES;
    const int r32 = lane & 31, hi = lane >> 5;
    const int qbase = SAMPLE ? PAST : 256 * qb + 32 * wid;
    const int qpos = qbase + r32;
    const size_t qrow = SAMPLE ? (size_t)(MP + 16 * b + r32) : (size_t)b * SEQ + qpos;
    const bool live = SAMPLE ? (wid == 0) : true;
    const bool rvalid = SAMPLE ? (wid == 0 && r32 < 16) : true;
    const int jt_hi = SAMPLE ? 32 : 4 * qb + 3;
    const int coff = h * 128;
    bf16x8 qr[8];
#pragma unroll
    for (int ks = 0; ks < 8; ++ks) qr[ks] = *(const bf16x8*)(Qb + qrow * D + coff + ks * 16 + hi * 8);
    f32x16 o[4];
#pragma unroll
    for (int i = 0; i < 4; ++i) o[i] = f32x16{};
    float C = 0.f;
#define SB_TILE_PTRS(jt_, kp_, vp_) do { size_t off_; \
        if (!SAMPLE) { off_ = ((size_t)b * SEQ + 64 * (size_t)(jt_)) * D + coff; kp_ = Kb + off_; vp_ = Vb + off_; } \
        else if ((jt_) == 32) { off_ = (size_t)(MP + 16 * b) * D + coff; kp_ = Kb + off_; vp_ = Vb + off_; } \
        else { off_ = ((size_t)b * PAST + 64 * (size_t)(jt_)) * D + coff; kp_ = CK + off_; vp_ = CV + off_; } } while (0)
    int jt = jt_hi, it = 0;
    { const bf16 *kp, *vp; SB_TILE_PTRS(jt, kp, vp); st.issue(ring, kp, vp, wid); }
    VM_WAIT(); __syncthreads();
    bool wdone = !live;
    for (;;) {
        const lptr cur = ring + (it & 1) * BUF, nxt = ring + ((it & 1) ^ 1) * BUF;
        const bool has_next = jt > 0;
        if (SAMPLE && has_next && jt - 1 < SB_EAGER_LO) {
            const int tid_ = wid * 64 + lane, row_ = tid_ >> 3, c0_ = (tid_ & 7) * 16; const size_t o_ = ((size_t)b * PAST + 64 * (size_t)(jt - 1) + row_) * D + coff + c0_;
#pragma unroll
            for (int t_ = 0; t_ < 2; ++t_) { const float* s_ = (t_ ? cv32 : ck32) + o_; bf16* d_ = (t_ ? CV : CK) + o_;
                const f32x4 x0 = ((const f32x4*)s_)[0], x1 = ((const f32x4*)s_)[1], x2 = ((const f32x4*)s_)[2], x3 = ((const f32x4*)s_)[3];
                v4u w0, w1; w0.x = pk2(x0.x, x0.y); w0.y = pk2(x0.z, x0.w); w0.z = pk2(x1.x, x1.y); w0.w = pk2(x1.z, x1.w); w1.x = pk2(x2.x, x2.y); w1.y = pk2(x2.z, x2.w); w1.z = pk2(x3.x, x3.y); w1.w = pk2(x3.z, x3.w);
                ((v4u*)d_)[0] = w0; ((v4u*)d_)[1] = w1; }
            VM_WAIT(); __syncthreads(); }
        if (has_next) { const bf16 *kp, *vp; SB_TILE_PTRS(jt - 1, kp, vp); st.issue(nxt, kp, vp, wid); }
        const int kmin = 64 * jt;
        if (!wdone && kmin < qbase + 31) {
            f32x16 p0 = f32x16{}, p1 = f32x16{};
            qkt1<256>(p0, cur, 0, qr, r32, hi); qkt1<256>(p1, cur + 32 * 256, 0, qr, r32, hi);
            f32x16 L0, L1;
#pragma unroll
            for (int r = 0; r < 16; ++r) {
                const float z0 = p0[r], z1 = p1[r];
                L0[r] = -(fmaxf(z0, 0.f) + __builtin_amdgcn_logf(1.0f + __builtin_amdgcn_exp2f(-fabsf(z0))));
                L1[r] = -(fmaxf(z1, 0.f) + __builtin_amdgcn_logf(1.0f + __builtin_amdgcn_exp2f(-fabsf(z1)))); }
            const bool need_mask = (kmin + 63 >= qbase);
            if (need_mask) {
                const float df = (float)(qpos - kmin - 4 * hi);
#pragma unroll
                for (int r = 0; r < 16; ++r) { const float c = (float)((r & 3) + 8 * (r >> 2));
                    const float f0 = __builtin_amdgcn_fmed3f(df - c, 0.f, 1.f), f1 = __builtin_amdgcn_fmed3f(df - (c + 32.f), 0.f, 1.f);
                    L0[r] *= f0; p0[r] += f0 * 1e30f - 1e30f; L1[r] *= f1; p1[r] += f1 * 1e30f - 1e30f; } }
            float T[8];
#pragma unroll
            for (int g = 0; g < 4; ++g) {
                L0[4 * g + 2] += L0[4 * g + 3]; L0[4 * g + 1] += L0[4 * g + 2]; L0[4 * g] += L0[4 * g + 1]; T[g] = L0[4 * g];
                L1[4 * g + 2] += L1[4 * g + 3]; L1[4 * g + 1] += L1[4 * g + 2]; L1[4 * g] += L1[4 * g + 1]; T[4 + g] = L1[4 * g]; }
            float off[8]; float run = 0.f;
#pragma unroll
            for (int g = 7; g >= 0; --g) { float t1; const float t0 = swap_lo(T[g], t1); off[g] = C + run + (hi == 0 ? t1 : 0.f); run += t0 + t1; }
#pragma unroll
            for (int g = 0; g < 4; ++g)
#pragma unroll
                for (int i = 0; i < 4; ++i) { const int r = 4 * g + i;
                    p0[r] = __builtin_amdgcn_exp2f(p0[r] + L0[r] + off[g]);
                    p1[r] = __builtin_amdgcn_exp2f(p1[r] + L1[r] + off[4 + g]); }
            C += run;
            bf16x8 pf[4]; pack_p(pf, p0); pack_p(pf + 2, p1);
            pv<4, 4, 4096>(o, cur + KBYTES, lane, pf);
            wdone = __all((!rvalid) || (C < SB_DONE));
        }
        if (lane == 0) flags[(it & 1) * 8 + wid] = wdone ? 1 : 0;
        VM_WAIT(); LDS_WAIT(); __syncthreads();
        if (!has_next) break;
        int all = 1;
#pragma unroll
        for (int w = 0; w < 8; ++w) all &= flags[(it & 1) * 8 + w];
        if (all) break;
        --jt; ++it;
    }
#undef SB_TILE_PTRS
    if (rvalid) {
#pragma unroll
        for (int db = 0; db < 4; ++db)
#pragma unroll
            for (int gq = 0; gq < 4; ++gq) { v2u w; w.x = pk2(o[db][4 * gq], o[db][4 * gq + 1]); w.y = pk2(o[db][4 * gq + 2], o[db][4 * gq + 3]);
                *(v2u*)(Ob + qrow * D + coff + 32 * db + 8 * gq + 4 * hi) = w; }
    }
}

constexpr int XSTEPS = 16;
__device__ __forceinline__ size_t xstep_off(int s, int wid, int lane) { return (size_t)(16 * wid + 2 * (s >> 1)) * D + lane * 4; }
__device__ __forceinline__ void xstep_store(float* dst, const v4u w) {
    __builtin_nontemporal_store((f32x4){__uint_as_float(w.x << 16), __uint_as_float(w.x & 0xffff0000u), __uint_as_float(w.y << 16), __uint_as_float(w.y & 0xffff0000u)}, (f32x4*)dst);
    __builtin_nontemporal_store((f32x4){__uint_as_float(w.z << 16), __uint_as_float(w.z & 0xffff0000u), __uint_as_float(w.w << 16), __uint_as_float(w.w & 0xffff0000u)}, (f32x4*)(dst + D));
}
__device__ __forceinline__ v4u xstep_load(const bf16* src) { const v2u a = *(const v2u*)src, b = *(const v2u*)(src + D); return (v4u){a.x, a.y, b.x, b.y}; }

template <bool SAMPLE, int VAR = 0>
__device__ __forceinline__ void diff_unit(lptr ring, const float* gtab  , volatile LAS float* qn, const float* kn, const bf16* Qb, const bf16* Kb, const bf16* Vb, const bf16* CK, const bf16* CV, bf16* Ob,
                                          float* kout, float* vout  , int b, int h8, int qb, float lam, int wid, int lane) {
    asm volatile("" : "+v"(lane));
    KVStage<256, 256, 32> st; st.init(wid, lane);
    constexpr int VDB = KVStage<256, 256, 32>::VDB;
    const int r32 = lane & 31, hi = lane >> 5, mp = wid >> 2, sb = wid & 3;
    const int qbase = SAMPLE ? PAST : 128 * qb + 32 * sb;
    const int qpos = qbase + r32;
    const size_t qrow = SAMPLE ? (size_t)(MP + 16 * b + r32) : (size_t)b * SEQ + qpos;
    const bool live = SAMPLE ? (sb == 0) : true;
    const bool rvalid = SAMPLE ? (sb == 0 && r32 < 16) : true;
    const int wchunk = SAMPLE ? 32 : (qbase >> 6);
    const int jt_hi = SAMPLE ? 64 : 4 * qb + 3;
    const int coff = h8 * 256;
    constexpr bool XP = EXPAND_L1 && !SAMPLE;
    const float slope2 = __builtin_amdgcn_exp2f(-(float)(h8 + 1)) * LOG2E;
    const int xk = (r32 & 15) << 4;
    const lptr qs = ring + 98304 + wid * 8192 + lane * 16;
    float q2 = 0.f;
#pragma unroll
    for (int ks = 0; ks < 8; ++ks) { const bf16x8 qf = *(const bf16x8*)(Qb + qrow * D + coff + mp * 128 + ks * 16 + hi * 8); *(LAS bf16x8*)(qs + ks * 1024) = qf;
        if (!SAMPLE) {
#pragma unroll
            for (int e = 0; e < 8; ++e) { const float x = __uint_as_float((unsigned)(unsigned short)qf[e] << 16); q2 = fmaf(x, x, q2); } } }
    if (!SAMPLE) {
        { float t1; const float t0 = swap_lo(q2, t1); q2 = t0 + t1; }
        q2 = fmaxf(q2, __shfl_xor(q2, 1)); q2 = fmaxf(q2, __shfl_xor(q2, 2)); q2 = fmaxf(q2, __shfl_xor(q2, 4)); q2 = fmaxf(q2, __shfl_xor(q2, 8)); q2 = fmaxf(q2, __shfl_xor(q2, 16));
        if (lane == 0) qn[wid] = q2; }
    f32x16 o[8];
#pragma unroll
    for (int i = 0; i < 8; ++i) o[i] = f32x16{};
    float m = 0.f, l = 0.f;
#define DF_TILE_PTRS(jt_, kp_, vp_) do { size_t off_; \
        if (!SAMPLE) { off_ = ((size_t)b * SEQ + 32 * (size_t)(jt_)) * D + coff; kp_ = Kb + off_; vp_ = Vb + off_; } \
        else if ((jt_) == 64) { off_ = (size_t)(MP + 16 * b) * D + coff; kp_ = Kb + off_; vp_ = Vb + off_; } \
        else { off_ = ((size_t)b * PAST + 32 * (size_t)(jt_)) * D + coff; kp_ = CK + off_; vp_ = CV + off_; } } while (0)
    { const bf16 *kp, *vp; DF_TILE_PTRS(jt_hi, kp, vp); st.issue(ring, kp, vp, wid); }
    VM_WAIT(); LDS_WAIT(); __syncthreads();
    int jt_lo = 0;
    if (!SAMPLE) {
        const float* knb = kn + (b * 16 + 2 * h8) * 4;
        const float k0s = (knb[0] + knb[1]) + (knb[2] + knb[3]), k1s = (knb[4] + knb[5]) + (knb[6] + knb[7]);
        const float q0m = fmaxf(fmaxf(qn[0], qn[1]), fmaxf(qn[2], qn[3])), q1m = fmaxf(fmaxf(qn[4], qn[5]), fmaxf(qn[6], qn[7]));
        const float Z = 1.02f * sqrtf(fmaxf(q0m * k0s, q1m * k1s));
        const float nneed = (154.f + 2.f * Z) / slope2;
        const float lo = floorf(((float)(128 * qb) - nneed) * (1.0f / 32.0f));
        jt_lo = lo > 0.f ? (int)lo : 0;
        jt_lo = __builtin_amdgcn_readfirstlane(jt_lo);
    }
#define DF_ISSUE(i_, bf_) do { const bf16 *kp_, *vp_; DF_TILE_PTRS(jt_hi - (i_), kp_, vp_); st.issue(ring + (bf_) * 32768, kp_, vp_, wid); } while (0)
    unsigned a0s[16];
#pragma unroll
    for (int r = 0; r < 16; ++r) { const int c = (r & 3) + 8 * (r >> 2); const float kc = (float)c * LOG2E;
        a0s[r] = c == 0 ? 0u : (unsigned)__builtin_amdgcn_readfirstlane((int)(__float_as_uint(kc) - ((unsigned)(h8 + 1) << 23))); }
    const int n = jt_hi - jt_lo + 1;
    const size_t xbase = ((size_t)b * SEQ + 128 * (size_t)qb) * D + coff;
    v4u xq = {0u, 0u, 0u, 0u};
#define XP_LOAD(ptr_) asm volatile("global_load_dwordx2 v[252:253], %0, off\n\tglobal_load_dwordx2 v[254:255], %1, off" :: "v"(ptr_), "v"((ptr_) + D) : "memory", "v252", "v253", "v254", "v255")
#define XP_READ(x_) asm volatile("v_mov_b32 %0, v252\n\tv_mov_b32 %1, v253\n\tv_mov_b32 %2, v254\n\tv_mov_b32 %3, v255" : "=v"(x_.x), "=v"(x_.y), "=v"(x_.z), "=v"(x_.w) :: "memory")
    if (XP) XP_LOAD(Kb + xbase + xstep_off(0, wid, lane));
    if (n > 1) DF_ISSUE(1, 1);
#define DF_QK(i_, bf_, P, MREF) do { const int jt_ = jt_hi - (i_); \
        if (live && (jt_ >> 1) <= wchunk) { \
            if ((jt_ >> 1) == wchunk) { P = f32x16{}; MREF = 0.f; } \
            else { const float e_ = slope2 * (float)(32 * jt_ + 4 * hi - qpos) - m; MREF = m; \
                _Pragma("unroll") for (int r = 0; r < 16; ++r) P[r] = e_ + __uint_as_float(a0s[r]); } \
            const LAS unsigned char* k0_ = ring + (bf_) * 32768 + r32 * 512 + mp * 256; \
            bf16x8 kf_[2], qf_[2]; kf_[0] = *(const LAS bf16x8*)(k0_ + ((hi * 16) ^ xk)); qf_[0] = *(const LAS bf16x8*)(qs); \
            _Pragma("unroll") for (int ks = 0; ks < 8; ++ks) { \
                if (ks < 7) { kf_[(ks + 1) & 1] = *(const LAS bf16x8*)(k0_ + (((ks + 1) * 32 + hi * 16) ^ xk)); qf_[(ks + 1) & 1] = *(const LAS bf16x8*)(qs + (ks + 1) * 1024); } \
                P = __builtin_amdgcn_mfma_f32_32x32x16_bf16(kf_[ks & 1], qf_[ks & 1], P, 0, 0, 0); } \
            __builtin_amdgcn_sched_group_barrier(0x100, 2, 0); \
            _Pragma("unroll") for (int ks = 0; ks < 8; ++ks) { if (ks < 7) __builtin_amdgcn_sched_group_barrier(0x100, 2, 0); __builtin_amdgcn_sched_group_barrier(0x8, 1, 0); } } } while (0)
    m = 0.f;
    f32x16 pN = f32x16{}; float mrefN = 0.f;
    DF_QK(0, 0, pN, mrefN);
    int bf = 0;
    for (int i = 0; i < n; ++i) {
        const int jt = jt_hi - i;
        const int bf1 = bf == 2 ? 0 : bf + 1, bf2 = bf1 == 2 ? 0 : bf1 + 1;
        if (XP && i >= 1 && i <= XSTEPS) asm volatile("s_waitcnt vmcnt(2)" ::: "memory"); else asm volatile("s_waitcnt vmcnt(0)" ::: "memory");
        asm volatile("s_waitcnt lgkmcnt(0)" ::: "memory"); __builtin_amdgcn_s_barrier(); asm volatile("" ::: "memory");
        if (XP && i < XSTEPS) XP_READ(xq);
        if (XP && i + 1 < XSTEPS) XP_LOAD((((i + 1) & 1) ? Vb : Kb) + xbase + xstep_off(i + 1, wid, lane));
        if (i + 2 < n && VAR != 2) DF_ISSUE(i + 2, bf2);
        if (XP && i < XSTEPS) xstep_store(((i & 1) ? vout : kout) + xbase + xstep_off(i, wid, lane), xq);
        f32x16 p = pN; float mref = mrefN;
        if (i + 1 < n) DF_QK(i + 1, bf1, pN, mrefN);
        if (live && (jt >> 1) <= wchunk && VAR != 3) {
            const lptr cur = ring + bf * 32768;
            if ((jt >> 1) == wchunk) {
                const float dqf = (float)(qpos - 32 * jt - 4 * hi);
#pragma unroll
                for (int r = 0; r < 16; ++r) { const float c = (float)((r & 3) + 8 * (r >> 2)); p[r] = fmaf(-slope2, fabsf(dqf - c), p[r]); }
                if (SAMPLE && jt == 64) {
#pragma unroll
                    for (int r = 8; r < 16; ++r) p[r] = -INFINITY; } }
            float tm = fmaxf(fmaxf(p[0], p[1]), p[2]);
#pragma unroll
            for (int r = 3; r < 15; r += 2) tm = fmaxf(fmaxf(tm, p[r]), p[r + 1]);
            tm = fmaxf(tm, p[15]);
            { float t1; const float t0 = swap_lo(tm, t1); tm = fmaxf(t0, t1); }
            float d = mref - m;
            if (__any(tm + d > DF_THR)) { const float mn = fmaxf(m, mref + tm); const float alpha = __builtin_amdgcn_exp2f(m - mn); m = mn; l *= alpha; d = mref - m;
#pragma unroll
                for (int db = 0; db < 8; ++db)
#pragma unroll
                    for (int r = 0; r < 16; ++r) o[db][r] *= alpha; }
            if (__any(d != 0.f)) {
#pragma unroll
                for (int r = 0; r < 16; ++r) p[r] += d; }
            float ps = 0.f;
#pragma unroll
            for (int r = 0; r < 16; ++r) { p[r] = __builtin_amdgcn_exp2f(p[r]); ps += p[r]; }
            l += ps;
            bf16x8 pf[2]; pack_p(pf, p);
            if (VAR != 1) pv<8, 2, VDB>(o, cur + 16384, lane, pf); else asm volatile("" :: "v"(pf[0]), "v"(pf[1]));
        }
        bf = bf1;
    }
    if (XP && n < XSTEPS) { asm volatile("s_waitcnt vmcnt(0)" ::: "memory"); XP_READ(xq);
        for (int s = n; s < XSTEPS; ++s) { xstep_store(((s & 1) ? vout : kout) + xbase + xstep_off(s, wid, lane), xq);
            if (s + 1 < XSTEPS) xq = xstep_load((((s + 1) & 1) ? Vb : Kb) + xbase + xstep_off(s + 1, wid, lane)); } }
    asm volatile("s_waitcnt lgkmcnt(0)" ::: "memory"); __builtin_amdgcn_s_barrier(); asm volatile("" ::: "memory");
#undef DF_QK
#undef XP_LOAD
#undef XP_READ
#undef DF_ISSUE
#undef DF_TILE_PTRS
    { float t1; const float t0 = swap_lo(l, t1); l = t0 + t1; }
    const float inv = live ? 1.0f / l : 0.f;
    const lptr xb = ring + sb * 32768 + lane * 16;
    if (mp == 1) { const float sc = lam * inv;
#pragma unroll
        for (int v = 0; v < 32; ++v) { const int db = v >> 2, gq = v & 3; f32x4 x = {o[db][4 * gq] * sc, o[db][4 * gq + 1] * sc, o[db][4 * gq + 2] * sc, o[db][4 * gq + 3] * sc};
            *(LAS f32x4*)(xb + v * 1024) = x; } }
    if (wid == 0) *(LAS f32x4*)(ring + 131072 + lane * 16) = *(const f32x4*)(gtab + lane * 4) * GSCALE;
    LDS_WAIT(); __syncthreads();
    if (mp == 0) { float ss = 0.f;
#pragma unroll
        for (int v = 0; v < 32; ++v) { const int db = v >> 2, gq = v & 3; const f32x4 x = *(const LAS f32x4*)(xb + v * 1024);
#pragma unroll
            for (int e = 0; e < 4; ++e) { const float y = o[db][4 * gq + e] * inv - x[e]; o[db][4 * gq + e] = y; ss += y * y; }
            if ((v & 3) == 3) asm volatile("" : "+v"(ss) :: "memory"); }
        { float t1; const float t0 = swap_lo(ss, t1); ss = t0 + t1; }
        const float rs = 1.0f / sqrtf(ss * (1.0f / 256.0f) + 1e-5f);
#pragma unroll
        for (int v = 0; v < 32; v += 2) { const int db = v >> 2, gq = v & 3; const int d0 = 32 * db + 8 * gq + 4 * hi; const f32x4 ga = *(const LAS f32x4*)(ring + 131072 + d0 * 4), gb = *(const LAS f32x4*)(ring + 131072 + d0 * 4 + 32);
            v2u wa, wb; wa.x = pk2(o[db][4 * gq] * rs * ga[0], o[db][4 * gq + 1] * rs * ga[1]); wa.y = pk2(o[db][4 * gq + 2] * rs * ga[2], o[db][4 * gq + 3] * rs * ga[3]);
            wb.x = pk2(o[db][4 * gq + 4] * rs * gb[0], o[db][4 * gq + 5] * rs * gb[1]); wb.y = pk2(o[db][4 * gq + 6] * rs * gb[2], o[db][4 * gq + 7] * rs * gb[3]);
            auto r = __builtin_amdgcn_permlane32_swap(wa.x, wb.x, false, false); wa.x = r[0]; wb.x = r[1];
            r = __builtin_amdgcn_permlane32_swap(wa.y, wb.y, false, false); wa.y = r[0]; wb.y = r[1];
            if (rvalid) *(v4u*)(Ob + qrow * D + coff + 32 * db + 8 * gq + 8 * hi) = (v4u){wa.x, wa.y, wb.x, wb.y};
            if ((v & 3) == 2) asm volatile("" ::: "memory"); }
    }
    LDS_WAIT(); __syncthreads();
}
}
#ifndef SKEW_TICKS
#define SKEW_TICKS 0
#endif
#ifndef SKEW2_QKV
#define SKEW2_QKV 0
#define SKEW2_WO 0
#define SKEW2_UP 0
#define SKEW2_DN 0
#endif
__device__ __forceinline__ void phase_skew(int ticks2) {
    if (SKEW_TICKS > 0 || ticks2 > 0) { const unsigned long long t0 = __builtin_amdgcn_s_memrealtime();
        const unsigned long long w = (unsigned long long)((blockIdx.x >> 3) & 31u) * SKEW_TICKS + (unsigned long long)((blockIdx.x >> 3) & 1u) * ticks2;
        while (__builtin_amdgcn_s_memrealtime() - t0 < w) __builtin_amdgcn_s_sleep(8); }
}
__device__ __forceinline__ int lane_id_fresh() { int l; asm volatile("v_mbcnt_lo_u32_b32 %0, -1, 0\n\tv_mbcnt_hi_u32_b32 %0, -1, %0" : "=v"(l)); return l; }
__device__ __forceinline__ void transpose_item(const float* W, int K, int N, bf16* WT, const float* gk  , LAS float* scr, int item, int lane) {
    const int nblk = N / 32, kb = item / nblk, nb = item % nblk, k0 = 64 * kb, n0 = 32 * nb;
    f32x4 v[8];
#pragma unroll
    for (int i = 0; i < 8; ++i) { v[i] = *(const f32x4*)(W + (size_t)(k0 + 8 * i + (lane >> 3)) * N + n0 + 4 * (lane & 7)); if (gk) v[i] = v[i] * gk[k0 + 8 * i + (lane >> 3)]; }
#pragma unroll
    for (int i = 0; i < 8; ++i) { LAS float* d = scr + (8 * i + (lane >> 3)) * 33 + 4 * (lane & 7); d[0] = v[i].x; d[1] = v[i].y; d[2] = v[i].z; d[3] = v[i].w; }
    LDS_WAIT(); asm volatile("" ::: "memory");
    const int c = lane & 7;
#pragma unroll
    for (int j = 0; j < 4; ++j) { const int n = (lane >> 3) + 8 * j; const LAS float* s = scr + (8 * c) * 33 + n;
        v4u o; o.x = pk2(s[0 * 33], s[1 * 33]); o.y = pk2(s[2 * 33], s[3 * 33]); o.z = pk2(s[4 * 33], s[5 * 33]); o.w = pk2(s[6 * 33], s[7 * 33]);
        *(v4u*)(WT + (size_t)(n0 + n) * K + k0 + 8 * c) = o; }
    LDS_WAIT(); asm volatile("" ::: "memory");
}
__device__ __forceinline__ void x0_rows(const float* srcp, const float* srcs, bf16* Xb, float* rowss, int gw, int NGW, int lane) {
    for (int m = gw; m < M; m += NGW) {
        v2u* o8 = (v2u*)(Xb + (size_t)m * D) + lane;
        if (m < MV) {
            const f32x4* xr = (const f32x4*)(m < MP ? srcp + (size_t)m * D : srcs + (size_t)(m - MP) * D) + lane;
            f32x4 v[8]; float ss = 0.f;
#pragma unroll
            for (int j = 0; j < 8; ++j) { v[j] = xr[64 * j]; ss += (v[j].x * v[j].x + v[j].y * v[j].y) + (v[j].z * v[j].z + v[j].w * v[j].w); }
            ss = wave_sum(ss); if (lane == 0) rowss[m] = ss;
#pragma unroll
            for (int j = 0; j < 8; ++j) { v2u w; w.x = pk2(v[j].x, v[j].y); w.y = pk2(v[j].z, v[j].w); o8[64 * j] = w; }
        } else {
#pragma unroll
            for (int j = 0; j < 8; ++j) o8[64 * j] = (v2u){0u, 0u};
        }
    }
}
__device__ __forceinline__ void final_rows(const bf16* Xb, const float* rowss, const float* g, float* Y, int gw, int NGW, int lane) {
    for (int m = gw; m < MV; m += NGW) {
        const v2u* xr = (const v2u*)(Xb + (size_t)m * D) + lane; f32x4* yr = (f32x4*)(Y + (size_t)m * D) + lane;
        const float rs = 1.0f / sqrtf(rowss[m] * (1.0f / D) + 1e-6f);
#pragma unroll
        for (int j = 0; j < 8; ++j) { const v2u w = xr[64 * j]; const f32x4 gv = ((const f32x4*)g)[lane + 64 * j];
            f32x4 x = {__uint_as_float(w.x << 16), __uint_as_float(w.x & 0xffff0000u), __uint_as_float(w.y << 16), __uint_as_float(w.y & 0xffff0000u)};
            yr[64 * j] = (x * rs) * gv; }
    }
}
__device__ __forceinline__ void cache_convert(const float* ck, const float* cv, bf16* CK, bf16* CV, int k_lo  , size_t gt, size_t NT) {
    const size_t per = (size_t)(PAST - k_lo) * D / 8, NCH = (size_t)DEC_B * per;
    for (size_t i = gt; i < 2 * NCH; i += NT) { const bool t = i >= NCH; const size_t j = t ? i - NCH : i; const size_t s_ = j / per, r_ = j % per;
        const size_t c = (s_ * PAST + k_lo) * (size_t)(D / 8) + r_;
        const f32x4* s = (const f32x4*)((t ? cv : ck) + c * 8); const f32x4 a = s[0], b2 = s[1];
        v4u o; o.x = pk2(a.x, a.y); o.y = pk2(a.z, a.w); o.z = pk2(b2.x, b2.y); o.w = pk2(b2.z, b2.w);
        *(v4u*)((t ? CV : CK) + c * 8) = o; }
}

struct Args { const float* in[16]; float* out; unsigned char* ws; int ph_lo, ph_hi; };
struct SkQKV { static constexpr bool SS = false; unsigned char* ws; float* out; int L; float qscale; const float* rowss;
    __device__ __forceinline__ float operator()(int row, int col, float v) const { const int t = col >> 11, c = col & 2047;
        if (rowss) v *= 1.0f / sqrtf(rowss[row] * (1.0f / D) + 1e-6f);
        bf16* ob = (bf16*)(ws + QKV_WS_Q + (size_t)t * QKV_WS_STRIDE) + (size_t)row * D + c;
        const float sv = t == 0 ? v * qscale : v; *ob = (bf16)(pk2(sv, 0.f) & 0xffffu);
        if (t != 0) { float* fs = out + (t == 1 ? QKV_OUT_KS : QKV_OUT_VS) + (size_t)L * MS * D; fs[(size_t)(row - MP) * D + c] = v; } return 0.f; } };
struct SkResidB { static constexpr bool SS = true; bf16* X; float* rowss;
    __device__ __forceinline__ float operator()(int row, int col, float v) const { bf16* p = X + (size_t)row * D + col; const float x = __uint_as_float((unsigned)*p << 16) + v;
        *p = (bf16)(pk2(x, 0.f) & 0xffffu); return x; } };
struct SkRelu2 { static constexpr bool SS = false; bf16* O; int ldc; const float* rowss;
    __device__ __forceinline__ float operator()(int row, int col, float v) const { if (rowss) v *= 1.0f / sqrtf(rowss[row] * (1.0f / D) + 1e-6f);
        const float a = fmaxf(v, 0.f); O[(size_t)row * ldc + col] = (bf16)(pk2(a * a, 0.f) & 0xffffu); return 0.f; } };
template <class Epi>
__device__ __forceinline__ void skinny_phase(LAS unsigned char* ring, const bf16* A, const bf16* Bt, int N, int K, const Epi& E, int vcu, int G, int wave, int lane) {
    typedef short bf16x8 __attribute__((ext_vector_type(8))); typedef float f32x16 __attribute__((ext_vector_type(16)));
    const int ntile = 4 * (N / 32), r32 = lane & 31, hi = lane >> 5, kw = K / 8;
    LAS float* red = (LAS float*)ring;
    LAS unsigned char* stg = ring + wave * 16384;
    const int srow = lane >> 4, sch = lane & 15, xk = (r32 & 15);
    for (int t = vcu; t < ntile; t += G) {
        const int mb = t & 3, nb = t >> 2;
        const bf16* ap = A + (size_t)(MP + 32 * mb + srow) * K + wave * kw + sch * 8;
        const bf16* bp = Bt + (size_t)(32 * nb + srow) * K + wave * kw + sch * 8;
        f32x16 acc = f32x16{};
#pragma unroll 1
        for (int k0 = 0; k0 < kw; k0 += 128) {
            bf16x8 ga[8], gb[8];
#pragma unroll
            for (int i = 0; i < 8; ++i) { ga[i] = *(const bf16x8*)(ap + (size_t)(4 * i) * K + k0); gb[i] = *(const bf16x8*)(bp + (size_t)(4 * i) * K + k0); }
#pragma unroll
            for (int i = 0; i < 8; ++i) { const int row = 4 * i + srow; const int off = row * 256 + ((sch ^ (row & 15)) << 4);
                *(LAS bf16x8*)(stg + off) = ga[i]; *(LAS bf16x8*)(stg + 8192 + off) = gb[i]; }
            LDS_WAIT();
#pragma unroll
            for (int ks = 0; ks < 8; ++ks) { const int off = r32 * 256 + (((2 * ks + hi) ^ xk) << 4);
                acc = __builtin_amdgcn_mfma_f32_32x32x16_bf16(*(const LAS bf16x8*)(stg + off), *(const LAS bf16x8*)(stg + 8192 + off), acc, 0, 0, 0); }
            LDS_WAIT();
        }
        __syncthreads();
#pragma unroll
        for (int r = 0; r < 16; ++r) red[(wave * 16 + r) * 64 + lane] = acc[r];
        LDS_WAIT(); __syncthreads();
        float v0 = 0.f, v1 = 0.f;
#pragma unroll
        for (int w = 0; w < 8; ++w) { v0 += red[(w * 16 + 2 * wave) * 64 + lane]; v1 += red[(w * 16 + 2 * wave + 1) * 64 + lane]; }
        const int r0 = 2 * wave, row0 = MP + 32 * mb + (r0 & 3) + 8 * (r0 >> 2) + 4 * hi, col = 32 * nb + r32;
        float x0 = E(row0, col, v0), x1 = E(row0 + 1, col, v1);
        if constexpr (Epi::SS) { x0 *= x0; x1 *= x1;
#pragma unroll
            for (int o = 1; o < 32; o <<= 1) { x0 += __shfl_xor(x0, o); x1 += __shfl_xor(x1, o); }
            if (r32 == 0) { atomicAdd(E.rowss + row0, x0); atomicAdd(E.rowss + row0 + 1, x1); } }
        LDS_WAIT(); __syncthreads();
    }
}

#ifndef WGM_QKV
#define WGM_QKV 4
#endif
#ifndef WGM_WO
#define WGM_WO 2
#endif
#ifndef WGM_UP
#define WGM_UP 4
#endif
#ifndef WGM_DN
#define WGM_DN 4
#endif
#ifndef FFN_CHUNKS
#define FFN_CHUNKS 1
#endif
#ifndef PROBE_VAR
#define PROBE_VAR 0
#endif
#ifndef PROBE_DUP
#define PROBE_DUP 0
#endif
template <int L>
__device__ __forceinline__ void layer_phases(const Args& args, LAS unsigned char* lds, volatile LAS int* flags, const XcdBarrier& bar, int lo, int hi, int G, int vcu, int wave) {
#define PHASE_LOCALS const int lane = lane_id_fresh(); const int tid = wave * 64 + lane;
#define IN(k) (lo <= (k) && (k) < hi)
#define SEAM(k) do { if (ONE_LAUNCH && IN(k) && IN((k) + 1)) xcd_barrier(bar); } while (0)
    unsigned char* ws = args.ws;
    const float* x_prompt = args.in[0]; const float* x_sample = args.in[1];
    bf16* XN = (bf16*)(ws + WS_XN);
    bf16* CK = (bf16*)(ws + (L == 0 ? WS_CK : WS_CK1)); bf16* CV = (bf16*)(ws + (L == 0 ? WS_CV : WS_CV1));
    float* const RSS = (float*)(ws + WS_CTL) + CW_RSS;
    const float* const rss_qkv = RSS + (size_t)(2 * L) * MV; float* const rss_wo = RSS + (size_t)(2 * L + 1) * MV; float* const rss_dn = RSS + (size_t)(2 * L + 2) * MV;
    bf16* Qb = (bf16*)(ws + WS_Q); bf16* Kb = (bf16*)(ws + WS_K); bf16* Vb = (bf16*)(ws + WS_V); bf16* Hb = (bf16*)(ws + WS_H);
    const int gw = vcu * NWAVES + wave, NGW = G * NWAVES;

        const int pb = 1 + 7 * L;
        unsigned char* wl = ws + WS_W + (size_t)L * W_LAYER;
        const bf16* Wqkv_t = (const bf16*)(wl + W_QKV); const bf16* Wo_t = (const bf16*)(wl + W_O); const bf16* Wup_t = (const bf16*)(wl + W_UP); const bf16* Wdn_t = (const bf16*)(wl + W_DN);
        constexpr bool DUPG = (L == 0) && (PROBE_DUP & 2), DUPA = (L == 0 ? (PROBE_DUP & 8) : (PROBE_DUP & 4)) != 0, DUPT = (L == 0) && (PROBE_DUP & 16), DUPU = (L == 0) && (PROBE_DUP & 32);
        bf16* const DUMMY_O = (bf16*)(ws + WS_V + (size_t)M * D * 2);
        float* const DUMMY_X = (float*)(ws + WS_XN);
        if (IN(pb)) { PHASE_LOCALS
#pragma unroll
            for (int rep = 0; rep < (DUPG ? 2 : 1); ++rep) {
            pg8::Gemm g{XN, Wqkv_t, MP, 3 * D, D}; pg8::StaticOrder S; S.init(MP, 3 * D, G, (int)blockIdx.x, WGM_QKV);
            pg8::EpiQKV E{ws, args.out, L, att::QSCALE, (unsigned*)(ws + WS_CTL) + CW_KN, rss_qkv};
            phase_skew(SKEW2_QKV);
            pg8::gemm_phase<pg8::EpiQKV, pg8::StaticOrder, PG8_ALIGN, PG8_SP2>(lds + RING_OFF, g, S, E, wave, lane);
            skinny_phase(lds + RING_OFF, XN, Wqkv_t, 3 * D, D, SkQKV{ws, args.out, L, att::QSCALE, rss_qkv}, vcu, G, wave, lane);
            }
        }
        SEAM(pb);
        if (IN(pb + 1)) { PHASE_LOCALS float* const KOUT = args.out + OUT_KP + (size_t)L * MP * D; float* const VOUT = args.out + OUT_VP + (size_t)L * MP * D;
            if (L == 0) {
#pragma unroll
                for (int rep = 0; rep < (DUPA ? 2 : 1); ++rep) { bf16* const Ob = (DUPA && rep == 0) ? DUMMY_O : Qb;
                for (int u = vcu; u < 2048; u += G) att::sb_unit<false>(lds + RING_OFF, flags, Qb, Kb, Vb, CK, CV, args.in[2], args.in[3], Ob, u >> 9, (u >> 5) & 15, u & 31, wave, lane);
                for (int u = vcu; u < 128; u += G) att::sb_unit<true>(lds + RING_OFF, flags, Qb, Kb, Vb, CK, CV, args.in[2], args.in[3], Ob, u >> 4, u & 15, 0, wave, lane);
                }
            } else {
                constexpr float LAMBDA_INIT = 0.35550906759096926f;
                float s1 = args.in[7][lane] * args.in[8][lane] + args.in[7][lane + 64] * args.in[8][lane + 64];
                float s2 = args.in[9][lane] * args.in[10][lane] + args.in[9][lane + 64] * args.in[10][lane + 64];
                s1 = wave_sum(s1); s2 = wave_sum(s2);
                const float lam = expf(s1) - expf(s2) + LAMBDA_INIT;
                const float* gtab = args.in[11];
                volatile LAS unsigned* MISCp = (volatile LAS unsigned*)(lds + LDSCTL_OFF);
                const unsigned st0 = MISCp[8], st1 = MISCp[9];
                LDS_WAIT(); __syncthreads();
#pragma unroll
                for (int rep = 0; rep < (DUPA ? 2 : 1); ++rep) { bf16* const Ob = (DUPA && rep == 0) ? DUMMY_O : Qb;
                volatile LAS float* qn = (volatile LAS float*)(lds + 65536);
                volatile LAS int* qslot = (volatile LAS int*)(lds + 65536 + 64);
                const float* kn = (const float*)(ws + WS_CTL) + CW_KN;
                const unsigned q0 = xb_xcc_id() & 7u;
                for (unsigned qk = 0; qk < 8; ++qk) { const unsigned q = (q0 + qk) & 7u; unsigned* head = (unsigned*)(ws + WS_CTL) + CW_QH + 64 * q + 16 * (DUPA ? rep : 0);
                    for (;;) {
                        if (tid == 0) *qslot = (int)atomicAdd(head, 1u);
                        LDS_WAIT(); __syncthreads();
                        const int e = *qslot;
                        __syncthreads();
                        if (e >= 264) break;
                        if (e >= 8) { const int ep = e - 8; const int qb = 63 - (ep >> 2), g4 = ep & 3; const int b = 2 * (q >> 2) + (g4 & 1), h8 = (g4 & 2) ? 7 - (q & 3) : (q & 3);
                            if (DUPA && rep == 0) att::diff_unit<false, PROBE_VAR>(lds + RING_OFF, gtab, qn, kn, Qb, Kb, Vb, CK, CV, Ob, KOUT, VOUT, b, h8, qb, lam, wave, lane);
                            else att::diff_unit<false>(lds + RING_OFF, gtab, qn, kn, Qb, Kb, Vb, CK, CV, Ob, KOUT, VOUT, b, h8, qb, lam, wave, lane); }
                        else att::diff_unit<true>(lds + RING_OFF, gtab, qn, kn, Qb, Kb, Vb, CK, CV, Ob, KOUT, VOUT, e, q, 0, lam, wave, lane);
                    }
                }
                if (DUPA ? rep == 1 : true) { LDS_WAIT(); __syncthreads(); if (tid == 0) { MISCp[8] = st0; MISCp[9] = st1; } LDS_WAIT(); __syncthreads(); }
                }
            }
        }
        SEAM(pb + 1);
        if (IN(pb + 2)) { PHASE_LOCALS
#pragma unroll
            for (int rep = 0; rep < (DUPG ? 2 : 1); ++rep) {
            pg8::Gemm g{Qb, Wo_t, MP, D, D}; pg8::StaticOrder S; S.init(MP, D, G, (int)blockIdx.x, WGM_WO);
            pg8::EpiResidB E{XN, rss_wo};
            phase_skew(SKEW2_WO);
            pg8::gemm_phase<pg8::EpiResidB, pg8::StaticOrder, PG8_ALIGN, PG8_SP2>(lds + RING_OFF, g, S, E, wave, lane);
            skinny_phase(lds + RING_OFF, Qb, Wo_t, D, D, SkResidB{XN, rss_wo}, vcu, G, wave, lane);
            }
        }
        SEAM(pb + 2);
        constexpr int NC = (ONE_LAUNCH && PROBE_DUP == 0) ? FFN_CHUNKS : 1, MC = MP / NC;
        static_assert(MP % NC == 0 && (MC / 256) * (FF / 256) % 256 == 0 && (MC / 256) * (D / 256) % 256 == 0, "chunk GEMMs must be whole rounds");
        bf16* const Hs = (bf16*)((unsigned char*)Hb + ((size_t)MC * FF - (size_t)MP * FF) * 2);
#pragma unroll 1
        for (int c = 0; c < NC; ++c) {
        if (IN(pb + 4)) { PHASE_LOCALS
#pragma unroll
            for (int rep = 0; rep < ((DUPG || DUPU) ? 2 : 1); ++rep) {
            pg8::Gemm g{XN + (size_t)c * MC * D, Wup_t, MC, FF, D}; pg8::StaticOrder S; S.init(MC, FF, G, (int)blockIdx.x, WGM_UP);
            pg8::EpiRelu2 E{Hb, FF, DUPU && rep == 0 && (PROBE_DUP & 64), rss_wo + (size_t)c * MC};
            phase_skew(SKEW2_UP);
            pg8::gemm_phase<pg8::EpiRelu2, pg8::StaticOrder, PG8_ALIGN, PG8_SP2>(lds + RING_OFF, g, S, E, wave, lane);
            if (c == 0) skinny_phase(lds + RING_OFF, XN, Wup_t, FF, D, SkRelu2{Hs, FF, rss_wo}, vcu, G, wave, lane);
            }
        }
        if (NC > 1) xcd_barrier(bar); else SEAM(pb + 4);
        if (IN(pb + 5)) { PHASE_LOCALS
#pragma unroll
            for (int rep = 0; rep < 1; ++rep) {
            pg8::Gemm g{Hb, Wdn_t, MC, D, FF}; pg8::StaticOrder S; S.init(MC, D, G, (int)blockIdx.x, WGM_DN);
            pg8::EpiResidB E{XN + (size_t)c * MC * D, rss_dn + (size_t)c * MC};
            phase_skew(SKEW2_DN);
            pg8::gemm_phase<pg8::EpiResidB, pg8::StaticOrder, PG8_ALIGN, PG8_SP2>(lds + RING_OFF, g, S, E, wave, lane);
            if (c == NC - 1) skinny_phase(lds + RING_OFF, Hs, Wdn_t, D, FF, SkResidB{XN, rss_dn}, vcu, G, wave, lane);
            }
        }
        if (NC > 1) xcd_barrier(bar); else SEAM(pb + 5);
        }
        if (L == 1 && IN(pb + 6)) { PHASE_LOCALS final_rows(XN, rss_dn, args.in[15], args.out + OUT_Y, gw, NGW, lane); }

#undef PHASE_LOCALS
#undef IN
#undef SEAM
}

__global__ void __launch_bounds__(NWAVES * 64, 2) fwd_kernel(Args args) {
    extern __shared__ __attribute__((aligned(16))) unsigned char lds_raw[];
    LAS unsigned char* lds = (LAS unsigned char*)lds_raw;
    volatile LAS unsigned* MISC = (volatile LAS unsigned*)(lds + LDSCTL_OFF);
    volatile LAS int* flags = (volatile LAS int*)(lds + LDSCTL_OFF + 128);
    const int wave = __builtin_amdgcn_readfirstlane((int)threadIdx.x >> 6);
    const int lane = lane_id_fresh(); const int tid = wave * 64 + lane;
    const int G = gridDim.x; const int bx = blockIdx.x; const int vcu = (G % 8 == 0) ? (bx % 8) * (G / 8) + bx / 8 : bx;
    for (int u = tid; u < 128; u += NWAVES * 64) ((LAS unsigned*)(lds + LDSCTL_OFF))[u] = 0u;
    __syncthreads();
    unsigned char* ws = args.ws;
    gu32* ctl = (gu32*)(ws + WS_CTL);
    XcdBarrier bar; bar.bar = (unsigned*)ctl + CW_BAR; bar.x = 0; bar.st = nullptr; bar.wave = wave;
    if (ONE_LAUNCH) bar = xcd_barrier_post((unsigned*)ctl + CW_BAR, MISC + 8, wave);
    const int lo = args.ph_lo, hi = args.ph_hi;
#define IN(k) (lo <= (k) && (k) < hi)
#define SEAM(k) do { if (ONE_LAUNCH && IN(k) && IN((k) + 1)) xcd_barrier(bar); } while (0)
    const float* x_prompt = args.in[0]; const float* x_sample = args.in[1];
    float* X = args.out + OUT_Y;
    bf16* XN = (bf16*)(ws + WS_XN); bf16* CK = (bf16*)(ws + WS_CK); bf16* CV = (bf16*)(ws + WS_CV);
    bf16* Qb = (bf16*)(ws + WS_Q); bf16* Kb = (bf16*)(ws + WS_K); bf16* Vb = (bf16*)(ws + WS_V); bf16* Hb = (bf16*)(ws + WS_H);
    const int gw = vcu * NWAVES + wave, NGW = G * NWAVES;

    if (IN(0)) {
#pragma unroll
        for (int rep = 0; rep < ((PROBE_DUP & 1) ? 2 : 1); ++rep) {
        LAS float* scr = (LAS float*)(lds + RING_OFF + wave * 16384);
        constexpr int I_QKV = (D / 64) * (3 * D / 32), I_O = (D / 64) * (D / 32), I_UP = (D / 64) * (FF / 32), I_DN = (FF / 64) * (D / 32), I_L = I_QKV + I_O + I_UP + I_DN;
        for (int it = gw; it < 2 * I_L; it += NGW) {
            const int L = it / I_L; int r = it % I_L; unsigned char* wl = ws + WS_W + (size_t)L * W_LAYER;
            if (r < I_QKV) { transpose_item(args.in[5] + (size_t)L * D * 3 * D, D, 3 * D, (bf16*)(wl + W_QKV), args.in[4] + (size_t)L * D, scr, r, lane); continue; } r -= I_QKV;
            if (r < I_O) { transpose_item(args.in[6] + (size_t)L * D * D, D, D, (bf16*)(wl + W_O), nullptr, scr, r, lane); continue; } r -= I_O;
            if (r < I_UP) { transpose_item(args.in[13] + (size_t)L * D * FF, D, FF, (bf16*)(wl + W_UP), args.in[12] + (size_t)L * D, scr, r, lane); continue; } r -= I_UP;
            transpose_item(args.in[14] + (size_t)L * FF * D, FF, D, (bf16*)(wl + W_DN), nullptr, scr, r, lane);
        }
        cache_convert(args.in[2], args.in[3], CK, CV, 64 * att::SB_EAGER_LO, (size_t)vcu * (NWAVES * 64) + tid, (size_t)G * (NWAVES * 64));
        cache_convert(args.in[2] + (size_t)DEC_B * PAST * D, args.in[3] + (size_t)DEC_B * PAST * D, (bf16*)(ws + WS_CK1), (bf16*)(ws + WS_CV1), 0, (size_t)vcu * (NWAVES * 64) + tid, (size_t)G * (NWAVES * 64));
        x0_rows(x_prompt, x_sample, XN, (float*)(ws + WS_CTL) + CW_RSS, gw, NGW, lane);
        for (int i = vcu * (NWAVES * 64) + tid; i < 3 * (M - MV) * D / 8; i += G * (NWAVES * 64)) { const int t = i / ((M - MV) * D / 8), c = i % ((M - MV) * D / 8);
            *(v4u*)(ws + WS_Q + (size_t)t * (WS_K - WS_Q) + ((size_t)MV * D + (size_t)c * 8) * 2) = (v4u){0u, 0u, 0u, 0u}; }
        }
    }
    SEAM(0);

    layer_phases<0>(args, lds, flags, bar, lo, hi, G, vcu, wave);
    layer_phases<1>(args, lds, flags, bar, lo, hi, G, vcu, wave);
#undef IN
#undef SEAM
}

extern "C" void kernel_launch(void* const* d_in, const int* in_sizes, int n_in, void* d_out, int out_size, void* d_ws, size_t ws_size, hipStream_t stream) {
    static int grid = 0;
    if (grid == 0) {
        if (n_in != 16 || (size_t)out_size != OUT_END || ws_size < WS_END) { fprintf(stderr, "kernel_launch: unexpected shapes (n_in %d out %d ws %zu)\n", n_in, out_size, ws_size); grid = -1; return; }
        int dev = 0, cus = 0;
        if (hipGetDevice(&dev) != hipSuccess || hipDeviceGetAttribute(&cus, hipDeviceAttributeMultiprocessorCount, dev) != hipSuccess) { grid = -1; return; }
        if (hipFuncSetAttribute((const void*)fwd_kernel, hipFuncAttributeMaxDynamicSharedMemorySize, LDS_BYTES) != hipSuccess) { fprintf(stderr, "kernel_launch: hipFuncSetAttribute failed\n"); grid = -1; return; }
        int per_cu = 0;
        if (hipOccupancyMaxActiveBlocksPerMultiprocessor(&per_cu, (const void*)fwd_kernel, NWAVES * 64, LDS_BYTES) != hipSuccess || per_cu < 1) fprintf(stderr, "kernel_launch: occupancy query says %d\n", per_cu);
        (void)hipGetLastError();
        grid = cus;
    }
    if (grid < 0) return;
    (void)hipMemsetAsync((char*)d_ws + WS_CTL, 0, CTL_ZERO_BYTES, stream);
    Args a{};
    for (int i = 0; i < 16; ++i) a.in[i] = (const float*)d_in[i];
    a.out = (float*)d_out; a.ws = (unsigned char*)d_ws;
    if (ONE_LAUNCH) { a.ph_lo = 0; a.ph_hi = N_PHASES; hipLaunchKernelGGL(fwd_kernel, dim3(grid), dim3(NWAVES * 64), LDS_BYTES, stream, a); }
    else for (int p = 0; p < N_PHASES; ++p) { a.ph_lo = p; a.ph_hi = p + 1; hipLaunchKernelGGL(fwd_kernel, dim3(grid), dim3(NWAVES * 64), LDS_BYTES, stream, a); }
}
```
